# Optimizing an MI355X kernel written in HIP

```python
import math
import jax, jax.numpy as jnp
from jax import lax
import numpy as np

D_MODEL = 2048
BATCH = 2
SEQ = 4096
DEPTH = 1

N_HEADS = 16
HEAD_DIM = 128
ATTN_WIDTH = N_HEADS * HEAD_DIM
ROPE_DIM = HEAD_DIM // 4
ROPE_THETA = 500000.0
MOBA_BLOCK = 256
MOBA_TOPK = 3
Q_CHUNK = 128
CONV_WIDTH = D_MODEL
CONV_GROUPS = 16
CONV_K = 3
N_EXPERTS = 32
TOP_K = 4
D_FF = D_MODEL
SWIGLU_LIMIT = 7.0
SWIGLU_ALPHA = 1.702
EXPERT_BLOCK = 128
NORM_EPS = 1e-5
NEG = -1e30
IN_COLS = 3 * CONV_WIDTH + 3 * ATTN_WIDTH + 2 * D_MODEL

kernel_name = 'hybrid_shortconv_moba_moe_block'


def rms_norm(x, g):
    xf = x.astype(jnp.float32)
    y = xf * lax.rsqrt(jnp.mean(xf * xf, axis=-1, keepdims=True) + NORM_EPS)
    return (y * g.astype(jnp.float32)).astype(x.dtype)


def partial_rope(t, pos):
    half = ROPE_DIM // 2
    inv_freq = jnp.exp(-math.log(ROPE_THETA) * jnp.arange(half, dtype=jnp.float32) / half)
    ang = pos.astype(jnp.float32)[:, None] * inv_freq[None, :]
    cos = jnp.cos(ang)[None, :, None, :]
    sin = jnp.sin(ang)[None, :, None, :]
    r1 = t[..., :half].astype(jnp.float32)
    r2 = t[..., half:ROPE_DIM].astype(jnp.float32)
    rot = jnp.concatenate([r1 * cos - r2 * sin, r2 * cos + r1 * sin], axis=-1).astype(t.dtype)
    return jnp.concatenate([rot, t[..., ROPE_DIM:]], axis=-1)


def short_conv_mixer(b_gate, c_gate, h, conv_w):
    u = c_gate * h
    y = lax.conv_general_dilated(
        u, conv_w[:, None, :].astype(u.dtype), window_strides=(1,),
        padding=[(CONV_K - 1, 0)], dimension_numbers=('NWC', 'WIO', 'NWC'),
        feature_group_count=CONV_WIDTH)
    return b_gate * y


def moba_attention(q, k, v):
    B, S, H, Dh = q.shape
    n_kb = -(-S // MOBA_BLOCK)
    pad = n_kb * MOBA_BLOCK - S
    k_sel_n = min(MOBA_TOPK, n_kb)
    n_qc = S // Q_CHUNK
    scale = Dh ** -0.5

    def to_bh(t):
        return t.transpose(0, 2, 1, 3).reshape(B * H, S, Dh)

    qf, kf, vf = to_bh(q), to_bh(k), to_bh(v)
    kb = jnp.pad(kf, ((0, 0), (0, pad), (0, 0))).reshape(B * H, n_kb, MOBA_BLOCK, Dh)
    vb = jnp.pad(vf, ((0, 0), (0, pad), (0, 0))).reshape(B * H, n_kb, MOBA_BLOCK, Dh)
    k_mean = jnp.mean(kb.astype(jnp.float32), axis=2)
    blk_ids = jnp.arange(n_kb)
    key_off = jnp.arange(MOBA_BLOCK)

    def one_chunk(idx):
        bh = idx // n_qc
        q0 = (idx % n_qc) * Q_CHUNK
        qc = lax.dynamic_slice(qf, (bh, q0, 0), (1, Q_CHUNK, Dh))[0].astype(jnp.float32)
        qpos = q0 + jnp.arange(Q_CHUNK)
        own = q0 // MOBA_BLOCK
        kb_bh, vb_bh = kb[bh], vb[bh]
        gate = qc @ k_mean[bh].T
        gate = jnp.where(blk_ids[None, :] < own, gate, NEG)
        _, sel = lax.top_k(gate, k_sel_n)
        sel_ok = sel < own
        k_sel = kb_bh[sel].astype(jnp.float32)
        v_sel = vb_bh[sel].astype(jnp.float32)
        s_sel = jnp.einsum('qd,qjkd->qjk', qc, k_sel) * scale
        s_sel = jnp.where(sel_ok[:, :, None], s_sel, NEG).reshape(Q_CHUNK, k_sel_n * MOBA_BLOCK)
        k_own = kb_bh[own].astype(jnp.float32)
        v_own = vb_bh[own].astype(jnp.float32)
        s_own = (qc @ k_own.T) * scale
        kpos = own * MOBA_BLOCK + key_off
        s_own = jnp.where(kpos[None, :] <= qpos[:, None], s_own, NEG)
        p = jax.nn.softmax(jnp.concatenate([s_sel, s_own], axis=-1), axis=-1)
        p_sel = p[:, :k_sel_n * MOBA_BLOCK].reshape(Q_CHUNK, k_sel_n, MOBA_BLOCK)
        p_own = p[:, k_sel_n * MOBA_BLOCK:]
        o = jnp.einsum('qjk,qjkd->qd', p_sel, v_sel) + p_own @ v_own
        return o.astype(q.dtype)

    out = lax.map(one_chunk, jnp.arange(B * H * n_qc))
    return out.reshape(B, H, S, Dh).transpose(0, 2, 1, 3)


def hybrid_mixer(x, w_in, conv_w, w_conv_out, w_attn_out, w_o, pos):
    B, S, _ = x.shape
    proj = x @ w_in
    cw, aw = CONV_WIDTH, ATTN_WIDTH
    splits = [cw, 2 * cw, 3 * cw, 3 * cw + aw, 3 * cw + 2 * aw, 3 * cw + 3 * aw, 3 * cw + 3 * aw + D_MODEL]
    b_g, c_g, h_c, q, k, v, g_conv, g_attn = jnp.split(proj, splits, axis=-1)
    y_conv = short_conv_mixer(b_g, c_g, h_c, conv_w) @ w_conv_out
    q = partial_rope(q.reshape(B, S, N_HEADS, HEAD_DIM), pos)
    k = partial_rope(k.reshape(B, S, N_HEADS, HEAD_DIM), pos)
    v = v.reshape(B, S, N_HEADS, HEAD_DIM)
    y_attn = moba_attention(q, k, v).reshape(B, S, ATTN_WIDTH) @ w_attn_out
    merged = jax.nn.sigmoid(g_conv) * y_conv + jax.nn.sigmoid(g_attn) * y_attn
    return merged @ w_o


def moe_ffn(x, w_router, b_router, w_gate, b_gate, w_up, b_up, w_down, b_down):
    B, S, D = x.shape
    T = B * S
    xt = x.reshape(T, D)
    logits = xt.astype(jnp.float32) @ w_router.astype(jnp.float32) + b_router.astype(jnp.float32)
    top_logit, top_e = lax.top_k(logits, TOP_K)
    top_w = jax.nn.softmax(top_logit, axis=-1)
    A = T * TOP_K
    flat_e = top_e.reshape(A)
    flat_tok = jnp.repeat(jnp.arange(T, dtype=jnp.int32), TOP_K)
    flat_w = top_w.reshape(A)
    order = jnp.argsort(flat_e)
    se, stok, sw = flat_e[order], flat_tok[order], flat_w[order]
    counts = jnp.bincount(flat_e, length=N_EXPERTS)
    starts = jnp.cumsum(counts) - counts
    padded = (counts + EXPERT_BLOCK - 1) // EXPERT_BLOCK * EXPERT_BLOCK
    pad_end = jnp.cumsum(padded)
    pad_start = pad_end - padded
    dest = pad_start[se] + (jnp.arange(A) - starts[se])
    n_blocks = (A + N_EXPERTS * (EXPERT_BLOCK - 1)) // EXPERT_BLOCK + 1
    rows = n_blocks * EXPERT_BLOCK
    row_tok = jnp.zeros((rows,), jnp.int32).at[dest].set(stok)
    row_w = jnp.zeros((rows,), jnp.float32).at[dest].set(sw)
    block_e = jnp.minimum(
        jnp.searchsorted(pad_end, jnp.arange(n_blocks) * EXPERT_BLOCK, side='right'), N_EXPERTS - 1)
    xb = xt[row_tok].reshape(n_blocks, EXPERT_BLOCK, D)

    def expert_block(args):
        e, xe = args
        g = xe @ w_gate[e] + b_gate[e]
        u = xe @ w_up[e] + b_up[e]
        g = jnp.minimum(g, SWIGLU_LIMIT)
        u = jnp.clip(u, -SWIGLU_LIMIT, SWIGLU_LIMIT)
        hid = (u + 1.0) * (g * jax.nn.sigmoid(SWIGLU_ALPHA * g))
        return hid @ w_down[e] + b_down[e]

    yb = lax.map(expert_block, (block_e, xb))
    y = jax.ops.segment_sum(yb.reshape(rows, D).astype(jnp.float32) * row_w[:, None],
                            row_tok, num_segments=T)
    return y.astype(x.dtype).reshape(B, S, D)


def setup_inputs(seed: int = 0) -> dict:
    key = jax.random.key(seed)
    ks = jax.random.split(key, 18)
    f32 = jnp.float32
    L, D, E, F = DEPTH, D_MODEL, N_EXPERTS, D_FF

    def nrm(k, shape, scale):
        return jax.random.normal(k, shape, f32) * scale

    return {
        'x': nrm(ks[0], (BATCH, SEQ, D), 1.0),
        'norm_mix': 1.0 + nrm(ks[1], (L, D), 0.02),
        'w_in': nrm(ks[2], (L, D, IN_COLS), D ** -0.5),
        'conv_w': nrm(ks[3], (L, CONV_K, CONV_WIDTH), CONV_K ** -0.5),
        'w_conv_out': nrm(ks[4], (L, CONV_WIDTH, D), CONV_WIDTH ** -0.5),
        'w_attn_out': nrm(ks[5], (L, ATTN_WIDTH, D), ATTN_WIDTH ** -0.5),
        'w_o': nrm(ks[6], (L, D, D), D ** -0.5),
        'norm_ffn': 1.0 + nrm(ks[7], (L, D), 0.02),
        'w_router': nrm(ks[8], (L, D, E), D ** -0.5),
        'b_router': nrm(ks[9], (L, E), 0.01),
        'w_gate': nrm(ks[10], (L, E, D, F), D ** -0.5),
        'b_gate': nrm(ks[11], (L, E, F), 0.01),
        'w_up': nrm(ks[12], (L, E, D, F), D ** -0.5),
        'b_up': nrm(ks[13], (L, E, F), 0.01),
        'w_down': nrm(ks[14], (L, E, F, D), F ** -0.5),
        'b_down': nrm(ks[15], (L, E, D), 0.01),
        'norm_final': 1.0 + nrm(ks[16], (D,), 0.02),
    }


def reference(x, norm_mix, w_in, conv_w, w_conv_out, w_attn_out, w_o, norm_ffn,
              w_router, b_router, w_gate, b_gate, w_up, b_up, w_down, b_down, norm_final):
    pos = jnp.arange(x.shape[1], dtype=jnp.int32)
    h = x
    for l in range(DEPTH):
        h = h + hybrid_mixer(rms_norm(h, norm_mix[l]), w_in[l], conv_w[l], w_conv_out[l],
                             w_attn_out[l], w_o[l], pos)
        h = h + moe_ffn(rms_norm(h, norm_ffn[l]), w_router[l], b_router[l], w_gate[l], b_gate[l],
                        w_up[l], b_up[l], w_down[l], b_down[l])
    return rms_norm(h, norm_final)
```

```cpp
#include <hip/hip_runtime.h>
#include <cstdint>
#include <cstdio>

typedef unsigned short bf16_t;
typedef short bf16x8 __attribute__((ext_vector_type(8)));
typedef short s16x4 __attribute__((ext_vector_type(4)));
typedef float f32x4 __attribute__((ext_vector_type(4)));
typedef float f32x16 __attribute__((ext_vector_type(16)));
typedef unsigned u32x4 __attribute__((ext_vector_type(4)));
typedef unsigned u32x2 __attribute__((ext_vector_type(2)));
typedef float f32x2 __attribute__((ext_vector_type(2)));
#define LAS __attribute__((address_space(3)))
#define GAS __attribute__((address_space(1)))

constexpr int DM = 2048, SEQ = 4096, NTOK = 8192, NHEAD = 16, HDIM = 128, NEXP = 32, INC = 16384;
constexpr float NORM_EPS = 1e-5f;
constexpr int N_PHASES = 10;
#ifndef PROBE_REP
#define PROBE_REP -1
#endif
#ifndef PROBE_ABL
#define PROBE_ABL 0
#endif
#ifndef G_DMAPOS
#define G_DMAPOS 2
#endif
#ifndef G_BT
#define G_BT 1
#endif
#ifndef G_PRIO
#define G_PRIO 1
#endif
#ifndef MK_FUSED
#define MK_FUSED 1
#endif

constexpr size_t MiB = 1u << 20;
constexpr size_t WS_CTL = 0, CTL_BYTES = 1 * MiB;
constexpr size_t WS_ROPE = 1 * MiB;
constexpr size_t WS_KMSUM = 256 * 1024;
constexpr size_t WS_SB = 36 * MiB;
constexpr size_t WS_SLOT = 2 * MiB;
constexpr size_t WS_TOKW = 2 * MiB + 128 * 1024;
constexpr size_t WS_EROWS = 2 * MiB + 256 * 1024;
constexpr size_t WS_XN = 4 * MiB;
constexpr size_t WS_BG = 36 * MiB, WS_CG = 68 * MiB, WS_HC = 100 * MiB, WS_GC = 132 * MiB, WS_GA = 164 * MiB;
constexpr size_t WS_Q = 196 * MiB, WS_K = 228 * MiB, WS_V = 260 * MiB;
constexpr size_t WS_CONV = 292 * MiB, WS_ATT = 324 * MiB, WS_MRG = 356 * MiB;
constexpr size_t WS_H1 = 388 * MiB;
constexpr size_t WS_HID = 452 * MiB;
constexpr size_t WS_YB = 612 * MiB;
constexpr size_t WS_W16IN = 772 * MiB;
constexpr size_t WS_W16C = 836 * MiB, WS_W16A = 844 * MiB, WS_W16O = 852 * MiB;
constexpr size_t WS_END = 860 * MiB;
constexpr int CW_BAR = 4096;
constexpr int CW_CNT = 16384;

constexpr int LDS_MAIN = 131072;
constexpr int MISC_OFF = LDS_MAIN;
constexpr int LDS_BYTES = LDS_MAIN + 4096;

__device__ __forceinline__ unsigned cvtpk(float lo, float hi) { unsigned r; asm("v_cvt_pk_bf16_f32 %0, %1, %2" : "=v"(r) : "v"(lo), "v"(hi)); return r; }
__device__ __forceinline__ float bf_lo(unsigned w) { return __uint_as_float(w << 16); }
__device__ __forceinline__ float bf_hi(unsigned w) { return __uint_as_float(w & 0xffff0000u); }
__device__ __forceinline__ float wave_sum(float v) {
#pragma unroll
    for (int o = 1; o < 64; o <<= 1) v += __shfl_xor(v, o);
    return v;
}
__device__ __forceinline__ float fast_exp(float x) { return __builtin_amdgcn_exp2f(x * 1.4426950408889634f); }
__device__ __forceinline__ float sigmoidf_(float x) { return __builtin_amdgcn_rcpf(1.f + fast_exp(-x)); }

#define XB_TMO      128
#define XB_XCNT(j)  (256  + 64 * (j))
#define XB_XSUB(j)  (1280 + 64 * (j))
#define XB_XGEN(j)  (2304 + 64 * (j))
#define XB_TOP      3328
#define XB_TOPGEN   3392
#define XCD_BAR_WORDS 3456
#define XB_SPIN_CAP (1u << 18)
__device__ __forceinline__ unsigned xb_ld(unsigned* p)              { return __hip_atomic_load(p, __ATOMIC_RELAXED, __HIP_MEMORY_SCOPE_AGENT); }
__device__ __forceinline__ unsigned xb_add(unsigned* p, unsigned v) { return __hip_atomic_fetch_add(p, v, __ATOMIC_RELAXED, __HIP_MEMORY_SCOPE_AGENT); }
__device__ __forceinline__ unsigned xb_xcc_id() { return (unsigned)__builtin_amdgcn_s_getreg((3 << 11) | 20) & 0xFu; }
#define XB_SPIN(cond, bar) do { unsigned _sp = 0; while (cond) { __builtin_amdgcn_s_sleep(1); \
    if ((++_sp & 255u) == 0u) { if (xb_ld(&(bar)[XB_TMO])) break; if (_sp > XB_SPIN_CAP) { atomicAdd(&(bar)[XB_TMO], 1u); break; } } } } while (0)
struct XcdBarrier { unsigned* bar; volatile LAS unsigned* st; };
__device__ __forceinline__ XcdBarrier xcd_barrier_post(unsigned* bar, volatile LAS unsigned* st) {
    XcdBarrier b; b.bar = bar; b.st = st;
    if (threadIdx.x == 0) (void)xb_add(&bar[XB_XCNT(xb_xcc_id())], 1u);
    return b;
}
__device__ __forceinline__ void xcd_barrier_complete(unsigned* bar, unsigned x, unsigned& nloc, unsigned& nx) {
    const unsigned G = gridDim.x * gridDim.y * gridDim.z;
    unsigned sum, cnt, mine, sp = 0u;
    for (;;) {
        sum = 0u; cnt = 0u; mine = 0u;
#pragma unroll
        for (unsigned j = 0; j < 16; ++j) { const unsigned c = xb_ld(&bar[XB_XCNT(j)]); sum += c; cnt += (c > 0u) ? 1u : 0u; mine = (j == x) ? c : mine; }
        if (sum == G) break;
        __builtin_amdgcn_s_sleep(1);
        if ((++sp & 255u) == 0u) { if (xb_ld(&bar[XB_TMO])) break; if (sp > XB_SPIN_CAP) { atomicAdd(&bar[XB_TMO], 1u); break; } }
    }
    nloc = mine > 0u ? mine : 1u; nx = cnt > 0u ? cnt : 1u;
}
__device__ __forceinline__ void xcd_barrier(const XcdBarrier& b) {
    asm volatile("s_waitcnt vmcnt(0)" ::: "memory");
    __syncthreads();
    if (threadIdx.x == 0) {
        unsigned* bar = b.bar; const unsigned bx_ = xb_xcc_id();
        __builtin_amdgcn_s_waitcnt(0);
        unsigned nloc = b.st[0], nx = b.st[1];
        if (nloc == 0u) { xcd_barrier_complete(bar, bx_, nloc, nx); b.st[0] = nloc; b.st[1] = nx; }
        const unsigned old = xb_add(&bar[XB_XSUB(bx_)], 1u);
        const unsigned gen = old / nloc;
        if (old + 1u == (gen + 1u) * nloc) {
            __builtin_amdgcn_fence(__ATOMIC_RELEASE, "agent");
            asm volatile("s_waitcnt vmcnt(0)" ::: "memory");
            const unsigned og = xb_add(&bar[XB_TOP], 1u);
            const unsigned tg = og / nx;
            if (og + 1u == (tg + 1u) * nx) xb_add(&bar[XB_TOPGEN], 1u);
            else XB_SPIN(xb_ld(&bar[XB_TOPGEN]) == tg, bar);
            __builtin_amdgcn_fence(__ATOMIC_ACQUIRE, "agent");
            xb_add(&bar[XB_XGEN(bx_)], 1u);
            asm volatile("s_waitcnt vmcnt(0)" ::: "memory");
        } else {
            XB_SPIN(xb_ld(&bar[XB_XGEN(bx_)]) == gen, bar);
            __builtin_amdgcn_fence(__ATOMIC_ACQUIRE, "agent");
            asm volatile("s_waitcnt vmcnt(0)" ::: "memory");
        }
    }
    __syncthreads();
}

namespace gm {
constexpr int HTB = 16384, SB0 = 65536, NT = 32;
__device__ __forceinline__ int lds_byte(int r, int c) { const int st = (r >> 4) * 2 + (c >> 5), rr = r & 15, cc = c & 31, ob = rr * 64 + cc * 2; return st * 1024 + (ob ^ (((ob >> 9) & 1) << 5)); }
__device__ __forceinline__ void stage_rc(int b, int& R, int& C) { const int st = b / 1024, sb = b % 1024, swz = sb ^ (((sb >> 9) & 1) << 5); R = (st >> 1) * 16 + swz / 64; C = (st & 1) * 32 + (swz % 64) / 2; }
__device__ __forceinline__ int inv_perm32(int q) { return 16 * ((q >> 2) & 1) + 4 * (q >> 3) + (q & 3); }
__device__ __forceinline__ int perm32(int rho) { const int n = rho >> 4, i = rho & 15; return 8 * (i >> 2) + 4 * n + (i & 3); }
__device__ __forceinline__ int bswz(int R) { return ((R >> 1) & 7) ^ ((R >> 4) & 1); }

typedef __amdgpu_buffer_rsrc_t rsrc_t;
__device__ __forceinline__ rsrc_t mk_rsrc(const void* base, unsigned bytes) { return __builtin_amdgcn_make_buffer_rsrc((void*)base, 0, bytes, 0x00020000); }

struct Unit {
    unsigned aS;
    unsigned bS0;
    int pm;
    int code;
    __device__ __forceinline__ int pn() const { return code & 255; }
    __device__ __forceinline__ int e() const { return (code >> 8) & 255; }
    __device__ __forceinline__ int aux() const { return (code >> 16) & 255; }
    __device__ __forceinline__ int keep() const { return (code >> 24) & 1; }
};
__device__ __forceinline__ int mk_code(int pn, int e, int aux, int keep) { return pn | (e << 8) | (aux << 16) | (keep << 24); }

template <class P, int ABL = 0>
__device__ __forceinline__ void gemm_stream(LAS unsigned char* lds, const P& S) {
    const int tid = threadIdx.x, wid = __builtin_amdgcn_readfirstlane(tid >> 6), lane = tid & 63;
    const int wr = wid >> 2, wc = wid & 3, fr = lane & 15, fq = lane >> 4;
    constexpr unsigned LDB4 = (unsigned)P::LDB * 4u;
    constexpr unsigned TSTEP = 64u * LDB4;
    int R0, C0, R1, C1; stage_rc(tid * 16, R0, C0); stage_rc(tid * 16 + 8192, R1, C1);
    const unsigned ldsw = (unsigned)wid * 1024u;
    const int aoff = lds_byte(wr * 64 + fr, fq * 8);
    const int bquad = (lane & 7) + 8 * (lane >> 4), bpar = (lane >> 3) & 1;
    unsigned bw0;
    { const int q = 4 * bquad; const int R = P::PERM ? ((q & ~31) + inv_perm32(q & 31)) : q; bw0 = (unsigned)(SB0 + R * 128 + ((wid ^ bswz(R)) << 4) + bpar * 8); }
    const unsigned brow = (unsigned)(SB0 + (wc * 32 + fr) * 128 + ((fq ^ (fr >> 1)) << 4));
    const unsigned boffs = (unsigned)(8 * wid + 4 * bpar) * LDB4 + (unsigned)bquad * 16u;
    constexpr bool B16 = P::B16;
    constexpr unsigned LDB2 = (unsigned)P::LDB * 2u, TSTEP16 = 64u * LDB2;
    const int boct = (lane & 7) + 8 * (lane >> 4);
    const unsigned boffs16 = (unsigned)(8 * wid + 4 * bpar) * LDB2 + (unsigned)boct * 16u;
    const unsigned bw16 = P::PERM ? (unsigned)(SB0 + 4096 * (boct >> 2) + 512 * (boct & 3) + (((wid ^ (2 * (boct & 3)) ^ ((boct >> 2) & 1)) & 7) << 4) + bpar * 8)
                                  : (unsigned)(SB0 + 1024 * boct + (((wid ^ (4 * (boct & 1)) ^ (2 * ((boct >> 1) & 1)) ^ ((boct >> 2) & 1)) & 7) << 4) + bpar * 8);
    const unsigned brow16 = brow ^ (unsigned)((wc & 1) << 4);
    const rsrc_t rA = S.adesc();
    constexpr bool BT = P::BT;
    const int boffT = lds_byte(wc * 32 + fr, fq * 8);
    const unsigned vb = (unsigned)((P::PERM ? ((R0 & ~31) + perm32(R0 & 31)) : R0) * 4096 + C0 * 2);

#define G_SA(b, h) (((b) * 2 + (h)) * HTB)
#define G_DMA(bufoff, soff, o) do { if (ABL != 3) __builtin_amdgcn_raw_ptr_buffer_load_lds(rA, (LAS void*)(lds + (bufoff) + ldsw), 16, (o), (soff), 0, 0); } while (0)
#define G_VO(h, i) (P::GATHER ? vo[2 * (h) + (i)] : vo[0])
#define G_SO(soff, h, i) (P::GATHER ? (soff) : (soff) + (unsigned)(128 * (h) + 64 * (i)) * (unsigned)P::LDA2)
#define G_DMAP(b, h, i, soff) G_DMA(G_SA(b, h) + 8192 * (i), G_SO(soff, h, i), G_VO(h, i))
#define G_LDA(dst, b, h) do { if (ABL == 4) { _Pragma("unroll") for (int m = 0; m < 4; ++m) _Pragma("unroll") for (int k = 0; k < 2; ++k) asm volatile("" : "+v"(dst[m][k])); break; } _Pragma("unroll") for (int m = 0; m < 4; ++m) _Pragma("unroll") for (int k = 0; k < 2; ++k) dst[m][k] = *(const LAS bf16x8*)(lds + G_SA(b, h) + aoff + m * 2048 + k * 1024); } while (0)
#define G_LDB(dst, b, bj) do { if (ABL == 4) { _Pragma("unroll") for (int n = 0; n < 2; ++n) _Pragma("unroll") for (int k = 0; k < 2; ++k) asm volatile("" : "+v"(dst[n][k])); break; } _Pragma("unroll") for (int n = 0; n < 2; ++n) _Pragma("unroll") for (int k = 0; k < 2; ++k) dst[n][k] = *(const LAS bf16x8*)(lds + ((brow ^ (unsigned)((k << 6) | (n << 4))) + n * 2048 + (bj) * 16384 + (b) * 32768)); } while (0)
#define G_MMA(ai, bj, At, Bt, DMA_STMT) do { if (ABL == 1) { _Pragma("unroll") for (int m = 0; m < 4; ++m) _Pragma("unroll") for (int k = 0; k < 2; ++k) asm volatile("" :: "v"(At[m][k])); _Pragma("unroll") for (int n = 0; n < 2; ++n) _Pragma("unroll") for (int k = 0; k < 2; ++k) asm volatile("" :: "v"(Bt[n][k])); DMA_STMT; break; } \
        if (G_PRIO == 1) __builtin_amdgcn_s_setprio(1); \
        _Pragma("unroll") for (int m = 0; m < 2; ++m) _Pragma("unroll") for (int n = 0; n < 2; ++n) _Pragma("unroll") for (int k = 0; k < 2; ++k) acc[ai][bj][m][n] = __builtin_amdgcn_mfma_f32_16x16x32_bf16(Bt[n][k], At[m][k], acc[ai][bj][m][n], 0, 0, 0); \
        G_SCHED; DMA_STMT; G_SCHED; \
        _Pragma("unroll") for (int m = 2; m < 4; ++m) _Pragma("unroll") for (int n = 0; n < 2; ++n) _Pragma("unroll") for (int k = 0; k < 2; ++k) acc[ai][bj][m][n] = __builtin_amdgcn_mfma_f32_16x16x32_bf16(Bt[n][k], At[m][k], acc[ai][bj][m][n], 0, 0, 0); \
        if (G_PRIO == 1) __builtin_amdgcn_s_setprio(0); } while (0)
#define G_DMAB(bufoff, desc, soff) __builtin_amdgcn_raw_ptr_buffer_load_lds((desc), (LAS void*)(lds + (bufoff) + ldsw), 16, vb, (soff), 0, 0)
#define G_STB(b, bj, desc, so) do { const rsrc_t _d = (desc); const unsigned _s = (so) + (unsigned)(bj) * 524288u; G_DMAB(SB0 + (b) * 32768 + (bj) * 16384, _d, _s); G_DMAB(SB0 + (b) * 32768 + (bj) * 16384 + 8192, _d, _s + 262144u); } while (0)
#define G_STA(b, h, so) do { G_DMAP(b, h, 0, so); G_DMAP(b, h, 1, so); } while (0)
#define G_LDBT(dst, b, bj) do { _Pragma("unroll") for (int n = 0; n < 2; ++n) _Pragma("unroll") for (int k = 0; k < 2; ++k) dst[n][k] = *(const LAS bf16x8*)(lds + SB0 + (b) * 32768 + (bj) * 16384 + boffT + n * 2048 + k * 1024); } while (0)
#define G_WAIT_V0 asm volatile("s_waitcnt vmcnt(0)" ::: "memory")
#define G_WAIT_L0 asm volatile("s_waitcnt lgkmcnt(0)" ::: "memory")
#define G_WAIT_B(first) do { if (first) asm volatile("; first load segment of a unit (peel: its counted wait may leave the epilogue's stores in flight)" ::: "memory"); } while (0)
#define G_BAR __builtin_amdgcn_s_barrier()
#define G_SCHED __builtin_amdgcn_sched_barrier(0)
#define G_BLOAD(desc, soff) do { if (ABL == 2) { asm volatile("" : "+v"(br[0]), "+v"(br[1]), "+v"(br[2]), "+v"(br[3])); break; } const rsrc_t _d = (desc); const unsigned _s = (soff); _Pragma("unroll") for (int i = 0; i < 4; ++i) br[i] = __builtin_amdgcn_raw_buffer_load_b128(_d, boffs, _s + (unsigned)i * LDB4, 0); } while (0)
#define G_LDB16(dst, b, bj) do { _Pragma("unroll") for (int n = 0; n < 2; ++n) _Pragma("unroll") for (int k = 0; k < 2; ++k) dst[n][k] = *(const LAS bf16x8*)(lds + ((brow16 ^ (unsigned)((k << 6) | (n << (P::PERM ? 4 : 5)))) + n * 2048 + (bj) * 16384 + (b) * 32768)); } while (0)
#define G_BLOAD16(desc, soff) do { const rsrc_t _d = (desc); const unsigned _s = (soff); _Pragma("unroll") for (int i = 0; i < 4; ++i) br[i] = __builtin_amdgcn_raw_buffer_load_b128(_d, boffs16, _s + (unsigned)i * LDB2, 0); } while (0)
#define G_BWRITE16(b) do { _Pragma("unroll") for (int c = 0; c < 8; ++c) { const unsigned sel_ = (c & 1) ? 0x07060302u : 0x05040100u; u32x2 w_; \
        w_.x = __builtin_amdgcn_perm(br[1][c >> 1], br[0][c >> 1], sel_); w_.y = __builtin_amdgcn_perm(br[3][c >> 1], br[2][c >> 1], sel_); \
        const unsigned ad_ = P::PERM ? ((bw16 ^ (unsigned)(((((c >> 1) & 1) ^ (c >> 2)) & 1) << 4)) + 2048u * (c >> 2) + 128u * (c & 3)) : ((bw16 ^ (unsigned)((c >> 1) << 4)) + 128u * c); \
        *(LAS u32x2*)(lds + ad_ + (b) * 32768) = w_; } } while (0)
#define G_WAITV(n) asm volatile("s_waitcnt vmcnt(" #n ")" ::: "memory")
#define G_F(x) __uint_as_float(x)
#define G_BWRITE(b, bj) do { if (ABL == 5) break; _Pragma("unroll") for (int j = 0; j < 4; ++j) { u32x2 w_; w_.x = cvtpk(G_F(br[0][j]), G_F(br[1][j])); w_.y = cvtpk(G_F(br[2][j]), G_F(br[3][j])); \
        *(LAS u32x2*)(lds + (bw0 ^ (unsigned)((j >> 1) << 4)) + j * 128 + (bj) * 16384 + (b) * 32768) = w_; } } while (0)

    Unit cur, nxt; int ui = 0;
    if (!S.next(0, cur)) return;
    f32x4 acc[2][2][4][2];
#pragma unroll
    for (int a = 0; a < 2; ++a)
#pragma unroll
        for (int b = 0; b < 2; ++b)
#pragma unroll
            for (int m = 0; m < 4; ++m)
#pragma unroll
                for (int n = 0; n < 2; ++n) acc[a][b][m][n] = (f32x4){0.f, 0.f, 0.f, 0.f};
    bf16x8 At[4][2], Bf0[2][2], Bf1[2][2];
    u32x4 br[4];
    unsigned vo[4];
    S.aoff(cur, vo, R0, C0, R1, C1);
    if constexpr (BT) {
    { const rsrc_t rB = S.bdesc(cur.aux(), 0);
      G_STB(0, 0, rB, cur.bS0); G_STB(0, 1, rB, cur.bS0); G_STA(0, 0, cur.aS); G_STA(0, 1, cur.aS);
      G_STB(1, 0, rB, cur.bS0 + 128u); G_STA(1, 0, cur.aS + 128u); G_STB(1, 1, rB, cur.bS0 + 128u); }
    G_WAITV(6); G_BAR;
    if (wr == 1) G_BAR;
    } else if constexpr (B16) {
    G_BLOAD16(S.bdesc(cur.aux(), 0), cur.bS0);
    G_DMAP(0, 0, 0, cur.aS); G_DMAP(0, 0, 1, cur.aS); G_DMAP(0, 1, 0, cur.aS); G_DMAP(0, 1, 1, cur.aS);
    G_WAIT_V0; G_BWRITE16(0); G_SCHED;
    G_BLOAD16(S.bdesc(cur.aux(), 0), cur.bS0 + TSTEP16); G_WAIT_V0; G_BWRITE16(1); G_SCHED;
    G_BLOAD16(S.bdesc(cur.aux(), 0), cur.bS0 + 2u * TSTEP16);
    G_DMAP(1, 0, 0, cur.aS + 128u); G_DMAP(1, 0, 1, cur.aS + 128u);
    G_WAIT_L0; G_BAR;
    if (wr == 1) G_BAR;
    } else {
    G_BLOAD(S.bdesc(cur.aux(), 0), cur.bS0);
    G_DMAP(0, 0, 0, cur.aS); G_DMAP(0, 0, 1, cur.aS); G_DMAP(0, 1, 0, cur.aS); G_DMAP(0, 1, 1, cur.aS);
    G_WAIT_B(true); G_BWRITE(0, 0); G_SCHED;
    G_BLOAD(S.bdesc(cur.aux(), 1), cur.bS0 + P::B1OFF); G_WAIT_B(true); G_BWRITE(0, 1); G_SCHED;
    G_BLOAD(S.bdesc(cur.aux(), 0), cur.bS0 + TSTEP); G_WAIT_B(true); G_BWRITE(1, 0); G_SCHED;
    G_BLOAD(S.bdesc(cur.aux(), 1), cur.bS0 + P::B1OFF + TSTEP);
    G_DMAP(1, 0, 0, cur.aS + 128u); G_DMAP(1, 0, 1, cur.aS + 128u);
    G_WAIT_L0; G_BAR;
    if (wr == 1) G_BAR;
    }
    for (;;) {
        const bool has_next = S.next(ui + 1, nxt);
        if (!has_next) nxt = cur;
        if constexpr (BT) {
        for (int t = 0; t < NT; t += 2) {
            const bool last = (t == NT - 2);
            const unsigned a1 = cur.aS + (unsigned)(t + 1) * 128u;
            const unsigned a2 = last ? nxt.aS : cur.aS + (unsigned)(t + 2) * 128u;
            const unsigned a3 = a2 + 128u;
            const unsigned b2 = last ? nxt.bS0 : cur.bS0 + (unsigned)(t + 2) * 128u;
            const unsigned b3 = b2 + 128u;
            const int bsl = last ? nxt.aux() : cur.aux();
            G_LDBT(Bf0, 0, 0); G_LDBT(Bf1, 0, 1); G_SCHED; G_LDA(At, 0, 0); G_SCHED; G_STA(1, 1, a1);
            G_WAITV(8); G_WAIT_L0; G_BAR; G_MMA(0, 0, At, Bf0, (void)0); G_MMA(0, 1, At, Bf1, (void)0); G_BAR; G_SCHED;
            G_LDA(At, 0, 1); G_SCHED; G_STB(0, 0, S.bdesc(bsl, 0), b2); G_STB(0, 1, S.bdesc(bsl, 0), b2); G_STA(0, 0, a2);
            G_WAITV(8); G_WAIT_L0; G_BAR; G_MMA(1, 0, At, Bf0, (void)0); G_MMA(1, 1, At, Bf1, (void)0); G_BAR; G_SCHED;
            G_LDBT(Bf0, 1, 0); G_LDBT(Bf1, 1, 1); G_SCHED; G_LDA(At, 1, 0); G_SCHED; G_STA(0, 1, a2);
            G_WAITV(8); G_WAIT_L0; G_BAR; G_MMA(0, 0, At, Bf0, (void)0); G_MMA(0, 1, At, Bf1, (void)0); G_BAR; G_SCHED;
            G_LDA(At, 1, 1); G_SCHED; G_STB(1, 0, S.bdesc(bsl, 0), b3); G_STB(1, 1, S.bdesc(bsl, 0), b3); G_STA(1, 0, a3);
            G_WAITV(8); G_WAIT_L0; G_BAR; G_MMA(1, 0, At, Bf0, (void)0); G_MMA(1, 1, At, Bf1, (void)0); G_BAR; G_SCHED;
        }
        } else if constexpr (B16) {
        for (int t = 0; t < NT; t += 2) {
            const bool last = (t == NT - 2), nx4 = (t + 4 >= NT);
            const unsigned a1 = cur.aS + (unsigned)(t + 1) * 128u;
            const unsigned a2 = last ? nxt.aS : cur.aS + (unsigned)(t + 2) * 128u;
            const unsigned a3 = a2 + 128u;
            const unsigned b3 = last ? nxt.bS0 + TSTEP16 : cur.bS0 + (unsigned)(t + 3) * TSTEP16;
            const unsigned b4 = nx4 ? nxt.bS0 + (unsigned)(t + 4 - NT) * TSTEP16 : cur.bS0 + (unsigned)(t + 4) * TSTEP16;
            const int sel3 = last ? nxt.aux() : cur.aux(), sel4 = nx4 ? nxt.aux() : cur.aux();
#define G_DL0(b, h, so) do { if (G_DMAPOS >= 1) G_DMAP(b, h, 0, so); } while (0)
#define G_DL1(b, h, so) do { if (G_DMAPOS == 1) G_DMAP(b, h, 1, so); } while (0)
#define G_DM0(b, h, so) do { if (G_DMAPOS == 0) G_DMAP(b, h, 0, so); } while (0)
#define G_DM1(b, h, so) do { if (G_DMAPOS != 1) G_DMAP(b, h, 1, so); } while (0)
            G_WAITV(6); G_LDB16(Bf0, 0, 0); G_LDB16(Bf1, 0, 1); G_SCHED; G_LDA(At, 0, 0); G_SCHED; G_DL0(1, 1, a1); G_DL1(1, 1, a1);
            G_WAIT_L0; G_BAR; G_MMA(0, 0, At, Bf0, G_DM0(1, 1, a1)); G_MMA(0, 1, At, Bf1, G_DM1(1, 1, a1)); G_BAR; G_SCHED;
            G_WAITV(2); G_BWRITE16(0); G_SCHED; G_BLOAD16(S.bdesc(sel3, 0), b3); G_SCHED;
            G_LDA(At, 0, 1); G_SCHED; G_DL0(0, 0, a2); G_DL1(0, 0, a2);
            G_WAIT_L0; G_BAR; G_MMA(1, 0, At, Bf0, G_DM0(0, 0, a2)); G_MMA(1, 1, At, Bf1, G_DM1(0, 0, a2)); G_BAR; G_SCHED;
            G_WAITV(6); G_LDB16(Bf0, 1, 0); G_LDB16(Bf1, 1, 1); G_SCHED; G_LDA(At, 1, 0); G_SCHED; G_DL0(0, 1, a2); G_DL1(0, 1, a2);
            G_WAIT_L0; G_BAR; G_MMA(0, 0, At, Bf0, G_DM0(0, 1, a2)); G_MMA(0, 1, At, Bf1, G_DM1(0, 1, a2)); G_BAR; G_SCHED;
            G_WAITV(2); G_BWRITE16(1); G_SCHED; G_BLOAD16(S.bdesc(sel4, 0), b4); G_SCHED;
            G_LDA(At, 1, 1); G_SCHED; G_DL0(1, 0, a3); G_DL1(1, 0, a3);
            G_WAIT_L0; G_BAR; G_MMA(1, 0, At, Bf0, G_DM0(1, 0, a3)); G_MMA(1, 1, At, Bf1, G_DM1(1, 0, a3)); G_BAR; G_SCHED;
#undef G_DL0
#undef G_DL1
#undef G_DM0
#undef G_DM1
        }
        } else {
        for (int t = 0; t < NT; t += 2) {
            const bool last = (t == NT - 2);
            const unsigned a1 = cur.aS + (unsigned)(t + 1) * 128u;
            const unsigned a2 = last ? nxt.aS : cur.aS + (unsigned)(t + 2) * 128u;
            const unsigned a3 = a2 + 128u;
            const unsigned b20 = last ? nxt.bS0 : cur.bS0 + (unsigned)(t + 2) * TSTEP;
            const unsigned b21 = b20 + P::B1OFF;
            const int bsl = last ? nxt.aux() : cur.aux();
            G_WAIT_B(t == 0); G_BWRITE(1, 1); G_SCHED; G_BLOAD(S.bdesc(bsl, 0), b20); G_SCHED;
            G_LDB(Bf0, 0, 0); G_SCHED; G_LDA(At, 0, 0);
            G_WAIT_L0; G_BAR; G_LDB(Bf1, 0, 1); G_SCHED; G_MMA(0, 0, At, Bf0, G_DMAP(1, 1, 0, a1)); G_MMA(0, 1, At, Bf1, G_DMAP(1, 1, 1, a1)); G_BAR; G_SCHED;
            if (P::GATHER) { if (last) { int tz = threadIdx.x; asm volatile("" : "+v"(tz)); int r0, c0, r1, c1; stage_rc(tz * 16, r0, c0); stage_rc(tz * 16 + 8192, r1, c1); S.aoff(nxt, vo, r0, c0, r1, c1); } }
            G_WAIT_B(P::GATHER && last); G_BWRITE(0, 0); G_SCHED; G_BLOAD(S.bdesc(bsl, 1), b21); G_SCHED;
            G_LDA(At, 0, 1); G_SCHED;
            G_WAIT_L0; G_BAR; G_MMA(1, 0, At, Bf0, G_DMAP(0, 0, 0, a2)); G_MMA(1, 1, At, Bf1, G_DMAP(0, 0, 1, a2)); G_BAR; G_SCHED;
            G_WAIT_B(false); G_BWRITE(0, 1); G_SCHED; G_BLOAD(S.bdesc(bsl, 0), b20 + TSTEP); G_SCHED;
            G_LDB(Bf0, 1, 0); G_SCHED; G_LDA(At, 1, 0);
            G_WAIT_L0; G_BAR; G_LDB(Bf1, 1, 1); G_SCHED; G_MMA(0, 0, At, Bf0, G_DMAP(0, 1, 0, a2)); G_MMA(0, 1, At, Bf1, G_DMAP(0, 1, 1, a2)); G_BAR; G_SCHED;
            G_WAIT_B(false); G_BWRITE(1, 0); G_SCHED; G_BLOAD(S.bdesc(bsl, 1), b21 + TSTEP); G_SCHED;
            G_LDA(At, 1, 1); G_SCHED;
            G_WAIT_L0; G_BAR; G_MMA(1, 0, At, Bf0, G_DMAP(1, 0, 0, a3)); G_MMA(1, 1, At, Bf1, G_DMAP(1, 0, 1, a3)); G_BAR; G_SCHED;
        }
        }
        if (wr == 0) G_BAR;
        if (ABL == 0) S.epi(acc, cur, wr, wc, fr, fq);
        else {
#pragma unroll
            for (int a = 0; a < 2; ++a)
#pragma unroll
                for (int b = 0; b < 2; ++b)
#pragma unroll
                    for (int m = 0; m < 4; ++m)
#pragma unroll
                        for (int n = 0; n < 2; ++n) asm volatile("" :: "v"(acc[a][b][m][n]));
        }
        if (!cur.keep()) {
#pragma unroll
            for (int a = 0; a < 2; ++a)
#pragma unroll
                for (int b = 0; b < 2; ++b)
#pragma unroll
                    for (int m = 0; m < 4; ++m)
#pragma unroll
                        for (int n = 0; n < 2; ++n) acc[a][b][m][n] = (f32x4){0.f, 0.f, 0.f, 0.f};
        }
        if (!has_next) break;
        cur = nxt;
        ++ui;
        if (wr == 1) G_BAR;
    }
    G_WAIT_V0;
    asm volatile("" :: "v"(br[0]), "v"(br[1]), "v"(br[2]), "v"(br[3]));
    G_BAR;
#undef G_SA
#undef G_STAGE
#undef G_DMA
#undef G_DMAP
#undef G_VO
#undef G_SO
#undef G_WAIT_B
#undef G_LDA
#undef G_LDB
#undef G_MMA
#undef G_WAIT_V0
#undef G_WAIT_L0
#undef G_BAR
#undef G_SCHED
#undef G_BLOAD
#undef G_DMAB
#undef G_STB
#undef G_STA
#undef G_LDBT
#undef G_BLOAD16
#undef G_BWRITE16
#undef G_LDB16
#undef G_WAITV
#undef G_BWRITE
#undef G_F
}

__device__ __forceinline__ bool static_tile(int L, int nM, int nN, int& pm, int& pn) {
    const int nwg = nM * nN; if (L >= nwg) return false;
    int wgid = L; { const int q = nwg / 8, r = nwg % 8, xcd = wgid % 8, off = wgid / 8; wgid = (xcd < r ? xcd * (q + 1) : r * (q + 1) + (xcd - r) * q) + off; }
    const int nig = 8 * nN, gid = wgid / nig, fm = gid * 8, gsz = (nM - fm) < 8 ? (nM - fm) : 8;
    pm = fm + ((wgid % nig) % gsz); pn = (wgid % nig) / gsz; return true;
}
__device__ __forceinline__ void plain_aoff(unsigned (&v)[4], int lda2, int R0, int C0, int R1, int C1) {
    v[0] = (unsigned)(R0 * lda2 + C0 * 2); v[1] = (unsigned)(R1 * lda2 + C1 * 2);
    v[2] = (unsigned)((128 + R0) * lda2 + C0 * 2); v[3] = (unsigned)((128 + R1) * lda2 + C1 * 2);
}
}

__device__ __forceinline__ int in_rowmap(int col) {
    const int g = col >> 11, c = col & 2047;
    if (g == 3 || g == 4 || g == 5 || g == 7) { const int gi = g == 7 ? 3 : g - 3; return (32 + gi * 8 + (c >> 8)) * 256 + (c & 255); }
    const int pn = c >> 6, ch = c & 63, bj = (g == 2 || g == 6) ? 1 : 0, n = (g == 1 || g == 6) ? 1 : 0;
    return pn * 256 + 128 * bj + 32 * (ch >> 4) + 8 * ((ch >> 2) & 3) + 4 * n + (ch & 3);
}
template <bool MAPIN = false>
__device__ __forceinline__ void p0_transpose_item(const float* W, int N, bf16_t* WT, LAS float* scr, int item, int lane) {
    const int nblk = N / 32, kb = item / nblk, nb = item % nblk, k0 = 64 * kb, n0 = 32 * nb;
    const GAS float* Wg = (const GAS float*)W;
#pragma unroll 8
    for (int i = 0; i < 32; ++i) { const int kk = 2 * i + (lane >> 5); scr[kk * 33 + (lane & 31)] = Wg[(size_t)(k0 + kk) * N + n0 + (lane & 31)]; }
    asm volatile("s_waitcnt lgkmcnt(0)" ::: "memory");
    const int c = lane & 7;
#pragma unroll
    for (int j = 0; j < 4; ++j) { const int n = (lane >> 3) + 8 * j; const LAS float* sp = scr + (8 * c) * 33 + n;
        u32x4 o; o.x = cvtpk(sp[0], sp[33]); o.y = cvtpk(sp[66], sp[99]); o.z = cvtpk(sp[132], sp[165]); o.w = cvtpk(sp[198], sp[231]);
        *(GAS u32x4*)(WT + (size_t)(MAPIN ? in_rowmap(n0 + n) : n0 + n) * 2048 + k0 + 8 * c) = o; }
    asm volatile("s_waitcnt lgkmcnt(0)" ::: "memory");
}

struct Params {
    const float* x; const float* norm_mix; const float* w_in; const float* conv_w; const float* w_conv_out; const float* w_attn_out; const float* w_o;
    const float* norm_ffn; const float* w_router; const float* b_router; const float* w_gate; const float* b_gate; const float* w_up; const float* b_up;
    const float* w_down; const float* b_down; const float* norm_final;
    float* out; unsigned char* ws;
    int ph_lo, ph_hi;
};

struct ProbIn {
    static constexpr bool B16 = true; static constexpr int LDA2 = 4096; static constexpr bool PERM = true, GATHER = false; static constexpr int LDB = INC; static constexpr unsigned B1OFF = 512; static constexpr bool BT = (G_BT != 0);
    const unsigned char* ws; const float* w_in; int G, c; LAS unsigned char* lds; const float* conv_w;
    __device__ __forceinline__ bool next(int i, gm::Unit& u) const {
        int pm, pn; if (!gm::static_tile(i * G + c, 32, 64, pm, pn)) return false;
        pm = __builtin_amdgcn_readfirstlane(pm); pn = __builtin_amdgcn_readfirstlane(pn);
        u.aS = (unsigned)(WS_XN + (size_t)pm * MiB); u.bS0 = G_BT ? ((unsigned)pn << 20) : (unsigned)pn * 512u; u.pm = pm; u.code = gm::mk_code(pn, 0, 0, 0); return true;
    }
    __device__ __forceinline__ gm::rsrc_t adesc() const { return gm::mk_rsrc(ws, (unsigned)WS_END); }
    __device__ __forceinline__ gm::rsrc_t bdesc(int, int) const { return gm::mk_rsrc(ws + WS_W16IN, 2048u * 16384u * 2u); }
    __device__ __forceinline__ void aoff(const gm::Unit&, unsigned (&v)[4], int R0, int C0, int R1, int C1) const { gm::plain_aoff(v, 4096, R0, C0, R1, C1); }
    __device__ __forceinline__ void epi(f32x4 (&acc)[2][2][4][2], const gm::Unit& u, int wr, int wc, int fr, int fq) const {
        const int row0 = u.pm * 256 + wr * 64 + fr;
        if (u.pn() < 32) {
            bf16_t* CONV = (bf16_t*)(ws + WS_CONV); bf16_t* GCb = (bf16_t*)(ws + WS_GC); float* SB = (float*)(ws + WS_SB) + (size_t)u.pm * (6 * 2048);
            const int chl = 16 * wc + 4 * fq, ch = 64 * u.pn() + chl;
            LAS float* halo = (LAS float*)(lds + MISC_OFF + 1024);
#pragma unroll
            for (int ai = 0; ai < 2; ++ai) {
                const f32x4 u3 = acc[ai][0][3][1] * acc[ai][1][3][0];
                if (fr >= 14) { *(LAS f32x4*)(halo + ((ai * 2 + wr) * 2 + (fr - 14)) * 64 + chl) = u3;
                    if (ai == 1 && wr == 1) *(GAS f32x4*)(SB + (fr - 14) * 2048 + ch) = u3; }
            }
            asm volatile("s_waitcnt lgkmcnt(0)" ::: "memory");
            __builtin_amdgcn_s_barrier();
            const f32x4 w0 = *(const GAS f32x4*)(conv_w + ch), w1 = *(const GAS f32x4*)(conv_w + 2048 + ch), w2 = *(const GAS f32x4*)(conv_w + 4096 + ch);
#pragma unroll
            for (int ai = 0; ai < 2; ++ai) {
                f32x4 h14 = {0.f, 0.f, 0.f, 0.f}, h15 = h14;
                if (wr == 1 || ai == 1) { const LAS float* hp = halo + ((wr == 1 ? ai * 2 : 1) * 2) * 64 + chl; h14 = *(const LAS f32x4*)hp; h15 = *(const LAS f32x4*)(hp + 64); }
                f32x4 prev = {0.f, 0.f, 0.f, 0.f};
#pragma unroll
                for (int m = 0; m < 4; ++m) {
                    const int row = row0 + ai * 128 + m * 16;
                    const f32x4 bg = acc[ai][0][m][0], uu = acc[ai][0][m][1] * acc[ai][1][m][0], gc = acc[ai][1][m][1];
                    f32x4 u1, u2;
#pragma unroll
                    for (int i = 0; i < 4; ++i) {
                        const float r1 = __int_as_float(__builtin_amdgcn_update_dpp(0, __float_as_int(uu[i]), 0x111, 0xf, 0xf, true));
                        const float r2 = __int_as_float(__builtin_amdgcn_update_dpp(0, __float_as_int(uu[i]), 0x112, 0xf, 0xf, true));
                        float p1, p2;
                        if (m == 0) { p1 = h15[i]; p2 = fr == 0 ? h14[i] : h15[i]; }
                        else { p1 = __int_as_float(__builtin_amdgcn_update_dpp(0, __float_as_int(prev[i]), 0x10f, 0xf, 0xf, true));
                               p2 = __int_as_float(__builtin_amdgcn_update_dpp(0, __float_as_int(prev[i]), 0x10e, 0xf, 0xf, true)); }
                        u1[i] = fr >= 1 ? r1 : p1; u2[i] = fr >= 2 ? r2 : p2;
                    }
                    const f32x4 y = bg * (w0 * u2 + w1 * u1 + w2 * uu);
                    u32x2 o; o.x = cvtpk(y[0], y[1]); o.y = cvtpk(y[2], y[3]);
                    *(GAS u32x2*)(CONV + (size_t)row * 2048 + ch) = o;
                    u32x2 g2; g2.x = cvtpk(gc[0], gc[1]); g2.y = cvtpk(gc[2], gc[3]);
                    *(GAS u32x2*)(GCb + (size_t)row * 2048 + ch) = g2;
                    if (ai == 0 && m == 0 && wr == 0 && fr < 2) { *(GAS f32x4*)(SB + (2 + 2 * fr) * 2048 + ch) = bg; *(GAS f32x4*)(SB + (3 + 2 * fr) * 2048 + ch) = uu; }
                    prev = uu;
                }
            }
            return;
        }
        const int q_ = u.pn() - 32, gi_ = q_ >> 3, grp = gi_ == 3 ? 7 : 3 + gi_, ct = q_ & 7;
        if (grp >= 3 && grp <= 5) {
            bf16_t* buf = (bf16_t*)(ws + (grp == 3 ? WS_Q : (grp == 4 ? WS_K : WS_V)));
            const bool rope = (grp != 5) && (wc == 0);
            const float* COS = (const float*)(ws + WS_ROPE); const float* SIN = COS + 4096 * 16;
#pragma unroll
            for (int ai = 0; ai < 2; ++ai)
#pragma unroll
                for (int m = 0; m < 4; ++m) {
                    const int row = row0 + ai * 128 + m * 16; const int b = row >> 12, s = row & 4095;
                    f32x4 c0 = {1.f, 1.f, 1.f, 1.f}, c1 = c0, s0 = {0.f, 0.f, 0.f, 0.f}, s1 = s0;
                    if (rope) { const GAS f32x4* cp = (const GAS f32x4*)(COS + s * 16 + 8 * (fq & 1)); const GAS f32x4* sp = (const GAS f32x4*)(SIN + s * 16 + 8 * (fq & 1));
                        c0 = cp[0]; c1 = cp[1]; s0 = sp[0]; s1 = sp[1]; if (fq < 2) { s0 = -s0; s1 = -s1; } }
#pragma unroll
                    for (int bj = 0; bj < 2; ++bj) {
                        f32x4 v0 = acc[ai][bj][m][0], v1 = acc[ai][bj][m][1];
                        if (rope) {
                            f32x4 p0, p1;
#pragma unroll
                            for (int i = 0; i < 4; ++i) { p0[i] = __shfl_xor(v0[i], 32); p1[i] = __shfl_xor(v1[i], 32); }
                            v0 = v0 * c0 + p0 * s0; v1 = v1 * c1 + p1 * s1;
                        }
                        const int head = ct * 2 + bj;
                        u32x4 w; w.x = cvtpk(v0[0], v0[1]); w.y = cvtpk(v0[2], v0[3]); w.z = cvtpk(v1[0], v1[1]); w.w = cvtpk(v1[2], v1[3]);
                        *(GAS u32x4*)(buf + ((size_t)((b * 16 + head) * 4096 + s)) * 128 + wc * 32 + 8 * fq) = w;
                    }
                }
            if (grp == 4) {
                f32x4 ks[2][2] = {{{0.f, 0.f, 0.f, 0.f}, {0.f, 0.f, 0.f, 0.f}}, {{0.f, 0.f, 0.f, 0.f}, {0.f, 0.f, 0.f, 0.f}}};
#pragma unroll 1
                for (int am = 0; am < 8; ++am) {
                    const int ai = am >> 2, m = am & 3; const int row = row0 + ai * 128 + m * 16; const int s = row & 4095;
                    f32x4 c0 = {1.f, 1.f, 1.f, 1.f}, c1 = c0, s0 = {0.f, 0.f, 0.f, 0.f}, s1 = s0;
                    if (rope) { const GAS f32x4* cp = (const GAS f32x4*)(COS + s * 16 + 8 * (fq & 1)); const GAS f32x4* sp = (const GAS f32x4*)(SIN + s * 16 + 8 * (fq & 1));
                        c0 = cp[0]; c1 = cp[1]; s0 = sp[0]; s1 = sp[1]; if (fq < 2) { s0 = -s0; s1 = -s1; } }
#pragma unroll
                    for (int bj = 0; bj < 2; ++bj) {
                        f32x4 v0, v1;
                        switch (am) {
#define KS_ARM(A, M) case (A) * 4 + (M): v0 = acc[A][bj][M][0]; v1 = acc[A][bj][M][1]; break;
                            KS_ARM(0, 0) KS_ARM(0, 1) KS_ARM(0, 2) KS_ARM(0, 3) KS_ARM(1, 0) KS_ARM(1, 1) KS_ARM(1, 2) default: v0 = acc[1][bj][3][0]; v1 = acc[1][bj][3][1]; break;
#undef KS_ARM
                        }
                        if (rope) { f32x4 p0, p1;
#pragma unroll
                            for (int i = 0; i < 4; ++i) { p0[i] = __shfl_xor(v0[i], 32); p1[i] = __shfl_xor(v1[i], 32); }
                            v0 = v0 * c0 + p0 * s0; v1 = v1 * c1 + p1 * s1; }
                        ks[bj][0] += v0; ks[bj][1] += v1;
                    }
                }
                float* KS = (float*)(ws + WS_KMSUM) + ((size_t)(((u.pm >> 4) * 16 + ct * 2) * 16 + (u.pm & 15))) * 128 + wc * 32 + 8 * fq;
#pragma unroll
                for (int bj = 0; bj < 2; ++bj)
#pragma unroll
                    for (int h = 0; h < 2; ++h)
#pragma unroll
                        for (int i = 0; i < 4; ++i) { float t = ks[bj][h][i];
                            t += __shfl_xor(t, 1); t += __shfl_xor(t, 2); t += __shfl_xor(t, 4); t += __shfl_xor(t, 8);
                            if (fr == 0) (void)__hip_atomic_fetch_add(KS + (size_t)bj * 16 * 128 + 4 * h + i, t, __ATOMIC_RELAXED, __HIP_MEMORY_SCOPE_AGENT); }
            }
        } else {
            const size_t off = WS_GA;
            bf16_t* buf = (bf16_t*)(ws + off);
#pragma unroll
            for (int ai = 0; ai < 2; ++ai)
#pragma unroll
                for (int m = 0; m < 4; ++m) {
                    const int row = row0 + ai * 128 + m * 16;
#pragma unroll
                    for (int bj = 0; bj < 2; ++bj) {
                        const f32x4 v0 = acc[ai][bj][m][0], v1 = acc[ai][bj][m][1];
                        u32x4 w; w.x = cvtpk(v0[0], v0[1]); w.y = cvtpk(v0[2], v0[3]); w.z = cvtpk(v1[0], v1[1]); w.w = cvtpk(v1[2], v1[3]);
                        *(GAS u32x4*)(buf + (size_t)row * 2048 + ct * 256 + bj * 128 + wc * 32 + 8 * fq) = w;
                    }
                }
        }
    }
};

struct ProbMerge {
    static constexpr bool B16 = true; static constexpr int LDA2 = 4096; static constexpr bool PERM = true, GATHER = false; static constexpr int LDB = 2048; static constexpr unsigned B1OFF = 512; static constexpr bool BT = (G_BT != 0);
    const unsigned char* ws; const float* wc_out; const float* wa_out; int G, c;
    __device__ __forceinline__ bool next(int i, gm::Unit& u) const {
        int pm, pn; if (!gm::static_tile((i >> 1) * G + c, 32, 8, pm, pn)) return false;
        pm = __builtin_amdgcn_readfirstlane(pm); pn = __builtin_amdgcn_readfirstlane(pn);
        const int seg = i & 1;
        u.aS = (unsigned)((seg ? WS_ATT : WS_CONV) + (size_t)pm * MiB); u.bS0 = G_BT ? ((unsigned)pn << 20) : (unsigned)pn * 512u;
        u.pm = pm; u.code = gm::mk_code(pn, 0, seg, seg ? 0 : 1); return true;
    }
    __device__ __forceinline__ gm::rsrc_t adesc() const { return gm::mk_rsrc(ws, (unsigned)WS_END); }
    __device__ __forceinline__ gm::rsrc_t bdesc(int sel, int) const { return gm::mk_rsrc(ws + (sel ? WS_W16A : WS_W16C), 2048u * 2048u * 2u); }
    __device__ __forceinline__ void aoff(const gm::Unit&, unsigned (&v)[4], int R0, int C0, int R1, int C1) const { gm::plain_aoff(v, 4096, R0, C0, R1, C1); }
    __device__ __forceinline__ void epi(f32x4 (&acc)[2][2][4][2], const gm::Unit& u, int wr, int wc, int fr, int fq) const {
        const bf16_t* GC = (const bf16_t*)(ws + WS_GC); const bf16_t* GA = (const bf16_t*)(ws + WS_GA); bf16_t* MRG = (bf16_t*)(ws + WS_MRG);
        const int row0 = u.pm * 256 + wr * 64 + fr, col0 = u.pn() * 256 + wc * 32 + 8 * fq; const int seg = u.aux();
#pragma unroll
        for (int ai = 0; ai < 2; ++ai)
#pragma unroll
            for (int m = 0; m < 4; ++m) {
                const int row = row0 + ai * 128 + m * 16;
#pragma unroll
                for (int bj = 0; bj < 2; ++bj) {
                    const size_t idx = (size_t)row * 2048 + col0 + bj * 128;
                    const u32x4 ga = *(const GAS u32x4*)(GA + idx);
                    float fa[8] = {bf_lo(ga.x), bf_hi(ga.x), bf_lo(ga.y), bf_hi(ga.y), bf_lo(ga.z), bf_hi(ga.z), bf_lo(ga.w), bf_hi(ga.w)};
                    if (seg == 0) {
                        const u32x4 gc = *(const GAS u32x4*)(GC + idx);
                        float fc[8] = {bf_lo(gc.x), bf_hi(gc.x), bf_lo(gc.y), bf_hi(gc.y), bf_lo(gc.z), bf_hi(gc.z), bf_lo(gc.w), bf_hi(gc.w)};
#pragma unroll
                        for (int i = 0; i < 8; ++i) { const float r = (1.f + fast_exp(-fa[i])) * __builtin_amdgcn_rcpf(1.f + fast_exp(-fc[i])); acc[ai][bj][m][i >> 2][i & 3] *= r; }
                    } else {
                        float o[8];
#pragma unroll
                        for (int i = 0; i < 8; ++i) o[i] = acc[ai][bj][m][i >> 2][i & 3] * sigmoidf_(fa[i]);
                        u32x4 w; w.x = cvtpk(o[0], o[1]); w.y = cvtpk(o[2], o[3]); w.z = cvtpk(o[4], o[5]); w.w = cvtpk(o[6], o[7]);
                        *(GAS u32x4*)(MRG + idx) = w;
                    }
                }
            }
    }
};

struct ProbWo {
    static constexpr bool B16 = true; static constexpr int LDA2 = 4096; static constexpr bool PERM = false, GATHER = false; static constexpr int LDB = 2048; static constexpr unsigned B1OFF = 512; static constexpr bool BT = (G_BT != 0);
    const unsigned char* ws; const float* w_o; const float* x; int G, c;
    __device__ __forceinline__ bool next(int i, gm::Unit& u) const {
        int pm, pn; if (!gm::static_tile(i * G + c, 32, 8, pm, pn)) return false;
        pm = __builtin_amdgcn_readfirstlane(pm); pn = __builtin_amdgcn_readfirstlane(pn);
        u.aS = (unsigned)(WS_MRG + (size_t)pm * MiB); u.bS0 = G_BT ? ((unsigned)pn << 20) : (unsigned)pn * 512u; u.pm = pm; u.code = gm::mk_code(pn, 0, 0, 0); return true;
    }
    __device__ __forceinline__ gm::rsrc_t adesc() const { return gm::mk_rsrc(ws, (unsigned)WS_END); }
    __device__ __forceinline__ gm::rsrc_t bdesc(int, int) const { return gm::mk_rsrc(ws + WS_W16O, 2048u * 2048u * 2u); }
    __device__ __forceinline__ void aoff(const gm::Unit&, unsigned (&v)[4], int R0, int C0, int R1, int C1) const { gm::plain_aoff(v, 4096, R0, C0, R1, C1); }
    __device__ __forceinline__ void epi(f32x4 (&acc)[2][2][4][2], const gm::Unit& u, int wr, int wc, int fr, int fq) const {
        float* H1 = (float*)(ws + WS_H1);
        const int row0 = u.pm * 256 + wr * 64 + fr, col0 = u.pn() * 256 + wc * 32 + 4 * fq;
#pragma unroll
        for (int ai = 0; ai < 2; ++ai)
#pragma unroll
            for (int m = 0; m < 4; ++m) {
                const int row = row0 + ai * 128 + m * 16;
#pragma unroll
                for (int bj = 0; bj < 2; ++bj)
#pragma unroll
                    for (int n = 0; n < 2; ++n) {
                        const size_t idx = (size_t)row * 2048 + col0 + bj * 128 + n * 16;
                        const f32x4 xv = *(const GAS f32x4*)(x + idx);
                        *(GAS f32x4*)(H1 + idx) = xv + acc[ai][bj][m][n];
                    }
            }
    }
};

struct MoeTab { const LAS int* pre; const LAS int* cnt; };
__device__ __forceinline__ bool moe_decode(const MoeTab& T, int L, int ntn, int& e, int& mt, int& pn) {
    const int tot = T.pre[32];
    if (L >= tot * ntn) return false;
    int ee = 0;
    while (ee < 31 && L >= ntn * T.pre[ee + 1]) ++ee;
    const int v = L - ntn * T.pre[ee], te = T.pre[ee + 1] - T.pre[ee];
    e = __builtin_amdgcn_readfirstlane(ee); pn = __builtin_amdgcn_readfirstlane(v / te); mt = __builtin_amdgcn_readfirstlane(v % te);
    return true;
}
struct ProbMoe1 {
    static constexpr bool B16 = false; static constexpr int LDA2 = 4096; static constexpr bool PERM = true, GATHER = true; static constexpr int LDB = 2048; static constexpr unsigned B1OFF = 0; static constexpr bool BT = false;
    const unsigned char* ws; const float* w_gate; const float* w_up; const float* b_gate; const float* b_up; MoeTab T; int G, vcu;
    __device__ __forceinline__ bool next(int i, gm::Unit& u) const {
        int e, mt, pn; if (!moe_decode(T, i * G + vcu, 16, e, mt, pn)) return false;
        u.aS = (unsigned)WS_XN; u.bS0 = (unsigned)e * (2048u * 2048u * 4u) + (unsigned)pn * 512u;
        u.pm = __builtin_amdgcn_readfirstlane(T.pre[e]) + mt; u.code = gm::mk_code(pn, e, mt, 0); return true;
    }
    __device__ __forceinline__ gm::rsrc_t adesc() const { return gm::mk_rsrc(ws, (unsigned)WS_END); }
    __device__ __forceinline__ gm::rsrc_t bdesc(int, int h) const { return gm::mk_rsrc(h ? w_up : w_gate, 32u * 2048u * 2048u * 4u); }
    __device__ __forceinline__ void aoff(const gm::Unit& u, unsigned (&v)[4], int R0, int C0, int R1, int C1) const {
        const int* er = (const int*)(ws + WS_EROWS) + u.e() * 8192; const int cnt = T.cnt[u.e()]; const int base = u.aux() * 256;
        int i0 = base + R0, i1 = base + R1, i2 = base + 128 + R0, i3 = base + 128 + R1;
        i0 = i0 < cnt ? i0 : cnt - 1; i1 = i1 < cnt ? i1 : cnt - 1; i2 = i2 < cnt ? i2 : cnt - 1; i3 = i3 < cnt ? i3 : cnt - 1;
        const int t0 = __hip_atomic_load(er + i0, __ATOMIC_RELAXED, __HIP_MEMORY_SCOPE_AGENT), t1 = __hip_atomic_load(er + i1, __ATOMIC_RELAXED, __HIP_MEMORY_SCOPE_AGENT);
        const int t2 = __hip_atomic_load(er + i2, __ATOMIC_RELAXED, __HIP_MEMORY_SCOPE_AGENT), t3 = __hip_atomic_load(er + i3, __ATOMIC_RELAXED, __HIP_MEMORY_SCOPE_AGENT);
        v[0] = (unsigned)(t0 * 4096 + C0 * 2); v[1] = (unsigned)(t1 * 4096 + C1 * 2); v[2] = (unsigned)(t2 * 4096 + C0 * 2); v[3] = (unsigned)(t3 * 4096 + C1 * 2);
    }
    __device__ __forceinline__ void epi(f32x4 (&acc)[2][2][4][2], const gm::Unit& u, int wr, int wc, int fr, int fq) const {
        bf16_t* HID = (bf16_t*)(ws + WS_HID);
        const int row0 = u.pm * 256 + wr * 64 + fr, col0 = u.pn() * 128 + wc * 32 + 8 * fq;
        const GAS f32x4* bgp = (const GAS f32x4*)(b_gate + u.e() * 2048 + col0); const GAS f32x4* bup = (const GAS f32x4*)(b_up + u.e() * 2048 + col0);
        const f32x4 bg0 = bgp[0], bg1 = bgp[1], bu0 = bup[0], bu1 = bup[1];
#pragma unroll
        for (int ai = 0; ai < 2; ++ai)
#pragma unroll
            for (int m = 0; m < 4; ++m) {
                const int row = row0 + ai * 128 + m * 16;
                float o[8];
#pragma unroll
                for (int i = 0; i < 8; ++i) {
                    float g = acc[ai][0][m][i >> 2][i & 3] + (i < 4 ? bg0[i & 3] : bg1[i & 3]);
                    float uu = acc[ai][1][m][i >> 2][i & 3] + (i < 4 ? bu0[i & 3] : bu1[i & 3]);
                    g = fminf(g, 7.f); uu = fminf(fmaxf(uu, -7.f), 7.f);
                    o[i] = (uu + 1.f) * (g * sigmoidf_(1.702f * g));
                }
                u32x4 w; w.x = cvtpk(o[0], o[1]); w.y = cvtpk(o[2], o[3]); w.z = cvtpk(o[4], o[5]); w.w = cvtpk(o[6], o[7]);
                *(GAS u32x4*)(HID + (size_t)row * 2048 + col0) = w;
            }
    }
};
struct ProbMoe2 {
    static constexpr bool B16 = false; static constexpr int LDA2 = 4096; static constexpr bool PERM = true, GATHER = false; static constexpr int LDB = 2048; static constexpr unsigned B1OFF = 512; static constexpr bool BT = false;
    const unsigned char* ws; const float* w_down; const float* b_down; MoeTab T; int G, vcu;
    __device__ __forceinline__ bool next(int i, gm::Unit& u) const {
        int e, mt, pn; if (!moe_decode(T, i * G + vcu, 8, e, mt, pn)) return false;
        const int pm = __builtin_amdgcn_readfirstlane(T.pre[e]) + mt;
        u.aS = (unsigned)(WS_HID + (size_t)pm * MiB); u.bS0 = (unsigned)e * (2048u * 2048u * 4u) + (unsigned)pn * 1024u;
        u.pm = pm; u.code = gm::mk_code(pn, e, mt, 0); return true;
    }
    __device__ __forceinline__ gm::rsrc_t adesc() const { return gm::mk_rsrc(ws, (unsigned)WS_END); }
    __device__ __forceinline__ gm::rsrc_t bdesc(int, int) const { return gm::mk_rsrc(w_down, 32u * 2048u * 2048u * 4u); }
    __device__ __forceinline__ void aoff(const gm::Unit&, unsigned (&v)[4], int R0, int C0, int R1, int C1) const { gm::plain_aoff(v, 4096, R0, C0, R1, C1); }
    __device__ __forceinline__ void epi(f32x4 (&acc)[2][2][4][2], const gm::Unit& u, int wr, int wc, int fr, int fq) const {
        bf16_t* YB = (bf16_t*)(ws + WS_YB);
        const int row0 = u.pm * 256 + wr * 64 + fr, col0 = u.pn() * 256 + wc * 32 + 8 * fq;
#pragma unroll
        for (int bj = 0; bj < 2; ++bj) {
            const GAS f32x4* bp = (const GAS f32x4*)(b_down + u.e() * 2048 + col0 + bj * 128);
            const f32x4 b0 = bp[0], b1 = bp[1];
#pragma unroll
            for (int ai = 0; ai < 2; ++ai)
#pragma unroll
                for (int m = 0; m < 4; ++m) {
                    const int row = row0 + ai * 128 + m * 16;
                    const f32x4 v0 = acc[ai][bj][m][0] + b0, v1 = acc[ai][bj][m][1] + b1;
                    u32x4 w; w.x = cvtpk(v0[0], v0[1]); w.y = cvtpk(v0[2], v0[3]); w.z = cvtpk(v1[0], v1[1]); w.w = cvtpk(v1[2], v1[3]);
                    *(GAS u32x4*)(YB + (size_t)row * 2048 + col0 + bj * 128) = w;
                }
        }
    }
};

namespace at {
constexpr int D = 128, NW = 8, QBLK = 32, KVBLK = 64, QB = 256, OSTR = 2048;
constexpr int SHM_V = KVBLK * D * 2, SHM_K = KVBLK * D * 2;
constexpr int GATE_OFF = 2 * SHM_V + 2 * SHM_K + NW * 64 * 4;
constexpr float SCALE = 0.08838834764831845f, THR = 8.f;
constexpr int WBIG = 1 << 30;
#define KSWZ(row, colB) ((row) * 256 + ((colB) ^ (((row) & 7) << 4)))
#define SBAR() __builtin_amdgcn_sched_barrier(0)
__device__ __forceinline__ int v_st(int k, int c) { const int kk = (k & ~0xC) | ((k & 4) << 1) | ((k & 8) >> 1); return ((kk >> 3) * 4 + (c >> 5)) * 512 + ((kk & 7) * 32 + (c & 31)) * 2; }
__device__ __forceinline__ int v_rd_base(int lane) { return ((lane & 3) << 3) | (((lane >> 2) & 3) << 6) | (((lane >> 4) & 1) << 5) | (((lane >> 5) & 1) << 8); }
constexpr int v_rd_off(int d0, int ks, int half) { return d0 * 512 + ks * 4096 + half * 2048; }
__device__ __forceinline__ int crow(int r, int hi) { return (r & 3) + 8 * (r >> 2) + 4 * hi; }
__device__ __forceinline__ unsigned cvtpkv(float lo, float hi) { unsigned r; asm volatile("v_cvt_pk_bf16_f32 %0, %1, %2" : "=v"(r) : "v"(lo), "v"(hi)); return r; }
__device__ __forceinline__ bf16x8 load8(const bf16_t* p) { return *reinterpret_cast<const bf16x8*>(p); }
__device__ __forceinline__ void mask_tile(f32x16& p0, f32x16& p1, int dq, unsigned W) {
    const float NEG = -__builtin_inff();
#pragma unroll
    for (int r = 0; r < 16; ++r) {
        const int c = (r & 3) + 8 * (r >> 2);
        if ((unsigned)(dq - c) >= W) p0[r] = NEG;
        if ((unsigned)(dq - c - 32) >= W) p1[r] = NEG;
    }
}
__device__ __forceinline__ void partialSM(f32x16& p0, f32x16& p1, float& m_reg, float& mn, float& alpha, bool rowsel) {
    float pmax = p0[0]; for (int r = 1; r < 16; ++r) pmax = fmaxf(pmax, p0[r]); for (int r = 0; r < 16; ++r) pmax = fmaxf(pmax, p1[r]);
    { auto rr = __builtin_amdgcn_permlane32_swap(__float_as_uint(pmax), __float_as_uint(pmax), false, false);
      pmax = fmaxf(__uint_as_float(rr[0]), __uint_as_float(rr[1])); }
    if (!rowsel) pmax = -__builtin_inff();
    constexpr float C2 = 1.4426950408889634f * SCALE;
    if (__builtin_expect(__all((pmax - m_reg) * SCALE <= THR), 1)) { mn = m_reg; alpha = 1.f; }
    else { mn = fmaxf(m_reg, pmax); alpha = __builtin_amdgcn_exp2f((m_reg - mn) * C2); m_reg = mn; }
    const float mnL = rowsel ? -mn * C2 : -__builtin_inff();
    for (int r = 0; r < 16; ++r) p0[r] = fmaf(p0[r], C2, mnL); for (int r = 0; r < 16; ++r) p1[r] = fmaf(p1[r], C2, mnL);
    for (int r = 0; r < 16; ++r) p0[r] = __builtin_amdgcn_exp2f(p0[r]);
}
__device__ __forceinline__ void finishSM(f32x16& p0, f32x16& p1, float alpha, float& l_reg, bf16x8& pa0, bf16x8& pa1, bf16x8& pa2, bf16x8& pa3) {
    for (int r = 0; r < 16; ++r) p1[r] = __builtin_amdgcn_exp2f(p1[r]);
    float ps = 0; for (int r = 0; r < 16; ++r) ps += p0[r]; for (int r = 0; r < 16; ++r) ps += p1[r];
    { auto rr = __builtin_amdgcn_permlane32_swap(__float_as_uint(ps), __float_as_uint(ps), false, false);
      ps = __uint_as_float(rr[0]) + __uint_as_float(rr[1]); }
    l_reg = l_reg * alpha + ps;
#define PK4(P, B_, OUT) do { unsigned a0 = cvtpkv(P[B_+0], P[B_+1]), a1 = cvtpkv(P[B_+2], P[B_+3]);                          \
        unsigned b0 = cvtpkv(P[B_+4], P[B_+5]), b1 = cvtpkv(P[B_+6], P[B_+7]);                                             \
        auto r0 = __builtin_amdgcn_permlane32_swap(a0, b0, false, false); auto r1 = __builtin_amdgcn_permlane32_swap(a1, b1, false, false); \
        u32x4 w = {r0[0], r1[0], r0[1], r1[1]}; OUT = *reinterpret_cast<bf16x8*>(&w); } while (0)
    PK4(p0, 0, pa0); PK4(p0, 8, pa1); PK4(p1, 0, pa2); PK4(p1, 8, pa3);
#undef PK4
}
template <int KB>
__device__ __forceinline__ void qkt(f32x16& p0, f32x16& p1, const char* K_lds, int r32, int hi, const bf16x8* qr) {
    p0 = f32x16{}; p1 = f32x16{};
    const char* kb[4];
#pragma unroll
    for (int dd = 0; dd < 4; ++dd) kb[dd] = K_lds + KB * SHM_K + KSWZ(r32, (dd * 16 + hi * 8) * 2);
#pragma unroll
    for (int d0 = 0; d0 < 8; ++d0) { const char* a = kb[d0 & 3] + (d0 >> 2) * 128;
        bf16x8 b0 = *reinterpret_cast<const bf16x8*>(a);
        bf16x8 b1 = *reinterpret_cast<const bf16x8*>(a + 32 * 256);
        p0 = __builtin_amdgcn_mfma_f32_32x32x16_bf16(b0, qr[d0], p0, 0, 0, 0);
        p1 = __builtin_amdgcn_mfma_f32_32x32x16_bf16(b1, qr[d0], p1, 0, 0, 0); }
}
__device__ __forceinline__ void gate_scores(f32x16& g, const char* G_lds, int r32, int hi, const bf16x8* qr) {
    g = f32x16{};
#pragma unroll
    for (int d0 = 0; d0 < 8; ++d0) { const char* a = G_lds + KSWZ(r32, ((d0 & 3) * 16 + hi * 8) * 2) + (d0 >> 2) * 128;
        bf16x8 b0 = *reinterpret_cast<const bf16x8*>(a);
        g = __builtin_amdgcn_mfma_f32_32x32x16_bf16(b0, qr[d0], g, 0, 0, 0); }
}
template <int VB>
__device__ __forceinline__ void pv_tile(f32x16* o, int vb0, bf16x8 pa0, bf16x8 pa1, bf16x8 pa2, bf16x8 pa3) {
#define TRRD(dst, off) asm volatile("ds_read_b64_tr_b16 %0, %1 offset:%2" : "=&v"(dst) : "v"(vb0), "i"(off) : "memory")
#define PV_D0(d0) do { s16x4 l0, l1, l2, l3, h0, h1, h2, h3; constexpr int b_ = VB * SHM_V + v_rd_off(d0, 0, 0); \
        TRRD(l0, b_); TRRD(h0, b_ + 2048); TRRD(l1, b_ + 4096); TRRD(h1, b_ + 6144); TRRD(l2, b_ + 8192); TRRD(h2, b_ + 10240); TRRD(l3, b_ + 12288); TRRD(h3, b_ + 14336); \
        asm volatile("s_waitcnt lgkmcnt(0)" ::: "memory"); SBAR();   \
        o[d0] = __builtin_amdgcn_mfma_f32_32x32x16_bf16(pa0, (bf16x8){l0[0], l0[1], l0[2], l0[3], h0[0], h0[1], h0[2], h0[3]}, o[d0], 0, 0, 0);   \
        o[d0] = __builtin_amdgcn_mfma_f32_32x32x16_bf16(pa1, (bf16x8){l1[0], l1[1], l1[2], l1[3], h1[0], h1[1], h1[2], h1[3]}, o[d0], 0, 0, 0);   \
        o[d0] = __builtin_amdgcn_mfma_f32_32x32x16_bf16(pa2, (bf16x8){l2[0], l2[1], l2[2], l2[3], h2[0], h2[1], h2[2], h2[3]}, o[d0], 0, 0, 0);   \
        o[d0] = __builtin_amdgcn_mfma_f32_32x32x16_bf16(pa3, (bf16x8){l3[0], l3[1], l3[2], l3[3], h3[0], h3[1], h3[2], h3[3]}, o[d0], 0, 0, 0); } while (0)
    PV_D0(0); PV_D0(1); PV_D0(2); PV_D0(3);
#undef PV_D0
#undef TRRD
}

struct BlockRef { unsigned q, k, v, o, km; int P0; };
struct Seam { bf16x8 qr[8]; bf16x8 st_v0, st_v1, st_k0, st_k1; };
typedef __amdgpu_buffer_rsrc_t rs_t;
__device__ __forceinline__ bf16x8 bl8(rs_t rs, unsigned voff, unsigned soff) { u32x4 t = __builtin_amdgcn_raw_buffer_load_b128(rs, voff, soff, 0); return *reinterpret_cast<bf16x8*>(&t); }
#define VMW() asm volatile("s_waitcnt vmcnt(0)" ::: "memory")
#define VMWN(n) asm volatile("s_waitcnt vmcnt(%0)" :: "i"(n) : "memory")
#define SLOAD_H(Ko, Vo, k0) do { const unsigned kb__ = (unsigned)(k0) * 256u; S.st_v0 = bl8(rs, kvo, (Vo) + kb__); S.st_v1 = bl8(rs, kvo, (Vo) + kb__ + 8192u);              \
                         S.st_k0 = bl8(rs, kvo, (Ko) + kb__); S.st_k1 = bl8(rs, kvo, (Ko) + kb__ + 8192u); } while (0)
#define SWRITE_HK(bf) do { *(bf16x8*)(K_lds + (bf) * SHM_K + kws) = S.st_k0; *(bf16x8*)(K_lds + (bf) * SHM_K + kws + 32 * 256) = S.st_k1; } while (0)
#define SWRITE_HV(bf) do { *(bf16x8*)(V_lds + (bf) * SHM_V + vst0) = S.st_v0; *(bf16x8*)(V_lds + (bf) * SHM_V + vst1) = S.st_v1; } while (0)
#define SWRITE_H(bf) do { SWRITE_HV(bf); SWRITE_HK(bf); } while (0)
#define QLOAD(qo) do { _Pragma("unroll") for (int d0 = 0; d0 < 8; ++d0) S.qr[d0] = bl8(rs, qvo + d0 * 32, (qo)); } while (0)
__device__ __forceinline__ void moba_prime(const BlockRef& cur, rs_t rs, char* lds, Seam& S) {
    const int tid = threadIdx.x, wid = __builtin_amdgcn_readfirstlane(tid >> 6), lane = tid & 63, r32 = lane & 31, hi = lane >> 5;
    const int sr = tid >> 4, sc = (tid & 15) * 8, kws = KSWZ(sr, sc * 2); char* K_lds = lds + 2 * SHM_V;
    const unsigned kvo = (unsigned)(sr * 128 + sc) * 2u, qvo = (unsigned)((wid * QBLK + r32) * 128 + hi * 8) * 2u;
    QLOAD(cur.q);
    SLOAD_H(cur.k, cur.v, 0); VMW(); SWRITE_HK(0);
    __syncthreads();
}
__device__ __forceinline__ void moba_block(const BlockRef& cur, const BlockRef& nxt, rs_t rs, char* lds, Seam& S) {
    const int tid = threadIdx.x, wid = __builtin_amdgcn_readfirstlane(tid >> 6), lane = tid & 63, r32 = lane & 31, hi = lane >> 5;
    const int own = cur.P0 >> 8;
    const int NT = 4 * own + 4;
    const int qlo = cur.P0 + wid * QBLK, qm = qlo + r32 - 4 * hi;
    char* V_lds = lds; char* K_lds = lds + 2 * SHM_V; char* G_lds = lds + GATE_OFF;
    float* ws = (float*)(lds + 2 * SHM_V + 2 * SHM_K) + wid * 64; float* li_l = ws, * al_l = ws + 32;
    const int sr = tid >> 4, sc = (tid & 15) * 8, vst0 = v_st(sr, sc), vst1 = v_st(32 + sr, sc), kws = KSWZ(sr, sc * 2);
    const unsigned kvo = (unsigned)(sr * 128 + sc) * 2u, qvo = (unsigned)((wid * QBLK + r32) * 128 + hi * 8) * 2u;
    { bf16x8 z = {0, 0, 0, 0, 0, 0, 0, 0};
      if (tid < 256) { const u32x4 s0 = __builtin_amdgcn_raw_buffer_load_b128(rs, 2u * kvo, cur.km, 0), s1 = __builtin_amdgcn_raw_buffer_load_b128(rs, 2u * kvo + 16u, cur.km, 0);
          const float q = 1.f / 256.f; u32x4 w;
          w.x = cvtpkv(__uint_as_float(s0.x) * q, __uint_as_float(s0.y) * q); w.y = cvtpkv(__uint_as_float(s0.z) * q, __uint_as_float(s0.w) * q);
          w.z = cvtpkv(__uint_as_float(s1.x) * q, __uint_as_float(s1.y) * q); w.w = cvtpkv(__uint_as_float(s1.z) * q, __uint_as_float(s1.w) * q); z = *reinterpret_cast<bf16x8*>(&w); }
      *(bf16x8*)(G_lds + KSWZ(sr, sc * 2)) = z; }
    __syncthreads();
    unsigned selmask = 0;
    { f32x16 g; gate_scores(g, G_lds, r32, hi, S.qr);
      float s[16];
#pragma unroll
      for (int r = 0; r < 8; ++r) { const float mine = g[r], oth = __shfl_xor(mine, 32);
          const float lo = hi ? oth : mine, hv = hi ? mine : oth;
          s[(r & 3) + 8 * (r >> 2)] = lo; s[(r & 3) + 8 * (r >> 2) + 4] = hv; }
      const float NEGI = -__builtin_inff();
#pragma unroll
      for (int j = 0; j < 16; ++j) if (j >= own) s[j] = NEGI;
#pragma unroll
      for (int k = 0; k < 3; ++k) { float best = NEGI; int bi = -1;
#pragma unroll
          for (int j = 0; j < 16; ++j) { const bool tk = s[j] > best; best = tk ? s[j] : best; bi = tk ? j : bi; }
          if (bi >= 0) { selmask |= 1u << bi;
#pragma unroll
              for (int j = 0; j < 16; ++j) if (j == bi) s[j] = NEGI; } }
    }
    float m_reg = -1e30f, l_reg = 0; f32x16 o[4] = {};
    const int vb0 = (int)(uintptr_t)V_lds + v_rd_base(lane);
    const unsigned Kh = cur.k, Vh = cur.v;
#define RESC(a) do { if (__any((a) < 1.f)) { if (hi == 0) al_l[r32] = (a); asm volatile("s_waitcnt lgkmcnt(0)" ::: "memory");              \
                     for (int d_ = 0; d_ < 4; ++d_) for (int r = 0; r < 16; ++r) o[d_][r] *= al_l[crow(r, hi)]; } } while (0)
#define KBASE(t) ((t) * KVBLK)
#define ROWSEL(t) ((((t) >> 2) >= own) || ((selmask >> ((t) >> 2)) & 1u))
#define MASKT(P0_, P1_, t) do { const int kb_ = KBASE(t); if (kb_ + KVBLK - 1 > qlo) mask_tile(P0_, P1_, qm - kb_, (unsigned)WBIG); } while (0)
    constexpr int NQL = 8;
#define SEAM_K0() do { VMWN(NQL); SWRITE_HK(0); SBAR(); } while (0)
    f32x16 pA0, pA1, pB0, pB1; float mnA, mnB, alA, alB; bf16x8 pa0, pa1, pa2, pa3;
    SWRITE_HV(0); SBAR();
    if (NT > 1) { SLOAD_H(Kh, Vh, KBASE(1)); }
    SBAR(); qkt<0>(pA0, pA1, K_lds, r32, hi, S.qr);
    MASKT(pA0, pA1, 0); partialSM(pA0, pA1, m_reg, mnA, alA, ROWSEL(0));
    if (NT > 1) { VMW(); SWRITE_H(1); }
    __syncthreads();
#define HALF_STEP(PX0, PX1, mnX, alX, PY0, PY1, alY, t, KB, VB, SB) do {                                                      \
        SBAR(); qkt<KB>(PX0, PX1, K_lds, r32, hi, S.qr);                                                                      \
        finishSM(PY0, PY1, alY, l_reg, pa0, pa1, pa2, pa3); SBAR();                                                           \
        if ((t) + 1 < NT) { SLOAD_H(Kh, Vh, KBASE((t) + 1)); SBAR(); }                                                        \
        pv_tile<VB>(o, vb0, pa0, pa1, pa2, pa3); MASKT(PX0, PX1, (t)); partialSM(PX0, PX1, m_reg, mnX, alX, ROWSEL(t));       \
        __syncthreads();                                                                                                      \
        if ((t) + 1 < NT) { VMW(); SWRITE_H(SB); }                                                                            \
        RESC(alX); __syncthreads(); } while (0)
    for (int t = 1; t + 1 < NT; t += 2) {
        HALF_STEP(pB0, pB1, mnB, alB, pA0, pA1, alA, t, 1, 0, 0);
        HALF_STEP(pA0, pA1, mnA, alA, pB0, pB1, alB, t + 1, 0, 1, 1);
    }
    SBAR(); qkt<1>(pB0, pB1, K_lds, r32, hi, S.qr); SBAR();
    SLOAD_H(nxt.k, nxt.v, 0); SBAR();
    QLOAD(nxt.q);
    SBAR();
    finishSM(pA0, pA1, alA, l_reg, pa0, pa1, pa2, pa3); SBAR();
    pv_tile<0>(o, vb0, pa0, pa1, pa2, pa3);
    MASKT(pB0, pB1, NT - 1); partialSM(pB0, pB1, m_reg, mnB, alB, true); __syncthreads(); RESC(alB);
    finishSM(pB0, pB1, alB, l_reg, pa0, pa1, pa2, pa3); SBAR(); pv_tile<1>(o, vb0, pa0, pa1, pa2, pa3);
    SBAR(); SEAM_K0();
    if (hi == 0) li_l[r32] = l_reg; asm volatile("s_waitcnt lgkmcnt(0)" ::: "memory");
    float rli[16];
#pragma unroll
    for (int r = 0; r < 16; ++r) rli[r] = __builtin_amdgcn_rcpf(li_l[crow(r, hi)]);
    int tz = threadIdx.x; asm volatile("" : "+v"(tz));
    const int r32e = tz & 31, hie = (tz >> 5) & 1;
    const unsigned osoff = cur.o + (unsigned)(wid * QBLK) * (unsigned)(OSTR * 2);
#pragma unroll
    for (int r = 0; r < 16; ++r) { const unsigned ob = (unsigned)(crow(r, hie) * OSTR + r32e) * 2u;
#pragma unroll
        for (int d0 = 0; d0 < 4; ++d0) { const float v = o[d0][r] * rli[r];
            const float vn = __shfl_xor(v, 1);
            if ((r32e & 1) == 0) __builtin_amdgcn_raw_buffer_store_b32(cvtpkv(v, vn), rs, ob + d0 * 64, osoff, 0); } }
    __syncthreads();
#undef RESC
#undef KBASE
#undef ROWSEL
#undef MASKT
#undef SEAM_K0
#undef HALF_STEP
}
#undef QLOAD
#undef VMW
#undef VMWN
#undef SLOAD_H
#undef SWRITE_HK
#undef SWRITE_HV
#undef SWRITE_H
}

__device__ __constant__ double ROPE_INVF[16] = {1.0, 0.4403666026717805, 0.1939227447486858, 0.08539710028576561, 0.03760603093086394, 0.016560440080994443,
    0.007292664737217109, 0.0032114459947525913, 0.0014142135623730955, 0.0006227724219145962, 0.00027424817567620724, 0.00012076973741146502,
    5.318295896944988e-05, 2.3419998961409345e-05, 1.0313385377212461e-05, 4.541670480607871e-06};

__device__ __forceinline__ void sincos_d(double a, double& sn, double& cs) {
    const double k = __builtin_rint(a * 0.63661977236758134308);
    double y = __builtin_fma(-k, 1.57079632679489655800e+00, a); y = __builtin_fma(-k, 6.12323399573676603587e-17, y);
    const double z = y * y;
    double s = -7.6471637318198164759e-13; s = s * z + 1.6059043836821614599e-10; s = s * z - 2.5052108385441718775e-08; s = s * z + 2.7557319223985890653e-06;
    s = s * z - 1.9841269841269841270e-04; s = s * z + 8.3333333333333333333e-03; s = s * z - 1.6666666666666666667e-01; s = y + y * z * s;
    double c = 4.7794773323873852974e-14; c = c * z - 1.1470745597729724714e-11; c = c * z + 2.0876756987868098979e-09; c = c * z - 2.7557319223985890653e-07;
    c = c * z + 2.4801587301587301587e-05; c = c * z - 1.3888888888888888889e-03; c = c * z + 4.1666666666666666667e-02; c = c * z - 0.5; c = 1.0 + z * c;
    const int q = ((int)k) & 3;
    sn = (q == 0) ? s : (q == 1) ? c : (q == 2) ? -s : -c;
    cs = (q == 0) ? c : (q == 1) ? -s : (q == 2) ? -c : s;
}

typedef const __attribute__((address_space(4))) Params* KP;
__device__ __forceinline__ KP kparams() { KP k = (KP)__builtin_amdgcn_kernarg_segment_ptr(); asm volatile("" : "+s"(k)); return k; }

__global__ void __launch_bounds__(512, 2) mega(Params p_unused) {
    extern __shared__ __attribute__((aligned(16))) unsigned char lds_raw[];
    LAS unsigned char* lds = (LAS unsigned char*)lds_raw;
#define PH_IDS int tid = threadIdx.x; asm volatile("" : "+v"(tid)); const int lane = tid & 63, wave = __builtin_amdgcn_readfirstlane(tid >> 6); (void)lane; (void)wave
    const int G = gridDim.x, bx = blockIdx.x;
    const int vcu = (G % 8 == 0) ? (bx % 8) * (G / 8) + bx / 8 : bx;
    unsigned char* ws; int lo, hi;
    { KP k = kparams(); ws = k->ws; lo = k->ph_lo; hi = k->ph_hi; }
    unsigned* ctl = (unsigned*)(ws + WS_CTL);
    volatile LAS unsigned* MISC = (volatile LAS unsigned*)(lds + MISC_OFF);
    { PH_IDS; for (int u = tid; u < (LDS_BYTES - MISC_OFF) / 4; u += 512) MISC[u] = 0u; }
    __syncthreads();
    XcdBarrier bar; bar.bar = ctl + CW_BAR; bar.st = MISC;
    if (hi - lo > 1) bar = xcd_barrier_post(ctl + CW_BAR, MISC);
#ifndef PH_MASK
#define PH_MASK 0x3ff
#endif
#define IN(k) ((((PH_MASK) >> (k)) & 1) && lo <= (k) && (k) < hi)
#define SEAM(k) do { if (IN(k) && IN((k) + 1)) xcd_barrier(bar); } while (0)
    LAS int* pre = (LAS int*)(lds + MISC_OFF + 64);
    LAS int* cntl = (LAS int*)(lds + MISC_OFF + 256);

    if (IN(0)) {
        PH_IDS; KP kp = kparams(); const float* px = kp->x; const float* pnm = kp->norm_mix;
        const int gw = vcu * 8 + wave, NGW = G * 8;
        bf16_t* XN = (bf16_t*)(ws + WS_XN);
        for (int m = gw; m < NTOK; m += NGW) {
            const GAS f32x4* xr = (const GAS f32x4*)(px + (size_t)m * DM) + lane;
            f32x4 v[8]; float s = 0.f;
#pragma unroll
            for (int j = 0; j < 8; ++j) { v[j] = xr[64 * j]; s += (v[j].x * v[j].x + v[j].y * v[j].y) + (v[j].z * v[j].z + v[j].w * v[j].w); }
            const float rs = 1.f / sqrtf(wave_sum(s) * (1.f / DM) + NORM_EPS);
            GAS u32x2* o8 = (GAS u32x2*)(XN + (size_t)m * DM) + lane;
#pragma unroll
            for (int j = 0; j < 8; ++j) { const f32x4 g = *((const GAS f32x4*)pnm + lane + 64 * j);
                u32x2 w; w.x = cvtpk(v[j].x * rs * g.x, v[j].y * rs * g.y); w.y = cvtpk(v[j].z * rs * g.z, v[j].w * rs * g.w); o8[64 * j] = w; }
        }
        if (G_BT) {
            LAS float* scr = (LAS float*)(lds + wave * 8448);
            for (int it = gw; it < 16384 + 3 * 2048; it += NGW) {
                int r = it; const float* W; size_t off; int N;
                if (r < 16384) { W = kp->w_in; off = WS_W16IN; N = 16384; }
                else { r -= 16384; const int q = r >> 11; r &= 2047; W = q == 0 ? kp->w_conv_out : (q == 1 ? kp->w_attn_out : kp->w_o); off = q == 0 ? WS_W16C : (q == 1 ? WS_W16A : WS_W16O); N = 2048; }
                if (N == 16384) p0_transpose_item<true>(W, N, (bf16_t*)(ws + off), scr, r, lane); else p0_transpose_item<false>(W, N, (bf16_t*)(ws + off), scr, r, lane);
            }
        } else
        { const float* srcs[4] = {kp->w_in, kp->w_conv_out, kp->w_attn_out, kp->w_o};
          const size_t offs[4] = {WS_W16IN, WS_W16C, WS_W16A, WS_W16O}; const int n8s[4] = {2048 * 16384 / 8, 2048 * 2048 / 8, 2048 * 2048 / 8, 2048 * 2048 / 8};
#pragma unroll
          for (int q = 0; q < 4; ++q) { const GAS f32x4* sp = (const GAS f32x4*)srcs[q]; GAS u32x4* dp = (GAS u32x4*)(ws + offs[q]);
              for (int i = vcu * 512 + tid; i < n8s[q]; i += G * 512) { const f32x4 a = sp[2 * i], b = sp[2 * i + 1];
                  u32x4 w; w.x = cvtpk(a.x, a.y); w.y = cvtpk(a.z, a.w); w.z = cvtpk(b.x, b.y); w.w = cvtpk(b.z, b.w); dp[i] = w; } } }
        float* COS = (float*)(ws + WS_ROPE); float* SIN = COS + 4096 * 16;
        for (int i = vcu * 512 + tid; i < 4096 * 16; i += G * 512) { const int pos = i >> 4, f = i & 15;
            double sn, cs; sincos_d((double)pos * ROPE_INVF[f], sn, cs); COS[i] = (float)cs; SIN[i] = (float)sn; }
    }
    SEAM(0);
    if (IN(1)) { KP kp = kparams(); ProbIn P{ws, kp->w_in, G, bx, lds, kp->conv_w}; gm::gemm_stream<ProbIn>(lds, P); }
    SEAM(1);
    if (IN(3)) {
        const at::rs_t rs = __builtin_amdgcn_make_buffer_rsrc((void*)ws, 0, (unsigned)WS_END, 0x00020000);
        { PH_IDS;
          KP kp = kparams(); const float* pcw = kp->conv_w; const float* SBp = (const float*)(ws + WS_SB); bf16_t* CONV = (bf16_t*)(ws + WS_CONV);
          for (int it = vcu * 512 + tid; it < 32 * 2 * 512; it += G * 512) {
              const int c4 = (it & 511) * 4, r01 = (it >> 9) & 1, pm = it >> 10;
              if ((pm & 15) != 0) {
                  const float* cur = SBp + (size_t)pm * (6 * 2048) + c4; const float* prv = SBp + (size_t)(pm - 1) * (6 * 2048) + c4;
                  const f32x4 w0 = *(const GAS f32x4*)(pcw + c4), w1 = *(const GAS f32x4*)(pcw + 2048 + c4), w2 = *(const GAS f32x4*)(pcw + 4096 + c4);
                  const f32x4 p254 = *(const GAS f32x4*)prv, p255 = *(const GAS f32x4*)(prv + 2048);
                  const f32x4 bg0 = *(const GAS f32x4*)(cur + 2 * 2048), u0 = *(const GAS f32x4*)(cur + 3 * 2048), bg1 = *(const GAS f32x4*)(cur + 4 * 2048), u1 = *(const GAS f32x4*)(cur + 5 * 2048);
                  const f32x4 y = r01 == 0 ? bg0 * (w0 * p254 + w1 * p255 + w2 * u0) : bg1 * (w0 * p255 + w1 * u0 + w2 * u1);
                  u32x2 o; o.x = cvtpk(y[0], y[1]); o.y = cvtpk(y[2], y[3]);
                  *(GAS u32x2*)(CONV + (size_t)(pm * 256 + r01) * 2048 + c4) = o;
              }
          } }
        int L = vcu;
        if (L < 256) {
            int pass = 0;
#define MK_REF(r, L_, p_) do { const int bh = (L_) >> 3, x_ = (L_) & 7, qb = (p_) ? 15 - x_ : x_; const int b_ = bh >> 4, h_ = bh & 15; \
                r.q = (unsigned)(WS_Q + ((size_t)bh * 4096 + qb * 256) * 256); r.k = (unsigned)(WS_K + (size_t)bh * MiB); r.v = (unsigned)(WS_V + (size_t)bh * MiB); \
                r.o = (unsigned)(WS_ATT + ((size_t)(b_ * 4096 + qb * 256)) * 4096 + h_ * 256); r.km = (unsigned)(WS_KMSUM + (size_t)bh * 8192); r.P0 = qb * 256; } while (0)
            at::BlockRef cur, nxt; MK_REF(cur, L, 0);
            at::Seam S;
            at::moba_prime(cur, rs, (char*)lds_raw, S);
            for (;;) {
                const bool more_pass = (pass == 0), more_item = (L + G < 256), last = !more_pass && !more_item;
                int passn = pass + 1, Ln = L;
                if (!more_pass) { passn = 0; Ln = more_item ? L + G : L; }
                if (last) nxt = cur; else MK_REF(nxt, Ln, passn);
                at::moba_block(cur, nxt, rs, (char*)lds_raw, S);
                if (last) break;
                cur = nxt; pass = passn; L = Ln;
            }
#undef MK_REF
        }
    }
    SEAM(3);
    if (IN(4)) { KP kp = kparams(); ProbMerge P{ws, kp->w_conv_out, kp->w_attn_out, G, bx}; gm::gemm_stream<ProbMerge>(lds, P); }
    SEAM(4);
    if (IN(5)) { KP kp = kparams(); ProbWo P{ws, kp->w_o, kp->x, G, bx}; gm::gemm_stream<ProbWo>(lds, P); }
    SEAM(5);
    if (IN(6)) {
        PH_IDS;
        const float* H1 = (const float*)(ws + WS_H1); bf16_t* XN2 = (bf16_t*)(ws + WS_XN);
        KP kp = kparams(); const float* pnf = kp->norm_ffn; const float* pwr = kp->w_router; const float* pbr = kp->b_router;
        int* SLOT = (int*)(ws + WS_SLOT); float* TOKW = (float*)(ws + WS_TOKW); int* EROWS = (int*)(ws + WS_EROWS);
        LAS float* rs_l = (LAS float*)lds;
        LAS float* part = (LAS float*)(lds + 1024);
        LAS float* lg = (LAS float*)(lds + 1024 + 32768);
        for (int rb = vcu; rb < NTOK / 32; rb += G) {
#pragma unroll 1
            for (int rr = 0; rr < 4; ++rr) {
                const int rl = wave * 4 + rr, m = rb * 32 + rl;
                const GAS f32x4* xr = (const GAS f32x4*)(H1 + (size_t)m * DM) + lane;
                f32x4 v[8]; float s = 0.f;
#pragma unroll
                for (int j = 0; j < 8; ++j) { v[j] = xr[64 * j]; s += (v[j].x * v[j].x + v[j].y * v[j].y) + (v[j].z * v[j].z + v[j].w * v[j].w); }
                const float rs = 1.f / sqrtf(wave_sum(s) * (1.f / DM) + NORM_EPS);
                GAS u32x2* o8 = (GAS u32x2*)(XN2 + (size_t)m * DM) + lane;
#pragma unroll
                for (int j = 0; j < 8; ++j) { const f32x4 gg = *((const GAS f32x4*)pnf + lane + 64 * j);
                    u32x2 w; w.x = cvtpk(v[j].x * rs * gg.x, v[j].y * rs * gg.y); w.y = cvtpk(v[j].z * rs * gg.z, v[j].w * rs * gg.w); o8[64 * j] = w; }
                if (lane == 0) rs_l[rl] = rs;
            }
            { const int row = lane & 31, kk = lane >> 5;
              const GAS float* hp = (const GAS float*)H1 + (size_t)(rb * 32 + row) * DM + 256 * wave + kk;
              const GAS float* wp = (const GAS float*)pwr + (size_t)(256 * wave + kk) * 32 + row;
              const GAS float* gp = (const GAS float*)pnf + 256 * wave + kk;
              f32x16 acc = {};
#pragma unroll 8
              for (int st = 0; st < 128; ++st) { const float a = hp[2 * st]; const float bb = wp[(size_t)(2 * st) * 32] * gp[2 * st];
                  acc = __builtin_amdgcn_mfma_f32_32x32x2f32(a, bb, acc, 0, 0, 0); }
#pragma unroll
              for (int r = 0; r < 16; ++r) part[(wave * 32 + ((r & 3) + 8 * (r >> 2) + 4 * kk)) * 32 + row] = acc[r];
            }
            __syncthreads();
            for (int idx = tid; idx < 1024; idx += 512) { float sum = 0.f;
#pragma unroll
                for (int w8 = 0; w8 < 8; ++w8) sum += part[w8 * 1024 + idx];
                lg[idx] = sum * rs_l[idx >> 5] + pbr[idx & 31]; }
            __syncthreads();
            if (tid < 32) {
                const int m = rb * 32 + tid; float l[32];
#pragma unroll
                for (int e = 0; e < 32; ++e) l[e] = lg[tid * 32 + e];
                int se[4]; float sv[4];
#pragma unroll
                for (int k = 0; k < 4; ++k) { float best = -__builtin_inff(); int bi = 0;
#pragma unroll
                    for (int e = 0; e < 32; ++e) { const bool tk = l[e] > best; best = tk ? l[e] : best; bi = tk ? e : bi; }
                    se[k] = bi; sv[k] = best;
#pragma unroll
                    for (int e = 0; e < 32; ++e) if (e == bi) l[e] = -__builtin_inff(); }
                const float e1 = fast_exp(sv[1] - sv[0]), e2 = fast_exp(sv[2] - sv[0]), e3 = fast_exp(sv[3] - sv[0]);
                const float inv = 1.f / (1.f + e1 + e2 + e3);
                const float wgt[4] = {inv, e1 * inv, e2 * inv, e3 * inv};
#pragma unroll
                for (int k = 0; k < 4; ++k) {
                    const int pos = (int)__hip_atomic_fetch_add(ctl + CW_CNT + 64 * se[k], 1u, __ATOMIC_RELAXED, __HIP_MEMORY_SCOPE_AGENT);
                    EROWS[se[k] * 8192 + pos] = m; SLOT[m * 4 + k] = (se[k] << 16) | pos; TOKW[m * 4 + k] = wgt[k];
                }
            }
            __syncthreads();
        }
    }
    SEAM(6);
    if (IN(7) || IN(8) || IN(9)) {
        PH_IDS;
        if (tid < 32) cntl[tid] = (int)__hip_atomic_load(ctl + CW_CNT + 64 * tid, __ATOMIC_RELAXED, __HIP_MEMORY_SCOPE_AGENT);
        __syncthreads();
        if (tid == 0) { int a = 0; for (int e = 0; e < 32; ++e) { pre[e] = a; a += (cntl[e] + 255) >> 8; } pre[32] = a; }
        __syncthreads();
    }
    const MoeTab MT{pre, cntl};
    if (IN(7)) { KP kp = kparams(); ProbMoe1 P{ws, kp->w_gate, kp->w_up, kp->b_gate, kp->b_up, MT, G, vcu}; gm::gemm_stream<ProbMoe1>(lds, P); }
    SEAM(7);
    if (IN(8)) { KP kp = kparams(); ProbMoe2 P{ws, kp->w_down, kp->b_down, MT, G, vcu}; gm::gemm_stream<ProbMoe2>(lds, P); }
    SEAM(8);
    if (IN(9)) {
        PH_IDS;
        const float* H1 = (const float*)(ws + WS_H1); const bf16_t* YB = (const bf16_t*)(ws + WS_YB);
        const int* SLOT = (const int*)(ws + WS_SLOT); const float* TOKW = (const float*)(ws + WS_TOKW);
        KP kp = kparams(); const float* pfin = kp->norm_final; float* pout = kp->out;
        const int gw = vcu * 8 + wave, NGW = G * 8;
        for (int m = gw; m < NTOK; m += NGW) {
            const GAS u32x4* yr[4]; float wk[4];
#pragma unroll
            for (int k = 0; k < 4; ++k) { const int sl = SLOT[m * 4 + k]; const int e = sl >> 16, pos = sl & 0xffff; wk[k] = TOKW[m * 4 + k];
                yr[k] = (const GAS u32x4*)(YB + ((size_t)pre[e] * 256 + pos) * 2048) + lane; }
            const GAS f32x4* xr = (const GAS f32x4*)(H1 + (size_t)m * DM) + 2 * lane;
            f32x4 v[4][2]; float s = 0.f;
#pragma unroll
            for (int j = 0; j < 4; ++j) { v[j][0] = xr[128 * j]; v[j][1] = xr[128 * j + 1];
#pragma unroll
                for (int k = 0; k < 4; ++k) { const u32x4 y = yr[k][64 * j];
                    v[j][0].x += wk[k] * bf_lo(y.x); v[j][0].y += wk[k] * bf_hi(y.x); v[j][0].z += wk[k] * bf_lo(y.y); v[j][0].w += wk[k] * bf_hi(y.y);
                    v[j][1].x += wk[k] * bf_lo(y.z); v[j][1].y += wk[k] * bf_hi(y.z); v[j][1].z += wk[k] * bf_lo(y.w); v[j][1].w += wk[k] * bf_hi(y.w); }
#pragma unroll
                for (int h = 0; h < 2; ++h) s += (v[j][h].x * v[j][h].x + v[j][h].y * v[j][h].y) + (v[j][h].z * v[j][h].z + v[j][h].w * v[j][h].w); }
            const float rs = 1.f / sqrtf(wave_sum(s) * (1.f / DM) + NORM_EPS);
            GAS f32x4* orow = (GAS f32x4*)(pout + (size_t)m * DM) + 2 * lane;
#pragma unroll
            for (int j = 0; j < 4; ++j)
#pragma unroll
                for (int h = 0; h < 2; ++h) { const f32x4 gg = *((const GAS f32x4*)pfin + 2 * lane + 128 * j + h);
                    orow[128 * j + h] = (f32x4){v[j][h].x * rs * gg.x, v[j][h].y * rs * gg.y, v[j][h].z * rs * gg.z, v[j][h].w * rs * gg.w}; }
        }
    }
#undef IN
#undef SEAM
}


#if PROBE_REP >= 0
__global__ void __launch_bounds__(512, 2) probe_k(Params p_unused) {
    extern __shared__ __attribute__((aligned(16))) unsigned char lds_raw[];
    LAS unsigned char* lds = (LAS unsigned char*)lds_raw;
    const int G = gridDim.x, bx = blockIdx.x;
    const int vcu = (G % 8 == 0) ? (bx % 8) * (G / 8) + bx / 8 : bx;
    KP kp = kparams(); unsigned char* ws = kp->ws; unsigned* ctl = (unsigned*)(ws + WS_CTL);
    LAS int* pre = (LAS int*)(lds + MISC_OFF + 64);
    LAS int* cntl = (LAS int*)(lds + MISC_OFF + 256);
    { const int tid = threadIdx.x;
      if (tid < 32) cntl[tid] = (int)__hip_atomic_load(ctl + CW_CNT + 64 * tid, __ATOMIC_RELAXED, __HIP_MEMORY_SCOPE_AGENT);
      __syncthreads();
      if (tid == 0) { int a = 0; for (int e = 0; e < 32; ++e) { pre[e] = a; a += (cntl[e] + 255) >> 8; } pre[32] = a; }
      __syncthreads(); }
    const MoeTab MT{pre, cntl};
    if (PROBE_REP == 1) { ProbIn P{ws, kp->w_in, G, bx, lds, kp->conv_w}; gm::gemm_stream<ProbIn, PROBE_ABL>(lds, P); }
    if (PROBE_REP == 7) { ProbMoe1 P{ws, kp->w_gate, kp->w_up, kp->b_gate, kp->b_up, MT, G, vcu}; gm::gemm_stream<ProbMoe1, PROBE_ABL>(lds, P); }
    if (PROBE_REP == 8) { ProbMoe2 P{ws, kp->w_down, kp->b_down, MT, G, vcu}; gm::gemm_stream<ProbMoe2, PROBE_ABL>(lds, P); }
}
#endif

extern "C" void kernel_launch(void* const* d_in, const int* in_sizes, int n_in, void* d_out, int out_size, void* d_ws, size_t ws_size, hipStream_t stream) {
    static int grid = 0;
    if (grid == 0) {
        if (n_in != 17 || in_sizes[0] != NTOK * DM || out_size != NTOK * DM || ws_size < WS_END) {
            fprintf(stderr, "kernel_launch: unexpected shapes (n_in %d, in0 %d, out %d, ws %zu); nothing launched\n", n_in, n_in > 0 ? in_sizes[0] : -1, out_size, ws_size); grid = -1; return; }
        int dev = 0, cus = 0, per_cu = 0;
        if (hipGetDevice(&dev) != hipSuccess || hipDeviceGetAttribute(&cus, hipDeviceAttributeMultiprocessorCount, dev) != hipSuccess) { grid = -1; return; }
        if (hipFuncSetAttribute((const void*)mega, hipFuncAttributeMaxDynamicSharedMemorySize, LDS_BYTES) != hipSuccess) { fprintf(stderr, "kernel_launch: hipFuncSetAttribute failed\n"); grid = -1; return; }
        if (hipOccupancyMaxActiveBlocksPerMultiprocessor(&per_cu, (const void*)mega, 512, LDS_BYTES) != hipSuccess || per_cu < 1) {
            fprintf(stderr, "kernel_launch: occupancy query says %d blocks per CU\n", per_cu); }
        (void)hipGetLastError();
        grid = cus;
    }
    if (grid < 0) return;
    (void)hipMemsetAsync((char*)d_ws + WS_CTL, 0, CTL_BYTES, stream);
    Params p{};
    p.x = (const float*)d_in[0]; p.norm_mix = (const float*)d_in[1]; p.w_in = (const float*)d_in[2]; p.conv_w = (const float*)d_in[3];
    p.w_conv_out = (const float*)d_in[4]; p.w_attn_out = (const float*)d_in[5]; p.w_o = (const float*)d_in[6]; p.norm_ffn = (const float*)d_in[7];
    p.w_router = (const float*)d_in[8]; p.b_router = (const float*)d_in[9]; p.w_gate = (const float*)d_in[10]; p.b_gate = (const float*)d_in[11];
    p.w_up = (const float*)d_in[12]; p.b_up = (const float*)d_in[13]; p.w_down = (const float*)d_in[14]; p.b_down = (const float*)d_in[15];
    p.norm_final = (const float*)d_in[16];
    p.out = (float*)d_out; p.ws = (unsigned char*)d_ws;
#if MK_FUSED
    p.ph_lo = 0; p.ph_hi = N_PHASES;
    hipLaunchKernelGGL(mega, dim3(grid), dim3(512), LDS_BYTES, stream, p);
#if PROBE_REP >= 0
    { static bool once = false; if (!once) { once = true; (void)hipFuncSetAttribute((const void*)probe_k, hipFuncAttributeMaxDynamicSharedMemorySize, LDS_BYTES); }
      hipLaunchKernelGGL(probe_k, dim3(grid), dim3(512), LDS_BYTES, stream, p); }
#endif
#else
    for (int ph = 0; ph < N_PHASES; ++ph) { p.ph_lo = ph; p.ph_hi = ph + 1; hipLaunchKernelGGL(mega, dim3(grid), dim3(512), LDS_BYTES, stream, p); }
#endif
}
```

```cpp
#include <hip/hip_runtime.h>
#include <cstdint>
#include <cstdio>

typedef unsigned short bf16_t;
typedef short bf16x8 __attribute__((ext_vector_type(8)));
typedef short s16x4 __attribute__((ext_vector_type(4)));
typedef float f32x4 __attribute__((ext_vector_type(4)));
typedef float f32x16 __attribute__((ext_vector_type(16)));
typedef unsigned u32x4 __attribute__((ext_vector_type(4)));
typedef unsigned u32x2 __attribute__((ext_vector_type(2)));
typedef float f32x2 __attribute__((ext_vector_type(2)));
#define LAS __attribute__((address_space(3)))
#define GAS __attribute__((address_space(1)))

constexpr int DM = 2048, SEQ = 4096, NTOK = 8192, NHEAD = 16, HDIM = 128, NEXP = 32, INC = 16384;
constexpr float NORM_EPS = 1e-5f;
constexpr int N_PHASES = 10;
#ifndef PROBE_REP
#define PROBE_REP -1
#endif
#ifndef PROBE_ABL
#define PROBE_ABL 0
#endif
#ifndef G_DMAPOS
#define G_DMAPOS 2
#endif
#ifndef G_BT
#define G_BT 1
#endif
#ifndef G_PRIO
#define G_PRIO 1
#endif
#ifndef MK_FUSED
#define MK_FUSED 1
#endif

constexpr size_t MiB = 1u << 20;
constexpr size_t WS_CTL = 0, CTL_BYTES = 1 * MiB;
constexpr size_t WS_ROPE = 1 * MiB;
constexpr size_t WS_KMSUM = 256 * 1024;
constexpr size_t WS_SB = 36 * MiB;
constexpr size_t WS_SLOT = 2 * MiB;
constexpr size_t WS_TOKW = 2 * MiB + 128 * 1024;
constexpr size_t WS_EROWS = 2 * MiB + 256 * 1024;
constexpr size_t WS_XN = 4 * MiB;
constexpr size_t WS_BG = 36 * MiB, WS_CG = 68 * MiB, WS_HC = 100 * MiB, WS_GC = 132 * MiB, WS_GA = 164 * MiB;
constexpr size_t WS_Q = 196 * MiB, WS_K = 228 * MiB, WS_V = 260 * MiB;
constexpr size_t WS_CONV = 292 * MiB, WS_ATT = 324 * MiB, WS_MRG = 356 * MiB;
constexpr size_t WS_H1 = 388 * MiB;
constexpr size_t WS_HID = 452 * MiB;
constexpr size_t WS_YB = 612 * MiB;
constexpr size_t WS_W16IN = 772 * MiB;
constexpr size_t WS_W16C = 836 * MiB, WS_W16A = 844 * MiB, WS_W16O = 852 * MiB;
constexpr size_t WS_END = 860 * MiB;
constexpr int CW_BAR = 4096;
constexpr int CW_CNT = 16384;

constexpr int LDS_MAIN = 131072;
constexpr int MISC_OFF = LDS_MAIN;
constexpr int LDS_BYTES = LDS_MAIN + 4096;

__device__ __forceinline__ unsigned cvtpk(float lo, float hi) { unsigned r; asm("v_cvt_pk_bf16_f32 %0, %1, %2" : "=v"(r) : "v"(lo), "v"(hi)); return r; }
__device__ __forceinline__ float bf_lo(unsigned w) { return __uint_as_float(w << 16); }
__device__ __forceinline__ float bf_hi(unsigned w) { return __uint_as_float(w & 0xffff0000u); }
__device__ __forceinline__ float wave_sum(float v) {
#pragma unroll
    for (int o = 1; o < 64; o <<= 1) v += __shfl_xor(v, o);
    return v;
}
__device__ __forceinline__ float fast_exp(float x) { return __builtin_amdgcn_exp2f(x * 1.4426950408889634f); }
__device__ __forceinline__ float sigmoidf_(float x) { return __builtin_amdgcn_rcpf(1.f + fast_exp(-x)); }

#define XB_TMO      128
#define XB_XCNT(j)  (256  + 64 * (j))
#define XB_XSUB(j)  (1280 + 64 * (j))
#define XB_XGEN(j)  (2304 + 64 * (j))
#define XB_TOP      3328
#define XB_TOPGEN   3392
#define XCD_BAR_WORDS 3456
#define XB_SPIN_CAP (1u << 18)
__device__ __forceinline__ unsigned xb_ld(unsigned* p)              { return __hip_atomic_load(p, __ATOMIC_RELAXED, __HIP_MEMORY_SCOPE_AGENT); }
__device__ __forceinline__ unsigned xb_add(unsigned* p, unsigned v) { return __hip_atomic_fetch_add(p, v, __ATOMIC_RELAXED, __HIP_MEMORY_SCOPE_AGENT); }
__device__ __forceinline__ unsigned xb_xcc_id() { return (unsigned)__builtin_amdgcn_s_getreg((3 << 11) | 20) & 0xFu; }
#define XB_SPIN(cond, bar) do { unsigned _sp = 0; while (cond) { __builtin_amdgcn_s_sleep(1); \
    if ((++_sp & 255u) == 0u) { if (xb_ld(&(bar)[XB_TMO])) break; if (_sp > XB_SPIN_CAP) { atomicAdd(&(bar)[XB_TMO], 1u); break; } } } } while (0)
struct XcdBarrier { unsigned* bar; volatile LAS unsigned* st; };
__device__ __forceinline__ XcdBarrier xcd_barrier_post(unsigned* bar, volatile LAS unsigned* st) {
    XcdBarrier b; b.bar = bar; b.st = st;
    if (threadIdx.x == 0) (void)xb_add(&bar[XB_XCNT(xb_xcc_id())], 1u);
    return b;
}
__device__ __forceinline__ void xcd_barrier_complete(unsigned* bar, unsigned x, unsigned& nloc, unsigned& nx) {
    const unsigned G = gridDim.x * gridDim.y * gridDim.z;
    unsigned sum, cnt, mine, sp = 0u;
    for (;;) {
        sum = 0u; cnt = 0u; mine = 0u;
#pragma unroll
        for (unsigned j = 0; j < 16; ++j) { const unsigned c = xb_ld(&bar[XB_XCNT(j)]); sum += c; cnt += (c > 0u) ? 1u : 0u; mine = (j == x) ? c : mine; }
        if (sum == G) break;
        __builtin_amdgcn_s_sleep(1);
        if ((++sp & 255u) == 0u) { if (xb_ld(&bar[XB_TMO])) break; if (sp > XB_SPIN_CAP) { atomicAdd(&bar[XB_TMO], 1u); break; } }
    }
    nloc = mine > 0u ? mine : 1u; nx = cnt > 0u ? cnt : 1u;
}
__device__ __forceinline__ void xcd_barrier(const XcdBarrier& b) {
    asm volatile("s_waitcnt vmcnt(0)" ::: "memory");
    __syncthreads();
    if (threadIdx.x == 0) {
        unsigned* bar = b.bar; const unsigned bx_ = xb_xcc_id();
        __builtin_amdgcn_s_waitcnt(0);
        unsigned nloc = b.st[0], nx = b.st[1];
        if (nloc == 0u) { xcd_barrier_complete(bar, bx_, nloc, nx); b.st[0] = nloc; b.st[1] = nx; }
        const unsigned old = xb_add(&bar[XB_XSUB(bx_)], 1u);
        const unsigned gen = old / nloc;
        if (old + 1u == (gen + 1u) * nloc) {
            __builtin_amdgcn_fence(__ATOMIC_RELEASE, "agent");
            asm volatile("s_waitcnt vmcnt(0)" ::: "memory");
            const unsigned og = xb_add(&bar[XB_TOP], 1u);
            const unsigned tg = og / nx;
            if (og + 1u == (tg + 1u) * nx) xb_add(&bar[XB_TOPGEN], 1u);
            else XB_SPIN(xb_ld(&bar[XB_TOPGEN]) == tg, bar);
            __builtin_amdgcn_fence(__ATOMIC_ACQUIRE, "agent");
            xb_add(&bar[XB_XGEN(bx_)], 1u);
            asm volatile("s_waitcnt vmcnt(0)" ::: "memory");
        } else {
            XB_SPIN(xb_ld(&bar[XB_XGEN(bx_)]) == gen, bar);
            __builtin_amdgcn_fence(__ATOMIC_ACQUIRE, "agent");
            asm volatile("s_waitcnt vmcnt(0)" ::: "memory");
        }
    }
    __syncthreads();
}

namespace gm {
constexpr int HTB = 16384, SB0 = 65536, NT = 32;
__device__ __forceinline__ int lds_byte(int r, int c) { const int st = (r >> 4) * 2 + (c >> 5), rr = r & 15, cc = c & 31, ob = rr * 64 + cc * 2; return st * 1024 + (ob ^ (((ob >> 9) & 1) << 5)); }
__device__ __forceinline__ void stage_rc(int b, int& R, int& C) { const int st = b / 1024, sb = b % 1024, swz = sb ^ (((sb >> 9) & 1) << 5); R = (st >> 1) * 16 + swz / 64; C = (st & 1) * 32 + (swz % 64) / 2; }
__device__ __forceinline__ int inv_perm32(int q) { return 16 * ((q >> 2) & 1) + 4 * (q >> 3) + (q & 3); }
__device__ __forceinline__ int perm32(int rho) { const int n = rho >> 4, i = rho & 15; return 8 * (i >> 2) + 4 * n + (i & 3); }
__device__ __forceinline__ int bswz(int R) { return ((R >> 1) & 7) ^ ((R >> 4) & 1); }

typedef __amdgpu_buffer_rsrc_t rsrc_t;
__device__ __forceinline__ rsrc_t mk_rsrc(const void* base, unsigned bytes) { return __builtin_amdgcn_make_buffer_rsrc((void*)base, 0, bytes, 0x00020000); }

struct Unit {
    unsigned aS;
    unsigned bS0;
    int pm;
    int code;
    __device__ __forceinline__ int pn() const { return code & 255; }
    __device__ __forceinline__ int e() const { return (code >> 8) & 255; }
    __device__ __forceinline__ int aux() const { return (code >> 16) & 255; }
    __device__ __forceinline__ int keep() const { return (code >> 24) & 1; }
};
__device__ __forceinline__ int mk_code(int pn, int e, int aux, int keep) { return pn | (e << 8) | (aux << 16) | (keep << 24); }

template <class P, int ABL = 0>
__device__ __forceinline__ void gemm_stream(LAS unsigned char* lds, const P& S) {
    const int tid = threadIdx.x, wid = __builtin_amdgcn_readfirstlane(tid >> 6), lane = tid & 63;
    const int wr = wid >> 2, wc = wid & 3, fr = lane & 15, fq = lane >> 4;
    constexpr unsigned LDB4 = (unsigned)P::LDB * 4u;
    constexpr unsigned TSTEP = 64u * LDB4;
    int R0, C0, R1, C1; stage_rc(tid * 16, R0, C0); stage_rc(tid * 16 + 8192, R1, C1);
    const unsigned ldsw = (unsigned)wid * 1024u;
    const int aoff = lds_byte(wr * 64 + fr, fq * 8);
    const int bquad = (lane & 7) + 8 * (lane >> 4), bpar = (lane >> 3) & 1;
    unsigned bw0;
    { const int q = 4 * bquad; const int R = P::PERM ? ((q & ~31) + inv_perm32(q & 31)) : q; bw0 = (unsigned)(SB0 + R * 128 + ((wid ^ bswz(R)) << 4) + bpar * 8); }
    const unsigned brow = (unsigned)(SB0 + (wc * 32 + fr) * 128 + ((fq ^ (fr >> 1)) << 4));
    const unsigned boffs = (unsigned)(8 * wid + 4 * bpar) * LDB4 + (unsigned)bquad * 16u;
    constexpr bool B16 = P::B16;
    constexpr unsigned LDB2 = (unsigned)P::LDB * 2u, TSTEP16 = 64u * LDB2;
    const int boct = (lane & 7) + 8 * (lane >> 4);
    const unsigned boffs16 = (unsigned)(8 * wid + 4 * bpar) * LDB2 + (unsigned)boct * 16u;
    const unsigned bw16 = P::PERM ? (unsigned)(SB0 + 4096 * (boct >> 2) + 512 * (boct & 3) + (((wid ^ (2 * (boct & 3)) ^ ((boct >> 2) & 1)) & 7) << 4) + bpar * 8)
                                  : (unsigned)(SB0 + 1024 * boct + (((wid ^ (4 * (boct & 1)) ^ (2 * ((boct >> 1) & 1)) ^ ((boct >> 2) & 1)) & 7) << 4) + bpar * 8);
    const unsigned brow16 = brow ^ (unsigned)((wc & 1) << 4);
    const rsrc_t rA = S.adesc();
    constexpr bool BT = P::BT;
    const int boffT = lds_byte(wc * 32 + fr, fq * 8);
    const unsigned vb = (unsigned)((P::PERM ? ((R0 & ~31) + perm32(R0 & 31)) : R0) * 4096 + C0 * 2);

#define G_SA(b, h) (((b) * 2 + (h)) * HTB)
#define G_DMA(bufoff, soff, o) do { if (ABL != 3) __builtin_amdgcn_raw_ptr_buffer_load_lds(rA, (LAS void*)(lds + (bufoff) + ldsw), 16, (o), (soff), 0, 0); } while (0)
#define G_VO(h, i) (P::GATHER ? vo[2 * (h) + (i)] : vo[0])
#define G_SO(soff, h, i) (P::GATHER ? (soff) : (soff) + (unsigned)(128 * (h) + 64 * (i)) * (unsigned)P::LDA2)
#define G_DMAP(b, h, i, soff) G_DMA(G_SA(b, h) + 8192 * (i), G_SO(soff, h, i), G_VO(h, i))
#define G_LDA(dst, b, h) do { if (ABL == 4) { _Pragma("unroll") for (int m = 0; m < 4; ++m) _Pragma("unroll") for (int k = 0; k < 2; ++k) asm volatile("" : "+v"(dst[m][k])); break; } _Pragma("unroll") for (int m = 0; m < 4; ++m) _Pragma("unroll") for (int k = 0; k < 2; ++k) dst[m][k] = *(const LAS bf16x8*)(lds + G_SA(b, h) + aoff + m * 2048 + k * 1024); } while (0)
#define G_LDB(dst, b, bj) do { if (ABL == 4) { _Pragma("unroll") for (int n = 0; n < 2; ++n) _Pragma("unroll") for (int k = 0; k < 2; ++k) asm volatile("" : "+v"(dst[n][k])); break; } _Pragma("unroll") for (int n = 0; n < 2; ++n) _Pragma("unroll") for (int k = 0; k < 2; ++k) dst[n][k] = *(const LAS bf16x8*)(lds + ((brow ^ (unsigned)((k << 6) | (n << 4))) + n * 2048 + (bj) * 16384 + (b) * 32768)); } while (0)
#define G_MMA(ai, bj, At, Bt, DMA_STMT) do { if (ABL == 1) { _Pragma("unroll") for (int m = 0; m < 4; ++m) _Pragma("unroll") for (int k = 0; k < 2; ++k) asm volatile("" :: "v"(At[m][k])); _Pragma("unroll") for (int n = 0; n < 2; ++n) _Pragma("unroll") for (int k = 0; k < 2; ++k) asm volatile("" :: "v"(Bt[n][k])); DMA_STMT; break; } \
        if (G_PRIO == 1) __builtin_amdgcn_s_setprio(1); \
        _Pragma("unroll") for (int m = 0; m < 2; ++m) _Pragma("unroll") for (int n = 0; n < 2; ++n) _Pragma("unroll") for (int k = 0; k < 2; ++k) acc[ai][bj][m][n] = __builtin_amdgcn_mfma_f32_16x16x32_bf16(Bt[n][k], At[m][k], acc[ai][bj][m][n], 0, 0, 0); \
        G_SCHED; DMA_STMT; G_SCHED; \
        _Pragma("unroll") for (int m = 2; m < 4; ++m) _Pragma("unroll") for (int n = 0; n < 2; ++n) _Pragma("unroll") for (int k = 0; k < 2; ++k) acc[ai][bj][m][n] = __builtin_amdgcn_mfma_f32_16x16x32_bf16(Bt[n][k], At[m][k], acc[ai][bj][m][n], 0, 0, 0); \
        if (G_PRIO == 1) __builtin_amdgcn_s_setprio(0); } while (0)
#define G_DMAB(bufoff, desc, soff) __builtin_amdgcn_raw_ptr_buffer_load_lds((desc), (LAS void*)(lds + (bufoff) + ldsw), 16, vb, (soff), 0, 0)
#define G_STB(b, bj, desc, so) do { const rsrc_t _d = (desc); const unsigned _s = (so) + (unsigned)(bj) * 524288u; G_DMAB(SB0 + (b) * 32768 + (bj) * 16384, _d, _s); G_DMAB(SB0 + (b) * 32768 + (bj) * 16384 + 8192, _d, _s + 262144u); } while (0)
#define G_STA(b, h, so) do { G_DMAP(b, h, 0, so); G_DMAP(b, h, 1, so); } while (0)
#define G_LDBT(dst, b, bj) do { _Pragma("unroll") for (int n = 0; n < 2; ++n) _Pragma("unroll") for (int k = 0; k < 2; ++k) dst[n][k] = *(const LAS bf16x8*)(lds + SB0 + (b) * 32768 + (bj) * 16384 + boffT + n * 2048 + k * 1024); } while (0)
#define G_WAIT_V0 asm volatile("s_waitcnt vmcnt(0)" ::: "memory")
#define G_WAIT_L0 asm volatile("s_waitcnt lgkmcnt(0)" ::: "memory")
#define G_WAIT_B(first) do { if (first) asm volatile("; first load segment of a unit (peel: its counted wait may leave the epilogue's stores in flight)" ::: "memory"); } while (0)
#define G_BAR __builtin_amdgcn_s_barrier()
#define G_SCHED __builtin_amdgcn_sched_barrier(0)
#define G_BLOAD(desc, soff) do { if (ABL == 2) { asm volatile("" : "+v"(br[0]), "+v"(br[1]), "+v"(br[2]), "+v"(br[3])); break; } const rsrc_t _d = (desc); const unsigned _s = (soff); _Pragma("unroll") for (int i = 0; i < 4; ++i) br[i] = __builtin_amdgcn_raw_buffer_load_b128(_d, boffs, _s + (unsigned)i * LDB4, 0); } while (0)
#define G_LDB16(dst, b, bj) do { _Pragma("unroll") for (int n = 0; n < 2; ++n) _Pragma("unroll") for (int k = 0; k < 2; ++k) dst[n][k] = *(const LAS bf16x8*)(lds + ((brow16 ^ (unsigned)((k << 6) | (n << (P::PERM ? 4 : 5)))) + n * 2048 + (bj) * 16384 + (b) * 32768)); } while (0)
#define G_BLOAD16(desc, soff) do { const rsrc_t _d = (desc); const unsigned _s = (soff); _Pragma("unroll") for (int i = 0; i < 4; ++i) br[i] = __builtin_amdgcn_raw_buffer_load_b128(_d, boffs16, _s + (unsigned)i * LDB2, 0); } while (0)
#define G_BWRITE16(b) do { _Pragma("unroll") for (int c = 0; c < 8; ++c) { const unsigned sel_ = (c & 1) ? 0x07060302u : 0x05040100u; u32x2 w_; \
        w_.x = __builtin_amdgcn_perm(br[1][c >> 1], br[0][c >> 1], sel_); w_.y = __builtin_amdgcn_perm(br[3][c >> 1], br[2][c >> 1], sel_); \
        const unsigned ad_ = P::PERM ? ((bw16 ^ (unsigned)(((((c >> 1) & 1) ^ (c >> 2)) & 1) << 4)) + 2048u * (c >> 2) + 128u * (c & 3)) : ((bw16 ^ (unsigned)((c >> 1) << 4)) + 128u * c); \
        *(LAS u32x2*)(lds + ad_ + (b) * 32768) = w_; } } while (0)
#define G_WAITV(n) asm volatile("s_waitcnt vmcnt(" #n ")" ::: "memory")
#define G_F(x) __uint_as_float(x)
#define G_BWRITE(b, bj) do { if (ABL == 5) break; _Pragma("unroll") for (int j = 0; j < 4; ++j) { u32x2 w_; w_.x = cvtpk(G_F(br[0][j]), G_F(br[1][j])); w_.y = cvtpk(G_F(br[2][j]), G_F(br[3][j])); \
        *(LAS u32x2*)(lds + (bw0 ^ (unsigned)((j >> 1) << 4)) + j * 128 + (bj) * 16384 + (b) * 32768) = w_; } } while (0)

    Unit cur, nxt; int ui = 0;
    if (!S.next(0, cur)) return;
    f32x4 acc[2][2][4][2];
#pragma unroll
    for (int a = 0; a < 2; ++a)
#pragma unroll
        for (int b = 0; b < 2; ++b)
#pragma unroll
            for (int m = 0; m < 4; ++m)
#pragma unroll
                for (int n = 0; n < 2; ++n) acc[a][b][m][n] = (f32x4){0.f, 0.f, 0.f, 0.f};
    if constexpr (P::ACCINIT) S.acc_init(acc, cur, wr, wc, fr, fq);
    bf16x8 At[4][2], Bf0[2][2], Bf1[2][2];
    u32x4 br[4];
    unsigned vo[4];
    S.aoff(cur, vo, R0, C0, R1, C1);
    if constexpr (BT) {
    { const rsrc_t rB = S.bdesc(cur.aux(), 0);
      G_STB(0, 0, rB, cur.bS0); G_STB(0, 1, rB, cur.bS0); G_STA(0, 0, cur.aS); G_STA(0, 1, cur.aS);
      G_STB(1, 0, rB, cur.bS0 + 128u); G_STA(1, 0, cur.aS + 128u); G_STB(1, 1, rB, cur.bS0 + 128u); }
    G_WAITV(6); G_BAR;
    if (wr == 1) G_BAR;
    } else if constexpr (B16) {
    G_BLOAD16(S.bdesc(cur.aux(), 0), cur.bS0);
    G_DMAP(0, 0, 0, cur.aS); G_DMAP(0, 0, 1, cur.aS); G_DMAP(0, 1, 0, cur.aS); G_DMAP(0, 1, 1, cur.aS);
    G_WAIT_V0; G_BWRITE16(0); G_SCHED;
    G_BLOAD16(S.bdesc(cur.aux(), 0), cur.bS0 + TSTEP16); G_WAIT_V0; G_BWRITE16(1); G_SCHED;
    G_BLOAD16(S.bdesc(cur.aux(), 0), cur.bS0 + 2u * TSTEP16);
    G_DMAP(1, 0, 0, cur.aS + 128u); G_DMAP(1, 0, 1, cur.aS + 128u);
    G_WAIT_L0; G_BAR;
    if (wr == 1) G_BAR;
    } else {
    G_BLOAD(S.bdesc(cur.aux(), 0), cur.bS0);
    G_DMAP(0, 0, 0, cur.aS); G_DMAP(0, 0, 1, cur.aS); G_DMAP(0, 1, 0, cur.aS); G_DMAP(0, 1, 1, cur.aS);
    G_WAIT_B(true); G_BWRITE(0, 0); G_SCHED;
    G_BLOAD(S.bdesc(cur.aux(), 1), cur.bS0 + P::B1OFF); G_WAIT_B(true); G_BWRITE(0, 1); G_SCHED;
    G_BLOAD(S.bdesc(cur.aux(), 0), cur.bS0 + TSTEP); G_WAIT_B(true); G_BWRITE(1, 0); G_SCHED;
    G_BLOAD(S.bdesc(cur.aux(), 1), cur.bS0 + P::B1OFF + TSTEP);
    G_DMAP(1, 0, 0, cur.aS + 128u); G_DMAP(1, 0, 1, cur.aS + 128u);
    G_WAIT_L0; G_BAR;
    if (wr == 1) G_BAR;
    }
    for (;;) {
        const bool has_next = S.next(ui + 1, nxt);
        if (!has_next) nxt = cur;
        if constexpr (BT) {
        for (int t = 0; t < NT; t += 2) {
            const bool last = (t == NT - 2);
            const unsigned a1 = cur.aS + (unsigned)(t + 1) * 128u;
            const unsigned a2 = last ? nxt.aS : cur.aS + (unsigned)(t + 2) * 128u;
            const unsigned a3 = a2 + 128u;
            const unsigned b2 = last ? nxt.bS0 : cur.bS0 + (unsigned)(t + 2) * 128u;
            const unsigned b3 = b2 + 128u;
            const int bsl = last ? nxt.aux() : cur.aux();
            G_LDBT(Bf0, 0, 0); G_LDBT(Bf1, 0, 1); G_SCHED; G_LDA(At, 0, 0); G_SCHED; G_STA(1, 1, a1);
            G_WAITV(8); G_WAIT_L0; G_BAR; G_MMA(0, 0, At, Bf0, (void)0); G_MMA(0, 1, At, Bf1, (void)0); G_BAR; G_SCHED;
            G_LDA(At, 0, 1); G_SCHED; G_STB(0, 0, S.bdesc(bsl, 0), b2); G_STB(0, 1, S.bdesc(bsl, 0), b2); G_STA(0, 0, a2);
            G_WAITV(8); G_WAIT_L0; G_BAR; G_MMA(1, 0, At, Bf0, (void)0); G_MMA(1, 1, At, Bf1, (void)0); G_BAR; G_SCHED;
            G_LDBT(Bf0, 1, 0); G_LDBT(Bf1, 1, 1); G_SCHED; G_LDA(At, 1, 0); G_SCHED; G_STA(0, 1, a2);
            G_WAITV(8); G_WAIT_L0; G_BAR; G_MMA(0, 0, At, Bf0, (void)0); G_MMA(0, 1, At, Bf1, (void)0); G_BAR; G_SCHED;
            G_LDA(At, 1, 1); G_SCHED; G_STB(1, 0, S.bdesc(bsl, 0), b3); G_STB(1, 1, S.bdesc(bsl, 0), b3); G_STA(1, 0, a3);
            G_WAITV(8); G_WAIT_L0; G_BAR; G_MMA(1, 0, At, Bf0, (void)0); G_MMA(1, 1, At, Bf1, (void)0); G_BAR; G_SCHED;
        }
        } else if constexpr (B16) {
        for (int t = 0; t < NT; t += 2) {
            const bool last = (t == NT - 2), nx4 = (t + 4 >= NT);
            const unsigned a1 = cur.aS + (unsigned)(t + 1) * 128u;
            const unsigned a2 = last ? nxt.aS : cur.aS + (unsigned)(t + 2) * 128u;
            const unsigned a3 = a2 + 128u;
            const unsigned b3 = last ? nxt.bS0 + TSTEP16 : cur.bS0 + (unsigned)(t + 3) * TSTEP16;
            const unsigned b4 = nx4 ? nxt.bS0 + (unsigned)(t + 4 - NT) * TSTEP16 : cur.bS0 + (unsigned)(t + 4) * TSTEP16;
            const int sel3 = last ? nxt.aux() : cur.aux(), sel4 = nx4 ? nxt.aux() : cur.aux();
#define G_DL0(b, h, so) do { if (G_DMAPOS >= 1) G_DMAP(b, h, 0, so); } while (0)
#define G_DL1(b, h, so) do { if (G_DMAPOS == 1) G_DMAP(b, h, 1, so); } while (0)
#define G_DM0(b, h, so) do { if (G_DMAPOS == 0) G_DMAP(b, h, 0, so); } while (0)
#define G_DM1(b, h, so) do { if (G_DMAPOS != 1) G_DMAP(b, h, 1, so); } while (0)
            G_WAITV(6); G_LDB16(Bf0, 0, 0); G_LDB16(Bf1, 0, 1); G_SCHED; G_LDA(At, 0, 0); G_SCHED; G_DL0(1, 1, a1); G_DL1(1, 1, a1);
            G_WAIT_L0; G_BAR; G_MMA(0, 0, At, Bf0, G_DM0(1, 1, a1)); G_MMA(0, 1, At, Bf1, G_DM1(1, 1, a1)); G_BAR; G_SCHED;
            G_WAITV(2); G_BWRITE16(0); G_SCHED; G_BLOAD16(S.bdesc(sel3, 0), b3); G_SCHED;
            G_LDA(At, 0, 1); G_SCHED; G_DL0(0, 0, a2); G_DL1(0, 0, a2);
            G_WAIT_L0; G_BAR; G_MMA(1, 0, At, Bf0, G_DM0(0, 0, a2)); G_MMA(1, 1, At, Bf1, G_DM1(0, 0, a2)); G_BAR; G_SCHED;
            G_WAITV(6); G_LDB16(Bf0, 1, 0); G_LDB16(Bf1, 1, 1); G_SCHED; G_LDA(At, 1, 0); G_SCHED; G_DL0(0, 1, a2); G_DL1(0, 1, a2);
            G_WAIT_L0; G_BAR; G_MMA(0, 0, At, Bf0, G_DM0(0, 1, a2)); G_MMA(0, 1, At, Bf1, G_DM1(0, 1, a2)); G_BAR; G_SCHED;
            G_WAITV(2); G_BWRITE16(1); G_SCHED; G_BLOAD16(S.bdesc(sel4, 0), b4); G_SCHED;
            G_LDA(At, 1, 1); G_SCHED; G_DL0(1, 0, a3); G_DL1(1, 0, a3);
            G_WAIT_L0; G_BAR; G_MMA(1, 0, At, Bf0, G_DM0(1, 0, a3)); G_MMA(1, 1, At, Bf1, G_DM1(1, 0, a3)); G_BAR; G_SCHED;
#undef G_DL0
#undef G_DL1
#undef G_DM0
#undef G_DM1
        }
        } else {
        for (int t = 0; t < NT; t += 2) {
            const bool last = (t == NT - 2);
            const unsigned a1 = cur.aS + (unsigned)(t + 1) * 128u;
            const unsigned a2 = last ? nxt.aS : cur.aS + (unsigned)(t + 2) * 128u;
            const unsigned a3 = a2 + 128u;
            const unsigned b20 = last ? nxt.bS0 : cur.bS0 + (unsigned)(t + 2) * TSTEP;
            const unsigned b21 = b20 + P::B1OFF;
            const int bsl = last ? nxt.aux() : cur.aux();
            G_WAIT_B(t == 0); G_BWRITE(1, 1); G_SCHED; G_BLOAD(S.bdesc(bsl, 0), b20); G_SCHED;
            G_LDB(Bf0, 0, 0); G_SCHED; G_LDA(At, 0, 0);
            G_WAIT_L0; G_BAR; G_LDB(Bf1, 0, 1); G_SCHED; G_MMA(0, 0, At, Bf0, G_DMAP(1, 1, 0, a1)); G_MMA(0, 1, At, Bf1, G_DMAP(1, 1, 1, a1)); G_BAR; G_SCHED;
            if (P::GATHER) { if (last) { int tz = threadIdx.x; asm volatile("" : "+v"(tz)); int r0, c0, r1, c1; stage_rc(tz * 16, r0, c0); stage_rc(tz * 16 + 8192, r1, c1); S.aoff(nxt, vo, r0, c0, r1, c1); } }
            G_WAIT_B(P::GATHER && last); G_BWRITE(0, 0); G_SCHED; G_BLOAD(S.bdesc(bsl, 1), b21); G_SCHED;
            G_LDA(At, 0, 1); G_SCHED;
            G_WAIT_L0; G_BAR; G_MMA(1, 0, At, Bf0, G_DMAP(0, 0, 0, a2)); G_MMA(1, 1, At, Bf1, G_DMAP(0, 0, 1, a2)); G_BAR; G_SCHED;
            G_WAIT_B(false); G_BWRITE(0, 1); G_SCHED; G_BLOAD(S.bdesc(bsl, 0), b20 + TSTEP); G_SCHED;
            G_LDB(Bf0, 1, 0); G_SCHED; G_LDA(At, 1, 0);
            G_WAIT_L0; G_BAR; G_LDB(Bf1, 1, 1); G_SCHED; G_MMA(0, 0, At, Bf0, G_DMAP(0, 1, 0, a2)); G_MMA(0, 1, At, Bf1, G_DMAP(0, 1, 1, a2)); G_BAR; G_SCHED;
            G_WAIT_B(false); G_BWRITE(1, 0); G_SCHED; G_BLOAD(S.bdesc(bsl, 1), b21 + TSTEP); G_SCHED;
            G_LDA(At, 1, 1); G_SCHED;
            G_WAIT_L0; G_BAR; G_MMA(1, 0, At, Bf0, G_DMAP(1, 0, 0, a3)); G_MMA(1, 1, At, Bf1, G_DMAP(1, 0, 1, a3)); G_BAR; G_SCHED;
        }
        }
        if (wr == 0) G_BAR;
        if (ABL == 0) S.epi(acc, cur, wr, wc, fr, fq);
        else {
#pragma unroll
            for (int a = 0; a < 2; ++a)
#pragma unroll
                for (int b = 0; b < 2; ++b)
#pragma unroll
                    for (int m = 0; m < 4; ++m)
#pragma unroll
                        for (int n = 0; n < 2; ++n) asm volatile("" :: "v"(acc[a][b][m][n]));
        }
        if (!cur.keep()) {
#pragma unroll
            for (int a = 0; a < 2; ++a)
#pragma unroll
                for (int b = 0; b < 2; ++b)
#pragma unroll
                    for (int m = 0; m < 4; ++m)
#pragma unroll
                        for (int n = 0; n < 2; ++n) acc[a][b][m][n] = (f32x4){0.f, 0.f, 0.f, 0.f};
        }
        if (!has_next) break;
        if constexpr (P::ACCINIT) S.acc_init(acc, nxt, wr, wc, fr, fq);
        cur = nxt;
        ++ui;
        if (wr == 1) G_BAR;
    }
    G_WAIT_V0;
    asm volatile("" :: "v"(br[0]), "v"(br[1]), "v"(br[2]), "v"(br[3]));
    G_BAR;
#undef G_SA
#undef G_STAGE
#undef G_DMA
#undef G_DMAP
#undef G_VO
#undef G_SO
#undef G_WAIT_B
#undef G_LDA
#undef G_LDB
#undef G_MMA
#undef G_WAIT_V0
#undef G_WAIT_L0
#undef G_BAR
#undef G_SCHED
#undef G_BLOAD
#undef G_DMAB
#undef G_STB
#undef G_STA
#undef G_LDBT
#undef G_BLOAD16
#undef G_BWRITE16
#undef G_LDB16
#undef G_WAITV
#undef G_BWRITE
#undef G_F
}

__device__ __forceinline__ bool static_tile(int L, int nM, int nN, int& pm, int& pn) {
    const int nwg = nM * nN; if (L >= nwg) return false;
    int wgid = L; { const int q = nwg / 8, r = nwg % 8, xcd = wgid % 8, off = wgid / 8; wgid = (xcd < r ? xcd * (q + 1) : r * (q + 1) + (xcd - r) * q) + off; }
    const int nig = 8 * nN, gid = wgid / nig, fm = gid * 8, gsz = (nM - fm) < 8 ? (nM - fm) : 8;
    pm = fm + ((wgid % nig) % gsz); pn = (wgid % nig) / gsz; return true;
}
__device__ __forceinline__ void plain_aoff(unsigned (&v)[4], int lda2, int R0, int C0, int R1, int C1) {
    v[0] = (unsigned)(R0 * lda2 + C0 * 2); v[1] = (unsigned)(R1 * lda2 + C1 * 2);
    v[2] = (unsigned)((128 + R0) * lda2 + C0 * 2); v[3] = (unsigned)((128 + R1) * lda2 + C1 * 2);
}
}

__device__ __forceinline__ int in_rowmap(int col) {
    const int g = col >> 11, c = col & 2047;
    if (g == 3 || g == 4 || g == 5 || g == 7) { const int gi = g == 7 ? 3 : g - 3; return (32 + gi * 8 + (c >> 8)) * 256 + (c & 255); }
    const int pn = c >> 6, ch = c & 63, bj = (g == 2 || g == 6) ? 1 : 0, n = (g == 1 || g == 6) ? 1 : 0;
    return pn * 256 + 128 * bj + 32 * (ch >> 4) + 8 * ((ch >> 2) & 3) + 4 * n + (ch & 3);
}
template <bool MAPIN = false>
__device__ __forceinline__ void p0_transpose_item(const float* W, int N, bf16_t* WT, LAS float* scr, int item, int lane) {
    const int nblk = N / 32, kb = item / nblk, nb = item % nblk, k0 = 64 * kb, n0 = 32 * nb;
    const GAS float* Wg = (const GAS float*)W;
#pragma unroll 8
    for (int i = 0; i < 32; ++i) { const int kk = 2 * i + (lane >> 5); scr[kk * 33 + (lane & 31)] = Wg[(size_t)(k0 + kk) * N + n0 + (lane & 31)]; }
    asm volatile("s_waitcnt lgkmcnt(0)" ::: "memory");
    const int c = lane & 7;
#pragma unroll
    for (int j = 0; j < 4; ++j) { const int n = (lane >> 3) + 8 * j; const LAS float* sp = scr + (8 * c) * 33 + n;
        u32x4 o; o.x = cvtpk(sp[0], sp[33]); o.y = cvtpk(sp[66], sp[99]); o.z = cvtpk(sp[132], sp[165]); o.w = cvtpk(sp[198], sp[231]);
        *(GAS u32x4*)(WT + (size_t)(MAPIN ? in_rowmap(n0 + n) : n0 + n) * 2048 + k0 + 8 * c) = o; }
    asm volatile("s_waitcnt lgkmcnt(0)" ::: "memory");
}

struct Params {
    const float* x; const float* norm_mix; const float* w_in; const float* conv_w; const float* w_conv_out; const float* w_attn_out; const float* w_o;
    const float* norm_ffn; const float* w_router; const float* b_router; const float* w_gate; const float* b_gate; const float* w_up; const float* b_up;
    const float* w_down; const float* b_down; const float* norm_final;
    float* out; unsigned char* ws;
    int ph_lo, ph_hi;
};

struct ProbIn {
    static constexpr bool B16 = true; static constexpr int LDA2 = 4096; static constexpr bool PERM = true, GATHER = false; static constexpr int LDB = INC; static constexpr unsigned B1OFF = 512; static constexpr bool BT = (G_BT != 0); static constexpr bool ACCINIT = false;
    const unsigned char* ws; const float* w_in; int G, c; LAS unsigned char* lds; const float* conv_w;
    __device__ __forceinline__ bool next(int i, gm::Unit& u) const {
        int pm, pn; if (!gm::static_tile(i * G + c, 32, 64, pm, pn)) return false;
        pm = __builtin_amdgcn_readfirstlane(pm); pn = __builtin_amdgcn_readfirstlane(pn);
        u.aS = (unsigned)(WS_XN + (size_t)pm * MiB); u.bS0 = G_BT ? ((unsigned)pn << 20) : (unsigned)pn * 512u; u.pm = pm; u.code = gm::mk_code(pn, 0, 0, 0); return true;
    }
    __device__ __forceinline__ gm::rsrc_t adesc() const { return gm::mk_rsrc(ws, (unsigned)WS_END); }
    __device__ __forceinline__ gm::rsrc_t bdesc(int, int) const { return gm::mk_rsrc(ws + WS_W16IN, 2048u * 16384u * 2u); }
    __device__ __forceinline__ void aoff(const gm::Unit&, unsigned (&v)[4], int R0, int C0, int R1, int C1) const { gm::plain_aoff(v, 4096, R0, C0, R1, C1); }
    __device__ __forceinline__ void epi(f32x4 (&acc)[2][2][4][2], const gm::Unit& u, int wr, int wc, int fr, int fq) const {
        const int row0 = u.pm * 256 + wr * 64 + fr;
        if (u.pn() < 32) {
            bf16_t* CONV = (bf16_t*)(ws + WS_CONV); bf16_t* GCb = (bf16_t*)(ws + WS_GC); float* SB = (float*)(ws + WS_SB) + (size_t)u.pm * (6 * 2048);
            const int chl = 16 * wc + 4 * fq, ch = 64 * u.pn() + chl;
            LAS float* halo = (LAS float*)(lds + MISC_OFF + 1024);
#pragma unroll
            for (int ai = 0; ai < 2; ++ai) {
                const f32x4 u3 = acc[ai][0][3][1] * acc[ai][1][3][0];
                if (fr >= 14) { *(LAS f32x4*)(halo + ((ai * 2 + wr) * 2 + (fr - 14)) * 64 + chl) = u3;
                    if (ai == 1 && wr == 1) *(GAS f32x4*)(SB + (fr - 14) * 2048 + ch) = u3; }
            }
            asm volatile("s_waitcnt lgkmcnt(0)" ::: "memory");
            __builtin_amdgcn_s_barrier();
            const f32x4 w0 = *(const GAS f32x4*)(conv_w + ch), w1 = *(const GAS f32x4*)(conv_w + 2048 + ch), w2 = *(const GAS f32x4*)(conv_w + 4096 + ch);
#pragma unroll
            for (int ai = 0; ai < 2; ++ai) {
                f32x4 h14 = {0.f, 0.f, 0.f, 0.f}, h15 = h14;
                if (wr == 1 || ai == 1) { const LAS float* hp = halo + ((wr == 1 ? ai * 2 : 1) * 2) * 64 + chl; h14 = *(const LAS f32x4*)hp; h15 = *(const LAS f32x4*)(hp + 64); }
                f32x4 prev = {0.f, 0.f, 0.f, 0.f};
#pragma unroll
                for (int m = 0; m < 4; ++m) {
                    const int row = row0 + ai * 128 + m * 16;
                    const f32x4 bg = acc[ai][0][m][0], uu = acc[ai][0][m][1] * acc[ai][1][m][0], gc = acc[ai][1][m][1];
                    f32x4 u1, u2;
#pragma unroll
                    for (int i = 0; i < 4; ++i) {
                        const float r1 = __int_as_float(__builtin_amdgcn_update_dpp(0, __float_as_int(uu[i]), 0x111, 0xf, 0xf, true));
                        const float r2 = __int_as_float(__builtin_amdgcn_update_dpp(0, __float_as_int(uu[i]), 0x112, 0xf, 0xf, true));
                        float p1, p2;
                        if (m == 0) { p1 = h15[i]; p2 = fr == 0 ? h14[i] : h15[i]; }
                        else { p1 = __int_as_float(__builtin_amdgcn_update_dpp(0, __float_as_int(prev[i]), 0x10f, 0xf, 0xf, true));
                               p2 = __int_as_float(__builtin_amdgcn_update_dpp(0, __float_as_int(prev[i]), 0x10e, 0xf, 0xf, true)); }
                        u1[i] = fr >= 1 ? r1 : p1; u2[i] = fr >= 2 ? r2 : p2;
                    }
                    const f32x4 y = bg * (w0 * u2 + w1 * u1 + w2 * uu);
                    u32x2 o; o.x = cvtpk(y[0], y[1]); o.y = cvtpk(y[2], y[3]);
                    *(GAS u32x2*)(CONV + (size_t)row * 2048 + ch) = o;
                    u32x2 g2; g2.x = cvtpk(gc[0], gc[1]); g2.y = cvtpk(gc[2], gc[3]);
                    *(GAS u32x2*)(GCb + (size_t)row * 2048 + ch) = g2;
                    if (ai == 0 && m == 0 && wr == 0 && fr < 2) { *(GAS f32x4*)(SB + (2 + 2 * fr) * 2048 + ch) = bg; *(GAS f32x4*)(SB + (3 + 2 * fr) * 2048 + ch) = uu; }
                    prev = uu;
                }
            }
            return;
        }
        const int q_ = u.pn() - 32, gi_ = q_ >> 3, grp = gi_ == 3 ? 7 : 3 + gi_, ct = q_ & 7;
        if (grp >= 3 && grp <= 5) {
            bf16_t* buf = (bf16_t*)(ws + (grp == 3 ? WS_Q : (grp == 4 ? WS_K : WS_V)));
            const bool rope = (grp != 5) && (wc == 0);
            const float* COS = (const float*)(ws + WS_ROPE); const float* SIN = COS + 4096 * 16;
#pragma unroll
            for (int ai = 0; ai < 2; ++ai)
#pragma unroll
                for (int m = 0; m < 4; ++m) {
                    const int row = row0 + ai * 128 + m * 16; const int b = row >> 12, s = row & 4095;
                    f32x4 c0 = {1.f, 1.f, 1.f, 1.f}, c1 = c0, s0 = {0.f, 0.f, 0.f, 0.f}, s1 = s0;
                    if (rope) { const GAS f32x4* cp = (const GAS f32x4*)(COS + s * 16 + 8 * (fq & 1)); const GAS f32x4* sp = (const GAS f32x4*)(SIN + s * 16 + 8 * (fq & 1));
                        c0 = cp[0]; c1 = cp[1]; s0 = sp[0]; s1 = sp[1]; if (fq < 2) { s0 = -s0; s1 = -s1; } }
#pragma unroll
                    for (int bj = 0; bj < 2; ++bj) {
                        f32x4 v0 = acc[ai][bj][m][0], v1 = acc[ai][bj][m][1];
                        if (rope) {
                            f32x4 p0, p1;
#pragma unroll
                            for (int i = 0; i < 4; ++i) { p0[i] = __shfl_xor(v0[i], 32); p1[i] = __shfl_xor(v1[i], 32); }
                            v0 = v0 * c0 + p0 * s0; v1 = v1 * c1 + p1 * s1;
                        }
                        const int head = ct * 2 + bj;
                        u32x4 w; w.x = cvtpk(v0[0], v0[1]); w.y = cvtpk(v0[2], v0[3]); w.z = cvtpk(v1[0], v1[1]); w.w = cvtpk(v1[2], v1[3]);
                        *(GAS u32x4*)(buf + ((size_t)((b * 16 + head) * 4096 + s)) * 128 + wc * 32 + 8 * fq) = w;
                    }
                }
            if (grp == 4) {
                f32x4 ks[2][2] = {{{0.f, 0.f, 0.f, 0.f}, {0.f, 0.f, 0.f, 0.f}}, {{0.f, 0.f, 0.f, 0.f}, {0.f, 0.f, 0.f, 0.f}}};
#pragma unroll 1
                for (int am = 0; am < 8; ++am) {
                    const int ai = am >> 2, m = am & 3; const int row = row0 + ai * 128 + m * 16; const int s = row & 4095;
                    f32x4 c0 = {1.f, 1.f, 1.f, 1.f}, c1 = c0, s0 = {0.f, 0.f, 0.f, 0.f}, s1 = s0;
                    if (rope) { const GAS f32x4* cp = (const GAS f32x4*)(COS + s * 16 + 8 * (fq & 1)); const GAS f32x4* sp = (const GAS f32x4*)(SIN + s * 16 + 8 * (fq & 1));
                        c0 = cp[0]; c1 = cp[1]; s0 = sp[0]; s1 = sp[1]; if (fq < 2) { s0 = -s0; s1 = -s1; } }
#pragma unroll
                    for (int bj = 0; bj < 2; ++bj) {
                        f32x4 v0, v1;
                        switch (am) {
#define KS_ARM(A, M) case (A) * 4 + (M): v0 = acc[A][bj][M][0]; v1 = acc[A][bj][M][1]; break;
                            KS_ARM(0, 0) KS_ARM(0, 1) KS_ARM(0, 2) KS_ARM(0, 3) KS_ARM(1, 0) KS_ARM(1, 1) KS_ARM(1, 2) default: v0 = acc[1][bj][3][0]; v1 = acc[1][bj][3][1]; break;
#undef KS_ARM
                        }
                        if (rope) { f32x4 p0, p1;
#pragma unroll
                            for (int i = 0; i < 4; ++i) { p0[i] = __shfl_xor(v0[i], 32); p1[i] = __shfl_xor(v1[i], 32); }
                            v0 = v0 * c0 + p0 * s0; v1 = v1 * c1 + p1 * s1; }
                        ks[bj][0] += v0; ks[bj][1] += v1;
                    }
                }
                float* KS = (float*)(ws + WS_KMSUM) + ((size_t)(((u.pm >> 4) * 16 + ct * 2) * 16 + (u.pm & 15))) * 128 + wc * 32 + 8 * fq;
#pragma unroll
                for (int bj = 0; bj < 2; ++bj)
#pragma unroll
                    for (int h = 0; h < 2; ++h)
#pragma unroll
                        for (int i = 0; i < 4; ++i) { float t = ks[bj][h][i];
                            t += __shfl_xor(t, 1); t += __shfl_xor(t, 2); t += __shfl_xor(t, 4); t += __shfl_xor(t, 8);
                            if (fr == 0) (void)__hip_atomic_fetch_add(KS + (size_t)bj * 16 * 128 + 4 * h + i, t, __ATOMIC_RELAXED, __HIP_MEMORY_SCOPE_AGENT); }
            }
        } else {
            const size_t off = WS_GA;
            bf16_t* buf = (bf16_t*)(ws + off);
#pragma unroll
            for (int ai = 0; ai < 2; ++ai)
#pragma unroll
                for (int m = 0; m < 4; ++m) {
                    const int row = row0 + ai * 128 + m * 16;
#pragma unroll
                    for (int bj = 0; bj < 2; ++bj) {
                        const f32x4 v0 = acc[ai][bj][m][0], v1 = acc[ai][bj][m][1];
                        u32x4 w; w.x = cvtpk(v0[0], v0[1]); w.y = cvtpk(v0[2], v0[3]); w.z = cvtpk(v1[0], v1[1]); w.w = cvtpk(v1[2], v1[3]);
                        *(GAS u32x4*)(buf + (size_t)row * 2048 + ct * 256 + bj * 128 + wc * 32 + 8 * fq) = w;
                    }
                }
        }
    }
};

struct ProbMerge {
    static constexpr bool B16 = true; static constexpr int LDA2 = 4096; static constexpr bool PERM = true, GATHER = false; static constexpr int LDB = 2048; static constexpr unsigned B1OFF = 512; static constexpr bool BT = (G_BT != 0); static constexpr bool ACCINIT = false;
    const unsigned char* ws; const float* wc_out; const float* wa_out; int G, c;
    __device__ __forceinline__ bool next(int i, gm::Unit& u) const {
        int pm, pn; if (!gm::static_tile((i >> 1) * G + c, 32, 8, pm, pn)) return false;
        pm = __builtin_amdgcn_readfirstlane(pm); pn = __builtin_amdgcn_readfirstlane(pn);
        const int seg = i & 1;
        u.aS = (unsigned)((seg ? WS_ATT : WS_CONV) + (size_t)pm * MiB); u.bS0 = G_BT ? ((unsigned)pn << 20) : (unsigned)pn * 512u;
        u.pm = pm; u.code = gm::mk_code(pn, 0, seg, seg ? 0 : 1); return true;
    }
    __device__ __forceinline__ gm::rsrc_t adesc() const { return gm::mk_rsrc(ws, (unsigned)WS_END); }
    __device__ __forceinline__ gm::rsrc_t bdesc(int sel, int) const { return gm::mk_rsrc(ws + (sel ? WS_W16A : WS_W16C), 2048u * 2048u * 2u); }
    __device__ __forceinline__ void aoff(const gm::Unit&, unsigned (&v)[4], int R0, int C0, int R1, int C1) const { gm::plain_aoff(v, 4096, R0, C0, R1, C1); }
    __device__ __forceinline__ void epi(f32x4 (&acc)[2][2][4][2], const gm::Unit& u, int wr, int wc, int fr, int fq) const {
        const bf16_t* GC = (const bf16_t*)(ws + WS_GC); const bf16_t* GA = (const bf16_t*)(ws + WS_GA); bf16_t* MRG = (bf16_t*)(ws + WS_MRG);
        const int row0 = u.pm * 256 + wr * 64 + fr, col0 = u.pn() * 256 + wc * 32 + 8 * fq; const int seg = u.aux();
#pragma unroll
        for (int ai = 0; ai < 2; ++ai)
#pragma unroll
            for (int m = 0; m < 4; ++m) {
                const int row = row0 + ai * 128 + m * 16;
#pragma unroll
                for (int bj = 0; bj < 2; ++bj) {
                    const size_t idx = (size_t)row * 2048 + col0 + bj * 128;
                    const u32x4 ga = *(const GAS u32x4*)(GA + idx);
                    float fa[8] = {bf_lo(ga.x), bf_hi(ga.x), bf_lo(ga.y), bf_hi(ga.y), bf_lo(ga.z), bf_hi(ga.z), bf_lo(ga.w), bf_hi(ga.w)};
                    if (seg == 0) {
                        const u32x4 gc = *(const GAS u32x4*)(GC + idx);
                        float fc[8] = {bf_lo(gc.x), bf_hi(gc.x), bf_lo(gc.y), bf_hi(gc.y), bf_lo(gc.z), bf_hi(gc.z), bf_lo(gc.w), bf_hi(gc.w)};
#pragma unroll
                        for (int i = 0; i < 8; ++i) { const float r = (1.f + fast_exp(-fa[i])) * __builtin_amdgcn_rcpf(1.f + fast_exp(-fc[i])); acc[ai][bj][m][i >> 2][i & 3] *= r; }
                    } else {
                        float o[8];
#pragma unroll
                        for (int i = 0; i < 8; ++i) o[i] = acc[ai][bj][m][i >> 2][i & 3] * sigmoidf_(fa[i]);
                        u32x4 w; w.x = cvtpk(o[0], o[1]); w.y = cvtpk(o[2], o[3]); w.z = cvtpk(o[4], o[5]); w.w = cvtpk(o[6], o[7]);
                        *(GAS u32x4*)(MRG + idx) = w;
                    }
                }
            }
    }
};

struct ProbWo {
    static constexpr bool B16 = true; static constexpr int LDA2 = 4096; static constexpr bool PERM = false, GATHER = false; static constexpr int LDB = 2048; static constexpr unsigned B1OFF = 512; static constexpr bool BT = (G_BT != 0); static constexpr bool ACCINIT = true;
    const unsigned char* ws; const float* w_o; const float* x; int G, c;
    __device__ __forceinline__ bool next(int i, gm::Unit& u) const {
        int pm, pn; if (!gm::static_tile(i * G + c, 32, 8, pm, pn)) return false;
        pm = __builtin_amdgcn_readfirstlane(pm); pn = __builtin_amdgcn_readfirstlane(pn);
        u.aS = (unsigned)(WS_MRG + (size_t)pm * MiB); u.bS0 = G_BT ? ((unsigned)pn << 20) : (unsigned)pn * 512u; u.pm = pm; u.code = gm::mk_code(pn, 0, 0, 0); return true;
    }
    __device__ __forceinline__ gm::rsrc_t adesc() const { return gm::mk_rsrc(ws, (unsigned)WS_END); }
    __device__ __forceinline__ gm::rsrc_t bdesc(int, int) const { return gm::mk_rsrc(ws + WS_W16O, 2048u * 2048u * 2u); }
    __device__ __forceinline__ void aoff(const gm::Unit&, unsigned (&v)[4], int R0, int C0, int R1, int C1) const { gm::plain_aoff(v, 4096, R0, C0, R1, C1); }
    __device__ __forceinline__ void acc_init(f32x4 (&acc)[2][2][4][2], const gm::Unit& u, int wr, int wc, int fr, int fq) const {
        const int row0 = u.pm * 256 + wr * 64 + fr, col0 = u.pn() * 256 + wc * 32 + 4 * fq;
#pragma unroll
        for (int ai = 0; ai < 2; ++ai)
#pragma unroll
            for (int m = 0; m < 4; ++m)
#pragma unroll
                for (int bj = 0; bj < 2; ++bj)
#pragma unroll
                    for (int n = 0; n < 2; ++n)
                        acc[ai][bj][m][n] = *(const GAS f32x4*)(x + (size_t)(row0 + ai * 128 + m * 16) * 2048 + col0 + bj * 128 + n * 16);
    }
    __device__ __forceinline__ void epi(f32x4 (&acc)[2][2][4][2], const gm::Unit& u, int wr, int wc, int fr, int fq) const {
        float* H1 = (float*)(ws + WS_H1);
        const int row0 = u.pm * 256 + wr * 64 + fr, col0 = u.pn() * 256 + wc * 32 + 4 * fq;
#pragma unroll
        for (int ai = 0; ai < 2; ++ai)
#pragma unroll
            for (int m = 0; m < 4; ++m) {
                const int row = row0 + ai * 128 + m * 16;
#pragma unroll
                for (int bj = 0; bj < 2; ++bj)
#pragma unroll
                    for (int n = 0; n < 2; ++n) {
                        const size_t idx = (size_t)row * 2048 + col0 + bj * 128 + n * 16;
                        *(GAS f32x4*)(H1 + idx) = acc[ai][bj][m][n];
                    }
            }
    }
};

struct MoeTab { const LAS int* pre; const LAS int* cnt; };
__device__ __forceinline__ bool moe_decode(const MoeTab& T, int L, int ntn, int& e, int& mt, int& pn) {
    const int tot = T.pre[32];
    if (L >= tot * ntn) return false;
    int ee = 0;
    while (ee < 31 && L >= ntn * T.pre[ee + 1]) ++ee;
    const int v = L - ntn * T.pre[ee], te = T.pre[ee + 1] - T.pre[ee];
    e = __builtin_amdgcn_readfirstlane(ee); pn = __builtin_amdgcn_readfirstlane(v / te); mt = __builtin_amdgcn_readfirstlane(v % te);
    return true;
}
struct ProbMoe1 {
    static constexpr bool B16 = false; static constexpr int LDA2 = 4096; static constexpr bool PERM = true, GATHER = true; static constexpr int LDB = 2048; static constexpr unsigned B1OFF = 0; static constexpr bool BT = false; static constexpr bool ACCINIT = false;
    const unsigned char* ws; const float* w_gate; const float* w_up; const float* b_gate; const float* b_up; MoeTab T; int G, vcu;
    __device__ __forceinline__ bool next(int i, gm::Unit& u) const {
        int e, mt, pn; if (!moe_decode(T, i * G + vcu, 16, e, mt, pn)) return false;
        u.aS = (unsigned)WS_XN; u.bS0 = (unsigned)e * (2048u * 2048u * 4u) + (unsigned)pn * 512u;
        u.pm = __builtin_amdgcn_readfirstlane(T.pre[e]) + mt; u.code = gm::mk_code(pn, e, mt, 0); return true;
    }
    __device__ __forceinline__ gm::rsrc_t adesc() const { return gm::mk_rsrc(ws, (unsigned)WS_END); }
    __device__ __forceinline__ gm::rsrc_t bdesc(int, int h) const { return gm::mk_rsrc(h ? w_up : w_gate, 32u * 2048u * 2048u * 4u); }
    __device__ __forceinline__ void aoff(const gm::Unit& u, unsigned (&v)[4], int R0, int C0, int R1, int C1) const {
        const int* er = (const int*)(ws + WS_EROWS) + u.e() * 8192; const int cnt = T.cnt[u.e()]; const int base = u.aux() * 256;
        int i0 = base + R0, i1 = base + R1, i2 = base + 128 + R0, i3 = base + 128 + R1;
        i0 = i0 < cnt ? i0 : cnt - 1; i1 = i1 < cnt ? i1 : cnt - 1; i2 = i2 < cnt ? i2 : cnt - 1; i3 = i3 < cnt ? i3 : cnt - 1;
        const int t0 = __hip_atomic_load(er + i0, __ATOMIC_RELAXED, __HIP_MEMORY_SCOPE_AGENT), t1 = __hip_atomic_load(er + i1, __ATOMIC_RELAXED, __HIP_MEMORY_SCOPE_AGENT);
        const int t2 = __hip_atomic_load(er + i2, __ATOMIC_RELAXED, __HIP_MEMORY_SCOPE_AGENT), t3 = __hip_atomic_load(er + i3, __ATOMIC_RELAXED, __HIP_MEMORY_SCOPE_AGENT);
        v[0] = (unsigned)(t0 * 4096 + C0 * 2); v[1] = (unsigned)(t1 * 4096 + C1 * 2); v[2] = (unsigned)(t2 * 4096 + C0 * 2); v[3] = (unsigned)(t3 * 4096 + C1 * 2);
    }
    __device__ __forceinline__ void epi(f32x4 (&acc)[2][2][4][2], const gm::Unit& u, int wr, int wc, int fr, int fq) const {
        bf16_t* HID = (bf16_t*)(ws + WS_HID);
        const int row0 = u.pm * 256 + wr * 64 + fr, col0 = u.pn() * 128 + wc * 32 + 8 * fq;
        const GAS f32x4* bgp = (const GAS f32x4*)(b_gate + u.e() * 2048 + col0); const GAS f32x4* bup = (const GAS f32x4*)(b_up + u.e() * 2048 + col0);
        const f32x4 bg0 = bgp[0], bg1 = bgp[1], bu0 = bup[0], bu1 = bup[1];
#pragma unroll
        for (int ai = 0; ai < 2; ++ai)
#pragma unroll
            for (int m = 0; m < 4; ++m) {
                const int row = row0 + ai * 128 + m * 16;
                float o[8];
#pragma unroll
                for (int i = 0; i < 8; ++i) {
                    float g = acc[ai][0][m][i >> 2][i & 3] + (i < 4 ? bg0[i & 3] : bg1[i & 3]);
                    float uu = acc[ai][1][m][i >> 2][i & 3] + (i < 4 ? bu0[i & 3] : bu1[i & 3]);
                    g = fminf(g, 7.f); uu = fminf(fmaxf(uu, -7.f), 7.f);
                    o[i] = (uu + 1.f) * (g * sigmoidf_(1.702f * g));
                }
                u32x4 w; w.x = cvtpk(o[0], o[1]); w.y = cvtpk(o[2], o[3]); w.z = cvtpk(o[4], o[5]); w.w = cvtpk(o[6], o[7]);
                *(GAS u32x4*)(HID + (size_t)row * 2048 + col0) = w;
            }
    }
};
struct ProbMoe2 {
    static constexpr bool B16 = false; static constexpr int LDA2 = 4096; static constexpr bool PERM = true, GATHER = false; static constexpr int LDB = 2048; static constexpr unsigned B1OFF = 512; static constexpr bool BT = false; static constexpr bool ACCINIT = false;
    const unsigned char* ws; const float* w_down; const float* b_down; MoeTab T; int G, vcu;
    __device__ __forceinline__ bool next(int i, gm::Unit& u) const {
        int e, mt, pn; if (!moe_decode(T, i * G + vcu, 8, e, mt, pn)) return false;
        const int pm = __builtin_amdgcn_readfirstlane(T.pre[e]) + mt;
        u.aS = (unsigned)(WS_HID + (size_t)pm * MiB); u.bS0 = (unsigned)e * (2048u * 2048u * 4u) + (unsigned)pn * 1024u;
        u.pm = pm; u.code = gm::mk_code(pn, e, mt, 0); return true;
    }
    __device__ __forceinline__ gm::rsrc_t adesc() const { return gm::mk_rsrc(ws, (unsigned)WS_END); }
    __device__ __forceinline__ gm::rsrc_t bdesc(int, int) const { return gm::mk_rsrc(w_down, 32u * 2048u * 2048u * 4u); }
    __device__ __forceinline__ void aoff(const gm::Unit&, unsigned (&v)[4], int R0, int C0, int R1, int C1) const { gm::plain_aoff(v, 4096, R0, C0, R1, C1); }
    __device__ __forceinline__ void epi(f32x4 (&acc)[2][2][4][2], const gm::Unit& u, int wr, int wc, int fr, int fq) const {
        bf16_t* YB = (bf16_t*)(ws + WS_YB);
        const int row0 = u.pm * 256 + wr * 64 + fr, col0 = u.pn() * 256 + wc * 32 + 8 * fq;
#pragma unroll
        for (int bj = 0; bj < 2; ++bj) {
            const GAS f32x4* bp = (const GAS f32x4*)(b_down + u.e() * 2048 + col0 + bj * 128);
            const f32x4 b0 = bp[0], b1 = bp[1];
#pragma unroll
            for (int ai = 0; ai < 2; ++ai)
#pragma unroll
                for (int m = 0; m < 4; ++m) {
                    const int row = row0 + ai * 128 + m * 16;
                    const f32x4 v0 = acc[ai][bj][m][0] + b0, v1 = acc[ai][bj][m][1] + b1;
                    u32x4 w; w.x = cvtpk(v0[0], v0[1]); w.y = cvtpk(v0[2], v0[3]); w.z = cvtpk(v1[0], v1[1]); w.w = cvtpk(v1[2], v1[3]);
                    *(GAS u32x4*)(YB + (size_t)row * 2048 + col0 + bj * 128) = w;
                }
        }
    }
};

namespace at {
constexpr int D = 128, NW = 8, QBLK = 32, KVBLK = 64, QB = 256, OSTR = 2048;
constexpr int SHM_V = KVBLK * D * 2, SHM_K = KVBLK * D * 2;
constexpr int GATE_OFF = 2 * SHM_V + 2 * SHM_K + NW * 64 * 4;
constexpr float SCALE = 0.08838834764831845f, THR = 8.f;
constexpr int WBIG = 1 << 30;
#define KSWZ(row, colB) ((row) * 256 + ((colB) ^ (((row) & 7) << 4)))
#define SBAR() __builtin_amdgcn_sched_barrier(0)
__device__ __forceinline__ int v_st(int k, int c) { const int kk = (k & ~0xC) | ((k & 4) << 1) | ((k & 8) >> 1); return ((kk >> 3) * 4 + (c >> 5)) * 512 + ((kk & 7) * 32 + (c & 31)) * 2; }
__device__ __forceinline__ int v_rd_base(int lane) { return ((lane & 3) << 3) | (((lane >> 2) & 3) << 6) | (((lane >> 4) & 1) << 5) | (((lane >> 5) & 1) << 8); }
constexpr int v_rd_off(int d0, int ks, int half) { return d0 * 512 + ks * 4096 + half * 2048; }
__device__ __forceinline__ int crow(int r, int hi) { return (r & 3) + 8 * (r >> 2) + 4 * hi; }
__device__ __forceinline__ unsigned cvtpkv(float lo, float hi) { unsigned r; asm volatile("v_cvt_pk_bf16_f32 %0, %1, %2" : "=v"(r) : "v"(lo), "v"(hi)); return r; }
__device__ __forceinline__ bf16x8 load8(const bf16_t* p) { return *reinterpret_cast<const bf16x8*>(p); }
__device__ __forceinline__ void mask_tile(f32x16& p0, f32x16& p1, int dq, unsigned W) {
    const float NEG = -__builtin_inff();
#pragma unroll
    for (int r = 0; r < 16; ++r) {
        const int c = (r & 3) + 8 * (r >> 2);
        if ((unsigned)(dq - c) >= W) p0[r] = NEG;
        if ((unsigned)(dq - c - 32) >= W) p1[r] = NEG;
    }
}
__device__ __forceinline__ void partialSM(f32x16& p0, f32x16& p1, float& m_reg, float& mn, float& alpha, bool rowsel) {
    float pmax = p0[0]; for (int r = 1; r < 16; ++r) pmax = fmaxf(pmax, p0[r]); for (int r = 0; r < 16; ++r) pmax = fmaxf(pmax, p1[r]);
    { auto rr = __builtin_amdgcn_permlane32_swap(__float_as_uint(pmax), __float_as_uint(pmax), false, false);
      pmax = fmaxf(__uint_as_float(rr[0]), __uint_as_float(rr[1])); }
    if (!rowsel) pmax = -__builtin_inff();
    constexpr float C2 = 1.4426950408889634f * SCALE;
    if (__builtin_expect(__all((pmax - m_reg) * SCALE <= THR), 1)) { mn = m_reg; alpha = 1.f; }
    else { mn = fmaxf(m_reg, pmax); alpha = __builtin_amdgcn_exp2f((m_reg - mn) * C2); m_reg = mn; }
    const float mnL = rowsel ? -mn * C2 : -__builtin_inff();
    for (int r = 0; r < 16; ++r) p0[r] = fmaf(p0[r], C2, mnL); for (int r = 0; r < 16; ++r) p1[r] = fmaf(p1[r], C2, mnL);
    for (int r = 0; r < 16; ++r) p0[r] = __builtin_amdgcn_exp2f(p0[r]);
}
__device__ __forceinline__ void finishSM(f32x16& p0, f32x16& p1, float alpha, float& l_reg, bf16x8& pa0, bf16x8& pa1, bf16x8& pa2, bf16x8& pa3) {
    for (int r = 0; r < 16; ++r) p1[r] = __builtin_amdgcn_exp2f(p1[r]);
    float ps = 0; for (int r = 0; r < 16; ++r) ps += p0[r]; for (int r = 0; r < 16; ++r) ps += p1[r];
    { auto rr = __builtin_amdgcn_permlane32_swap(__float_as_uint(ps), __float_as_uint(ps), false, false);
      ps = __uint_as_float(rr[0]) + __uint_as_float(rr[1]); }
    l_reg = l_reg * alpha + ps;
#define PK4(P, B_, OUT) do { unsigned a0 = cvtpkv(P[B_+0], P[B_+1]), a1 = cvtpkv(P[B_+2], P[B_+3]);                          \
        unsigned b0 = cvtpkv(P[B_+4], P[B_+5]), b1 = cvtpkv(P[B_+6], P[B_+7]);                                             \
        auto r0 = __builtin_amdgcn_permlane32_swap(a0, b0, false, false); auto r1 = __builtin_amdgcn_permlane32_swap(a1, b1, false, false); \
        u32x4 w = {r0[0], r1[0], r0[1], r1[1]}; OUT = *reinterpret_cast<bf16x8*>(&w); } while (0)
    PK4(p0, 0, pa0); PK4(p0, 8, pa1); PK4(p1, 0, pa2); PK4(p1, 8, pa3);
#undef PK4
}
template <int KB>
__device__ __forceinline__ void qkt(f32x16& p0, f32x16& p1, const char* K_lds, int r32, int hi, const bf16x8* qr) {
    p0 = f32x16{}; p1 = f32x16{};
    const char* kb[4];
#pragma unroll
    for (int dd = 0; dd < 4; ++dd) kb[dd] = K_lds + KB * SHM_K + KSWZ(r32, (dd * 16 + hi * 8) * 2);
#pragma unroll
    for (int d0 = 0; d0 < 8; ++d0) { const char* a = kb[d0 & 3] + (d0 >> 2) * 128;
        bf16x8 b0 = *reinterpret_cast<const bf16x8*>(a);
        bf16x8 b1 = *reinterpret_cast<const bf16x8*>(a + 32 * 256);
        p0 = __builtin_amdgcn_mfma_f32_32x32x16_bf16(b0, qr[d0], p0, 0, 0, 0);
        p1 = __builtin_amdgcn_mfma_f32_32x32x16_bf16(b1, qr[d0], p1, 0, 0, 0); }
}
__device__ __forceinline__ void gate_scores(f32x16& g, const char* G_lds, int r32, int hi, const bf16x8* qr) {
    g = f32x16{};
#pragma unroll
    for (int d0 = 0; d0 < 8; ++d0) { const char* a = G_lds + KSWZ(r32, ((d0 & 3) * 16 + hi * 8) * 2) + (d0 >> 2) * 128;
        bf16x8 b0 = *reinterpret_cast<const bf16x8*>(a);
        g = __builtin_amdgcn_mfma_f32_32x32x16_bf16(b0, qr[d0], g, 0, 0, 0); }
}
template <int VB>
__device__ __forceinline__ void pv_tile(f32x16* o, int vb0, bf16x8 pa0, bf16x8 pa1, bf16x8 pa2, bf16x8 pa3) {
#define TRRD(dst, off) asm volatile("ds_read_b64_tr_b16 %0, %1 offset:%2" : "=&v"(dst) : "v"(vb0), "i"(off) : "memory")
#define PV_D0(d0) do { s16x4 l0, l1, l2, l3, h0, h1, h2, h3; constexpr int b_ = VB * SHM_V + v_rd_off(d0, 0, 0); \
        TRRD(l0, b_); TRRD(h0, b_ + 2048); TRRD(l1, b_ + 4096); TRRD(h1, b_ + 6144); TRRD(l2, b_ + 8192); TRRD(h2, b_ + 10240); TRRD(l3, b_ + 12288); TRRD(h3, b_ + 14336); \
        asm volatile("s_waitcnt lgkmcnt(0)" ::: "memory"); SBAR();   \
        o[d0] = __builtin_amdgcn_mfma_f32_32x32x16_bf16(pa0, (bf16x8){l0[0], l0[1], l0[2], l0[3], h0[0], h0[1], h0[2], h0[3]}, o[d0], 0, 0, 0);   \
        o[d0] = __builtin_amdgcn_mfma_f32_32x32x16_bf16(pa1, (bf16x8){l1[0], l1[1], l1[2], l1[3], h1[0], h1[1], h1[2], h1[3]}, o[d0], 0, 0, 0);   \
        o[d0] = __builtin_amdgcn_mfma_f32_32x32x16_bf16(pa2, (bf16x8){l2[0], l2[1], l2[2], l2[3], h2[0], h2[1], h2[2], h2[3]}, o[d0], 0, 0, 0);   \
        o[d0] = __builtin_amdgcn_mfma_f32_32x32x16_bf16(pa3, (bf16x8){l3[0], l3[1], l3[2], l3[3], h3[0], h3[1], h3[2], h3[3]}, o[d0], 0, 0, 0); } while (0)
    PV_D0(0); PV_D0(1); PV_D0(2); PV_D0(3);
#undef PV_D0
#undef TRRD
}

struct BlockRef { unsigned q, k, v, o, km; int P0; };
struct Seam { bf16x8 qr[8]; bf16x8 st_v0, st_v1, st_k0, st_k1; };
typedef __amdgpu_buffer_rsrc_t rs_t;
__device__ __forceinline__ bf16x8 bl8(rs_t rs, unsigned voff, unsigned soff) { u32x4 t = __builtin_amdgcn_raw_buffer_load_b128(rs, voff, soff, 0); return *reinterpret_cast<bf16x8*>(&t); }
#define VMW() asm volatile("s_waitcnt vmcnt(0)" ::: "memory")
#define VMWN(n) asm volatile("s_waitcnt vmcnt(%0)" :: "i"(n) : "memory")
#define SLOAD_H(Ko, Vo, k0) do { const unsigned kb__ = (unsigned)(k0) * 256u; S.st_v0 = bl8(rs, kvo, (Vo) + kb__); S.st_v1 = bl8(rs, kvo, (Vo) + kb__ + 8192u);              \
                         S.st_k0 = bl8(rs, kvo, (Ko) + kb__); S.st_k1 = bl8(rs, kvo, (Ko) + kb__ + 8192u); } while (0)
#define SWRITE_HK(bf) do { *(bf16x8*)(K_lds + (bf) * SHM_K + kws) = S.st_k0; *(bf16x8*)(K_lds + (bf) * SHM_K + kws + 32 * 256) = S.st_k1; } while (0)
#define SWRITE_HV(bf) do { *(bf16x8*)(V_lds + (bf) * SHM_V + vst0) = S.st_v0; *(bf16x8*)(V_lds + (bf) * SHM_V + vst1) = S.st_v1; } while (0)
#define SWRITE_H(bf) do { SWRITE_HV(bf); SWRITE_HK(bf); } while (0)
#define QLOAD(qo) do { _Pragma("unroll") for (int d0 = 0; d0 < 8; ++d0) S.qr[d0] = bl8(rs, qvo + d0 * 32, (qo)); } while (0)
__device__ __forceinline__ void moba_prime(const BlockRef& cur, rs_t rs, char* lds, Seam& S) {
    const int tid = threadIdx.x, wid = __builtin_amdgcn_readfirstlane(tid >> 6), lane = tid & 63, r32 = lane & 31, hi = lane >> 5;
    const int sr = tid >> 4, sc = (tid & 15) * 8, kws = KSWZ(sr, sc * 2); char* K_lds = lds + 2 * SHM_V;
    const unsigned kvo = (unsigned)(sr * 128 + sc) * 2u, qvo = (unsigned)((wid * QBLK + r32) * 128 + hi * 8) * 2u;
    QLOAD(cur.q);
    SLOAD_H(cur.k, cur.v, 0); VMW(); SWRITE_HK(0);
    __syncthreads();
}
__device__ __forceinline__ void moba_block(const BlockRef& cur, const BlockRef& nxt, rs_t rs, char* lds, Seam& S) {
    const int tid = threadIdx.x, wid = __builtin_amdgcn_readfirstlane(tid >> 6), lane = tid & 63, r32 = lane & 31, hi = lane >> 5;
    const int own = cur.P0 >> 8;
    const int NT = 4 * own + 4;
    const int qlo = cur.P0 + wid * QBLK, qm = qlo + r32 - 4 * hi;
    char* V_lds = lds; char* K_lds = lds + 2 * SHM_V; char* G_lds = lds + GATE_OFF;
    float* ws = (float*)(lds + 2 * SHM_V + 2 * SHM_K) + wid * 64; float* li_l = ws, * al_l = ws + 32;
    const int sr = tid >> 4, sc = (tid & 15) * 8, vst0 = v_st(sr, sc), vst1 = v_st(32 + sr, sc), kws = KSWZ(sr, sc * 2);
    const unsigned kvo = (unsigned)(sr * 128 + sc) * 2u, qvo = (unsigned)((wid * QBLK + r32) * 128 + hi * 8) * 2u;
    { bf16x8 z = {0, 0, 0, 0, 0, 0, 0, 0};
      if (tid < 256) { const u32x4 s0 = __builtin_amdgcn_raw_buffer_load_b128(rs, 2u * kvo, cur.km, 0), s1 = __builtin_amdgcn_raw_buffer_load_b128(rs, 2u * kvo + 16u, cur.km, 0);
          const float q = 1.f / 256.f; u32x4 w;
          w.x = cvtpkv(__uint_as_float(s0.x) * q, __uint_as_float(s0.y) * q); w.y = cvtpkv(__uint_as_float(s0.z) * q, __uint_as_float(s0.w) * q);
          w.z = cvtpkv(__uint_as_float(s1.x) * q, __uint_as_float(s1.y) * q); w.w = cvtpkv(__uint_as_float(s1.z) * q, __uint_as_float(s1.w) * q); z = *reinterpret_cast<bf16x8*>(&w); }
      *(bf16x8*)(G_lds + KSWZ(sr, sc * 2)) = z; }
    __syncthreads();
    unsigned selmask = 0;
    { f32x16 g; gate_scores(g, G_lds, r32, hi, S.qr);
      float s[16];
#pragma unroll
      for (int r = 0; r < 8; ++r) { const float mine = g[r], oth = __shfl_xor(mine, 32);
          const float lo = hi ? oth : mine, hv = hi ? mine : oth;
          s[(r & 3) + 8 * (r >> 2)] = lo; s[(r & 3) + 8 * (r >> 2) + 4] = hv; }
      const float NEGI = -__builtin_inff();
#pragma unroll
      for (int j = 0; j < 16; ++j) if (j >= own) s[j] = NEGI;
#pragma unroll
      for (int k = 0; k < 3; ++k) { float best = NEGI; int bi = -1;
#pragma unroll
          for (int j = 0; j < 16; ++j) { const bool tk = s[j] > best; best = tk ? s[j] : best; bi = tk ? j : bi; }
          if (bi >= 0) { selmask |= 1u << bi;
#pragma unroll
              for (int j = 0; j < 16; ++j) if (j == bi) s[j] = NEGI; } }
    }
    float m_reg = -1e30f, l_reg = 0; f32x16 o[4] = {};
    const int vb0 = (int)(uintptr_t)V_lds + v_rd_base(lane);
    const unsigned Kh = cur.k, Vh = cur.v;
#define RESC(a) do { if (__any((a) < 1.f)) { if (hi == 0) al_l[r32] = (a); asm volatile("s_waitcnt lgkmcnt(0)" ::: "memory");              \
                     for (int d_ = 0; d_ < 4; ++d_) for (int r = 0; r < 16; ++r) o[d_][r] *= al_l[crow(r, hi)]; } } while (0)
#define KBASE(t) ((t) * KVBLK)
#define ROWSEL(t) ((((t) >> 2) >= own) || ((selmask >> ((t) >> 2)) & 1u))
#define MASKT(P0_, P1_, t) do { const int kb_ = KBASE(t); if (kb_ + KVBLK - 1 > qlo) mask_tile(P0_, P1_, qm - kb_, (unsigned)WBIG); } while (0)
    constexpr int NQL = 8;
#define SEAM_K0() do { VMWN(NQL); SWRITE_HK(0); SBAR(); } while (0)
    f32x16 pA0, pA1, pB0, pB1; float mnA, mnB, alA, alB; bf16x8 pa0, pa1, pa2, pa3;
    SWRITE_HV(0); SBAR();
    if (NT > 1) { SLOAD_H(Kh, Vh, KBASE(1)); }
    SBAR(); qkt<0>(pA0, pA1, K_lds, r32, hi, S.qr);
    MASKT(pA0, pA1, 0); partialSM(pA0, pA1, m_reg, mnA, alA, ROWSEL(0));
    if (NT > 1) { VMW(); SWRITE_H(1); }
    __syncthreads();
#define HALF_STEP(PX0, PX1, mnX, alX, PY0, PY1, alY, t, KB, VB, SB) do {                                                      \
        SBAR(); qkt<KB>(PX0, PX1, K_lds, r32, hi, S.qr);                                                                      \
        finishSM(PY0, PY1, alY, l_reg, pa0, pa1, pa2, pa3); SBAR();                                                           \
        if ((t) + 1 < NT) { SLOAD_H(Kh, Vh, KBASE((t) + 1)); SBAR(); }                                                        \
        pv_tile<VB>(o, vb0, pa0, pa1, pa2, pa3); MASKT(PX0, PX1, (t)); partialSM(PX0, PX1, m_reg, mnX, alX, ROWSEL(t));       \
        __syncthreads();                                                                                                      \
        if ((t) + 1 < NT) { VMW(); SWRITE_H(SB); }                                                                            \
        RESC(alX); __syncthreads(); } while (0)
    for (int t = 1; t + 1 < NT; t += 2) {
        HALF_STEP(pB0, pB1, mnB, alB, pA0, pA1, alA, t, 1, 0, 0);
        HALF_STEP(pA0, pA1, mnA, alA, pB0, pB1, alB, t + 1, 0, 1, 1);
    }
    SBAR(); qkt<1>(pB0, pB1, K_lds, r32, hi, S.qr); SBAR();
    SLOAD_H(nxt.k, nxt.v, 0); SBAR();
    QLOAD(nxt.q);
    SBAR();
    finishSM(pA0, pA1, alA, l_reg, pa0, pa1, pa2, pa3); SBAR();
    pv_tile<0>(o, vb0, pa0, pa1, pa2, pa3);
    MASKT(pB0, pB1, NT - 1); partialSM(pB0, pB1, m_reg, mnB, alB, true); __syncthreads(); RESC(alB);
    finishSM(pB0, pB1, alB, l_reg, pa0, pa1, pa2, pa3); SBAR(); pv_tile<1>(o, vb0, pa0, pa1, pa2, pa3);
    SBAR(); SEAM_K0();
    if (hi == 0) li_l[r32] = l_reg; asm volatile("s_waitcnt lgkmcnt(0)" ::: "memory");
    float rli[16];
#pragma unroll
    for (int r = 0; r < 16; ++r) rli[r] = __builtin_amdgcn_rcpf(li_l[crow(r, hi)]);
    int tz = threadIdx.x; asm volatile("" : "+v"(tz));
    const int r32e = tz & 31, hie = (tz >> 5) & 1;
    const unsigned osoff = cur.o + (unsigned)(wid * QBLK) * (unsigned)(OSTR * 2);
#pragma unroll
    for (int r = 0; r < 16; ++r) { const unsigned ob = (unsigned)(crow(r, hie) * OSTR + r32e) * 2u;
#pragma unroll
        for (int d0 = 0; d0 < 4; ++d0) { const float v = o[d0][r] * rli[r];
            const float vn = __shfl_xor(v, 1);
            if ((r32e & 1) == 0) __builtin_amdgcn_raw_buffer_store_b32(cvtpkv(v, vn), rs, ob + d0 * 64, osoff, 0); } }
    __syncthreads();
#undef RESC
#undef KBASE
#undef ROWSEL
#undef MASKT
#undef SEAM_K0
#undef HALF_STEP
}
#undef QLOAD
#undef VMW
#undef VMWN
#undef SLOAD_H
#undef SWRITE_HK
#undef SWRITE_HV
#undef SWRITE_H
}

__device__ __constant__ double ROPE_INVF[16] = {1.0, 0.4403666026717805, 0.1939227447486858, 0.08539710028576561, 0.03760603093086394, 0.016560440080994443,
    0.007292664737217109, 0.0032114459947525913, 0.0014142135623730955, 0.0006227724219145962, 0.00027424817567620724, 0.00012076973741146502,
    5.318295896944988e-05, 2.3419998961409345e-05, 1.0313385377212461e-05, 4.541670480607871e-06};

__device__ __forceinline__ void sincos_d(double a, double& sn, double& cs) {
    const double k = __builtin_rint(a * 0.63661977236758134308);
    double y = __builtin_fma(-k, 1.57079632679489655800e+00, a); y = __builtin_fma(-k, 6.12323399573676603587e-17, y);
    const double z = y * y;
    double s = -7.6471637318198164759e-13; s = s * z + 1.6059043836821614599e-10; s = s * z - 2.5052108385441718775e-08; s = s * z + 2.7557319223985890653e-06;
    s = s * z - 1.9841269841269841270e-04; s = s * z + 8.3333333333333333333e-03; s = s * z - 1.6666666666666666667e-01; s = y + y * z * s;
    double c = 4.7794773323873852974e-14; c = c * z - 1.1470745597729724714e-11; c = c * z + 2.0876756987868098979e-09; c = c * z - 2.7557319223985890653e-07;
    c = c * z + 2.4801587301587301587e-05; c = c * z - 1.3888888888888888889e-03; c = c * z + 4.1666666666666666667e-02; c = c * z - 0.5; c = 1.0 + z * c;
    const int q = ((int)k) & 3;
    sn = (q == 0) ? s : (q == 1) ? c : (q == 2) ? -s : -c;
    cs = (q == 0) ? c : (q == 1) ? -s : (q == 2) ? -c : s;
}

typedef const __attribute__((address_space(4))) Params* KP;
__device__ __forceinline__ KP kparams() { KP k = (KP)__builtin_amdgcn_kernarg_segment_ptr(); asm volatile("" : "+s"(k)); return k; }

__global__ void __launch_bounds__(512, 2) mega(Params p_unused) {
    extern __shared__ __attribute__((aligned(16))) unsigned char lds_raw[];
    LAS unsigned char* lds = (LAS unsigned char*)lds_raw;
#define PH_IDS int tid = threadIdx.x; asm volatile("" : "+v"(tid)); const int lane = tid & 63, wave = __builtin_amdgcn_readfirstlane(tid >> 6); (void)lane; (void)wave
    const int G = gridDim.x, bx = blockIdx.x;
    const int vcu = (G % 8 == 0) ? (bx % 8) * (G / 8) + bx / 8 : bx;
    unsigned char* ws; int lo, hi;
    { KP k = kparams(); ws = k->ws; lo = k->ph_lo; hi = k->ph_hi; }
    unsigned* ctl = (unsigned*)(ws + WS_CTL);
    volatile LAS unsigned* MISC = (volatile LAS unsigned*)(lds + MISC_OFF);
    { PH_IDS; for (int u = tid; u < (LDS_BYTES - MISC_OFF) / 4; u += 512) MISC[u] = 0u; }
    __syncthreads();
    XcdBarrier bar; bar.bar = ctl + CW_BAR; bar.st = MISC;
    if (hi - lo > 1) bar = xcd_barrier_post(ctl + CW_BAR, MISC);
#ifndef PH_MASK
#define PH_MASK 0x3ff
#endif
#define IN(k) ((((PH_MASK) >> (k)) & 1) && lo <= (k) && (k) < hi)
#define SEAM(k) do { if (IN(k) && IN((k) + 1)) xcd_barrier(bar); } while (0)
    LAS int* pre = (LAS int*)(lds + MISC_OFF + 64);
    LAS int* cntl = (LAS int*)(lds + MISC_OFF + 256);

    if (IN(0)) {
        PH_IDS; KP kp = kparams(); const float* px = kp->x; const float* pnm = kp->norm_mix;
        const int gw = vcu * 8 + wave, NGW = G * 8;
        bf16_t* XN = (bf16_t*)(ws + WS_XN);
        for (int m = gw; m < NTOK; m += NGW) {
            const GAS f32x4* xr = (const GAS f32x4*)(px + (size_t)m * DM) + lane;
            f32x4 v[8]; float s = 0.f;
#pragma unroll
            for (int j = 0; j < 8; ++j) { v[j] = xr[64 * j]; s += (v[j].x * v[j].x + v[j].y * v[j].y) + (v[j].z * v[j].z + v[j].w * v[j].w); }
            const float rs = 1.f / sqrtf(wave_sum(s) * (1.f / DM) + NORM_EPS);
            GAS u32x2* o8 = (GAS u32x2*)(XN + (size_t)m * DM) + lane;
#pragma unroll
            for (int j = 0; j < 8; ++j) { const f32x4 g = *((const GAS f32x4*)pnm + lane + 64 * j);
                u32x2 w; w.x = cvtpk(v[j].x * rs * g.x, v[j].y * rs * g.y); w.y = cvtpk(v[j].z * rs * g.z, v[j].w * rs * g.w); o8[64 * j] = w; }
        }
        if (G_BT) {
            LAS float* scr = (LAS float*)(lds + wave * 8448);
            for (int it = gw; it < 16384 + 3 * 2048; it += NGW) {
                int r = it; const float* W; size_t off; int N;
                if (r < 16384) { W = kp->w_in; off = WS_W16IN; N = 16384; }
                else { r -= 16384; const int q = r >> 11; r &= 2047; W = q == 0 ? kp->w_conv_out : (q == 1 ? kp->w_attn_out : kp->w_o); off = q == 0 ? WS_W16C : (q == 1 ? WS_W16A : WS_W16O); N = 2048; }
                if (N == 16384) p0_transpose_item<true>(W, N, (bf16_t*)(ws + off), scr, r, lane); else p0_transpose_item<false>(W, N, (bf16_t*)(ws + off), scr, r, lane);
            }
        } else
        { const float* srcs[4] = {kp->w_in, kp->w_conv_out, kp->w_attn_out, kp->w_o};
          const size_t offs[4] = {WS_W16IN, WS_W16C, WS_W16A, WS_W16O}; const int n8s[4] = {2048 * 16384 / 8, 2048 * 2048 / 8, 2048 * 2048 / 8, 2048 * 2048 / 8};
#pragma unroll
          for (int q = 0; q < 4; ++q) { const GAS f32x4* sp = (const GAS f32x4*)srcs[q]; GAS u32x4* dp = (GAS u32x4*)(ws + offs[q]);
              for (int i = vcu * 512 + tid; i < n8s[q]; i += G * 512) { const f32x4 a = sp[2 * i], b = sp[2 * i + 1];
                  u32x4 w; w.x = cvtpk(a.x, a.y); w.y = cvtpk(a.z, a.w); w.z = cvtpk(b.x, b.y); w.w = cvtpk(b.z, b.w); dp[i] = w; } } }
        float* COS = (float*)(ws + WS_ROPE); float* SIN = COS + 4096 * 16;
        for (int i = vcu * 512 + tid; i < 4096 * 16; i += G * 512) { const int pos = i >> 4, f = i & 15;
            double sn, cs; sincos_d((double)pos * ROPE_INVF[f], sn, cs); COS[i] = (float)cs; SIN[i] = (float)sn; }
    }
    SEAM(0);
    if (IN(1)) { KP kp = kparams(); ProbIn P{ws, kp->w_in, G, bx, lds, kp->conv_w}; gm::gemm_stream<ProbIn>(lds, P); }
    SEAM(1);
    if (IN(3)) {
        const at::rs_t rs = __builtin_amdgcn_make_buffer_rsrc((void*)ws, 0, (unsigned)WS_END, 0x00020000);
        { PH_IDS;
          KP kp = kparams(); const float* pcw = kp->conv_w; const float* SBp = (const float*)(ws + WS_SB); bf16_t* CONV = (bf16_t*)(ws + WS_CONV);
          for (int it = vcu * 512 + tid; it < 32 * 2 * 512; it += G * 512) {
              const int c4 = (it & 511) * 4, r01 = (it >> 9) & 1, pm = it >> 10;
              if ((pm & 15) != 0) {
                  const float* cur = SBp + (size_t)pm * (6 * 2048) + c4; const float* prv = SBp + (size_t)(pm - 1) * (6 * 2048) + c4;
                  const f32x4 w0 = *(const GAS f32x4*)(pcw + c4), w1 = *(const GAS f32x4*)(pcw + 2048 + c4), w2 = *(const GAS f32x4*)(pcw + 4096 + c4);
                  const f32x4 p254 = *(const GAS f32x4*)prv, p255 = *(const GAS f32x4*)(prv + 2048);
                  const f32x4 bg0 = *(const GAS f32x4*)(cur + 2 * 2048), u0 = *(const GAS f32x4*)(cur + 3 * 2048), bg1 = *(const GAS f32x4*)(cur + 4 * 2048), u1 = *(const GAS f32x4*)(cur + 5 * 2048);
                  const f32x4 y = r01 == 0 ? bg0 * (w0 * p254 + w1 * p255 + w2 * u0) : bg1 * (w0 * p255 + w1 * u0 + w2 * u1);
                  u32x2 o; o.x = cvtpk(y[0], y[1]); o.y = cvtpk(y[2], y[3]);
                  *(GAS u32x2*)(CONV + (size_t)(pm * 256 + r01) * 2048 + c4) = o;
              }
          } }
        int L = vcu;
        if (L < 256) {
            int pass = 0;
#define MK_REF(r, L_, p_) do { const int bh = (L_) >> 3, x_ = (L_) & 7, qb = (p_) ? 15 - x_ : x_; const int b_ = bh >> 4, h_ = bh & 15; \
                r.q = (unsigned)(WS_Q + ((size_t)bh * 4096 + qb * 256) * 256); r.k = (unsigned)(WS_K + (size_t)bh * MiB); r.v = (unsigned)(WS_V + (size_t)bh * MiB); \
                r.o = (unsigned)(WS_ATT + ((size_t)(b_ * 4096 + qb * 256)) * 4096 + h_ * 256); r.km = (unsigned)(WS_KMSUM + (size_t)bh * 8192); r.P0 = qb * 256; } while (0)
            at::BlockRef cur, nxt; MK_REF(cur, L, 0);
            at::Seam S;
            at::moba_prime(cur, rs, (char*)lds_raw, S);
            for (;;) {
                const bool more_pass = (pass == 0), more_item = (L + G < 256), last = !more_pass && !more_item;
                int passn = pass + 1, Ln = L;
                if (!more_pass) { passn = 0; Ln = more_item ? L + G : L; }
                if (last) nxt = cur; else MK_REF(nxt, Ln, passn);
                at::moba_block(cur, nxt, rs, (char*)lds_raw, S);
                if (last) break;
                cur = nxt; pass = passn; L = Ln;
            }
#undef MK_REF
        }
    }
    SEAM(3);
    if (IN(4)) { KP kp = kparams(); ProbMerge P{ws, kp->w_conv_out, kp->w_attn_out, G, bx}; gm::gemm_stream<ProbMerge>(lds, P); }
    SEAM(4);
    if (IN(5)) { KP kp = kparams(); ProbWo P{ws, kp->w_o, kp->x, G, bx}; gm::gemm_stream<ProbWo>(lds, P); }
    SEAM(5);
    if (IN(6)) {
        PH_IDS;
        const float* H1 = (const float*)(ws + WS_H1); bf16_t* XN2 = (bf16_t*)(ws + WS_XN);
        KP kp = kparams(); const float* pnf = kp->norm_ffn; const float* pwr = kp->w_router; const float* pbr = kp->b_router;
        int* SLOT = (int*)(ws + WS_SLOT); float* TOKW = (float*)(ws + WS_TOKW); int* EROWS = (int*)(ws + WS_EROWS);
        LAS float* rs_l = (LAS float*)lds;
        LAS float* part = (LAS float*)(lds + 1024);
        LAS float* lg = (LAS float*)(lds + 1024 + 32768);
        for (int rb = vcu; rb < NTOK / 32; rb += G) {
#pragma unroll 1
            for (int rr = 0; rr < 4; ++rr) {
                const int rl = wave * 4 + rr, m = rb * 32 + rl;
                const GAS f32x4* xr = (const GAS f32x4*)(H1 + (size_t)m * DM) + lane;
                f32x4 v[8]; float s = 0.f;
#pragma unroll
                for (int j = 0; j < 8; ++j) { v[j] = xr[64 * j]; s += (v[j].x * v[j].x + v[j].y * v[j].y) + (v[j].z * v[j].z + v[j].w * v[j].w); }
                const float rs = 1.f / sqrtf(wave_sum(s) * (1.f / DM) + NORM_EPS);
                GAS u32x2* o8 = (GAS u32x2*)(XN2 + (size_t)m * DM) + lane;
#pragma unroll
                for (int j = 0; j < 8; ++j) { const f32x4 gg = *((const GAS f32x4*)pnf + lane + 64 * j);
                    u32x2 w; w.x = cvtpk(v[j].x * rs * gg.x, v[j].y * rs * gg.y); w.y = cvtpk(v[j].z * rs * gg.z, v[j].w * rs * gg.w); o8[64 * j] = w; }
                if (lane == 0) rs_l[rl] = rs;
            }
            { const int row = lane & 31, kk = lane >> 5;
              const GAS float* hp = (const GAS float*)H1 + (size_t)(rb * 32 + row) * DM + 256 * wave + kk;
              const GAS float* wp = (const GAS float*)pwr + (size_t)(256 * wave + kk) * 32 + row;
              const GAS float* gp = (const GAS float*)pnf + 256 * wave + kk;
              f32x16 acc = {};
#pragma unroll 8
              for (int st = 0; st < 128; ++st) { const float a = hp[2 * st]; const float bb = wp[(size_t)(2 * st) * 32] * gp[2 * st];
                  acc = __builtin_amdgcn_mfma_f32_32x32x2f32(a, bb, acc, 0, 0, 0); }
#pragma unroll
              for (int r = 0; r < 16; ++r) part[(wave * 32 + ((r & 3) + 8 * (r >> 2) + 4 * kk)) * 32 + row] = acc[r];
            }
            __syncthreads();
            for (int idx = tid; idx < 1024; idx += 512) { float sum = 0.f;
#pragma unroll
                for (int w8 = 0; w8 < 8; ++w8) sum += part[w8 * 1024 + idx];
                lg[idx] = sum * rs_l[idx >> 5] + pbr[idx & 31]; }
            __syncthreads();
            if (tid < 32) {
                const int m = rb * 32 + tid; float l[32];
#pragma unroll
                for (int e = 0; e < 32; ++e) l[e] = lg[tid * 32 + e];
                int se[4]; float sv[4];
#pragma unroll
                for (int k = 0; k < 4; ++k) { float best = -__builtin_inff(); int bi = 0;
#pragma unroll
                    for (int e = 0; e < 32; ++e) { const bool tk = l[e] > best; best = tk ? l[e] : best; bi = tk ? e : bi; }
                    se[k] = bi; sv[k] = best;
#pragma unroll
                    for (int e = 0; e < 32; ++e) if (e == bi) l[e] = -__builtin_inff(); }
                const float e1 = fast_exp(sv[1] - sv[0]), e2 = fast_exp(sv[2] - sv[0]), e3 = fast_exp(sv[3] - sv[0]);
                const float inv = 1.f / (1.f + e1 + e2 + e3);
                const float wgt[4] = {inv, e1 * inv, e2 * inv, e3 * inv};
#pragma unroll
                for (int k = 0; k < 4; ++k) {
                    const int pos = (int)__hip_atomic_fetch_add(ctl + CW_CNT + 64 * se[k], 1u, __ATOMIC_RELAXED, __HIP_MEMORY_SCOPE_AGENT);
                    EROWS[se[k] * 8192 + pos] = m; SLOT[m * 4 + k] = (se[k] << 16) | pos; TOKW[m * 4 + k] = wgt[k];
                }
            }
            __syncthreads();
        }
    }
    SEAM(6);
    if (IN(7) || IN(8) || IN(9)) {
        PH_IDS;
        if (tid < 32) cntl[tid] = (int)__hip_atomic_load(ctl + CW_CNT + 64 * tid, __ATOMIC_RELAXED, __HIP_MEMORY_SCOPE_AGENT);
        __syncthreads();
        if (tid == 0) { int a = 0; for (int e = 0; e < 32; ++e) { pre[e] = a; a += (cntl[e] + 255) >> 8; } pre[32] = a; }
        __syncthreads();
    }
    const MoeTab MT{pre, cntl};
    if (IN(7)) { KP kp = kparams(); ProbMoe1 P{ws, kp->w_gate, kp->w_up, kp->b_gate, kp->b_up, MT, G, vcu}; gm::gemm_stream<ProbMoe1>(lds, P); }
    SEAM(7);
    if (IN(8)) { KP kp = kparams(); ProbMoe2 P{ws, kp->w_down, kp->b_down, MT, G, vcu}; gm::gemm_stream<ProbMoe2>(lds, P); }
    SEAM(8);
    if (IN(9)) {
        PH_IDS;
        const float* H1 = (const float*)(ws + WS_H1); const bf16_t* YB = (const bf16_t*)(ws + WS_YB);
        const int* SLOT = (const int*)(ws + WS_SLOT); const float* TOKW = (const float*)(ws + WS_TOKW);
        KP kp = kparams(); const float* pfin = kp->norm_final; float* pout = kp->out;
        const int gw = vcu * 8 + wave, NGW = G * 8;
        for (int m = gw; m < NTOK; m += NGW) {
            const GAS u32x4* yr[4]; float wk[4];
#pragma unroll
            for (int k = 0; k < 4; ++k) { const int sl = SLOT[m * 4 + k]; const int e = sl >> 16, pos = sl & 0xffff; wk[k] = TOKW[m * 4 + k];
                yr[k] = (const GAS u32x4*)(YB + ((size_t)pre[e] * 256 + pos) * 2048) + lane; }
            const GAS f32x4* xr = (const GAS f32x4*)(H1 + (size_t)m * DM) + 2 * lane;
            f32x4 v[4][2]; float s = 0.f;
#pragma unroll
            for (int j = 0; j < 4; ++j) { v[j][0] = xr[128 * j]; v[j][1] = xr[128 * j + 1];
#pragma unroll
                for (int k = 0; k < 4; ++k) { const u32x4 y = yr[k][64 * j];
                    v[j][0].x += wk[k] * bf_lo(y.x); v[j][0].y += wk[k] * bf_hi(y.x); v[j][0].z += wk[k] * bf_lo(y.y); v[j][0].w += wk[k] * bf_hi(y.y);
                    v[j][1].x += wk[k] * bf_lo(y.z); v[j][1].y += wk[k] * bf_hi(y.z); v[j][1].z += wk[k] * bf_lo(y.w); v[j][1].w += wk[k] * bf_hi(y.w); }
#pragma unroll
                for (int h = 0; h < 2; ++h) s += (v[j][h].x * v[j][h].x + v[j][h].y * v[j][h].y) + (v[j][h].z * v[j][h].z + v[j][h].w * v[j][h].w); }
            const float rs = 1.f / sqrtf(wave_sum(s) * (1.f / DM) + NORM_EPS);
            GAS f32x4* orow = (GAS f32x4*)(pout + (size_t)m * DM) + 2 * lane;
#pragma unroll
            for (int j = 0; j < 4; ++j)
#pragma unroll
                for (int h = 0; h < 2; ++h) { const f32x4 gg = *((const GAS f32x4*)pfin + 2 * lane + 128 * j + h);
                    orow[128 * j + h] = (f32x4){v[j][h].x * rs * gg.x, v[j][h].y * rs * gg.y, v[j][h].z * rs * gg.z, v[j][h].w * rs * gg.w}; }
        }
    }
#undef IN
#undef SEAM
}


#if PROBE_REP >= 0
__global__ void __launch_bounds__(512, 2) probe_k(Params p_unused) {
    extern __shared__ __attribute__((aligned(16))) unsigned char lds_raw[];
    LAS unsigned char* lds = (LAS unsigned char*)lds_raw;
    const int G = gridDim.x, bx = blockIdx.x;
    const int vcu = (G % 8 == 0) ? (bx % 8) * (G / 8) + bx / 8 : bx;
    KP kp = kparams(); unsigned char* ws = kp->ws; unsigned* ctl = (unsigned*)(ws + WS_CTL);
    LAS int* pre = (LAS int*)(lds + MISC_OFF + 64);
    LAS int* cntl = (LAS int*)(lds + MISC_OFF + 256);
    { const int tid = threadIdx.x;
      if (tid < 32) cntl[tid] = (int)__hip_atomic_load(ctl + CW_CNT + 64 * tid, __ATOMIC_RELAXED, __HIP_MEMORY_SCOPE_AGENT);
      __syncthreads();
      if (tid == 0) { int a = 0; for (int e = 0; e < 32; ++e) { pre[e] = a; a += (cntl[e] + 255) >> 8; } pre[32] = a; }
      __syncthreads(); }
    const MoeTab MT{pre, cntl};
    if (PROBE_REP == 1) { ProbIn P{ws, kp->w_in, G, bx, lds, kp->conv_w}; gm::gemm_stream<ProbIn, PROBE_ABL>(lds, P); }
    if (PROBE_REP == 7) { ProbMoe1 P{ws, kp->w_gate, kp->w_up, kp->b_gate, kp->b_up, MT, G, vcu}; gm::gemm_stream<ProbMoe1, PROBE_ABL>(lds, P); }
    if (PROBE_REP == 8) { ProbMoe2 P{ws, kp->w_down, kp->b_down, MT, G, vcu}; gm::gemm_stream<ProbMoe2, PROBE_ABL>(lds, P); }
}
#endif

extern "C" void kernel_launch(void* const* d_in, const int* in_sizes, int n_in, void* d_out, int out_size, void* d_ws, size_t ws_size, hipStream_t stream) {
    static int grid = 0;
    if (grid == 0) {
        if (n_in != 17 || in_sizes[0] != NTOK * DM || out_size != NTOK * DM || ws_size < WS_END) {
            fprintf(stderr, "kernel_launch: unexpected shapes (n_in %d, in0 %d, out %d, ws %zu); nothing launched\n", n_in, n_in > 0 ? in_sizes[0] : -1, out_size, ws_size); grid = -1; return; }
        int dev = 0, cus = 0, per_cu = 0;
        if (hipGetDevice(&dev) != hipSuccess || hipDeviceGetAttribute(&cus, hipDeviceAttributeMultiprocessorCount, dev) != hipSuccess) { grid = -1; return; }
        if (hipFuncSetAttribute((const void*)mega, hipFuncAttributeMaxDynamicSharedMemorySize, LDS_BYTES) != hipSuccess) { fprintf(stderr, "kernel_launch: hipFuncSetAttribute failed\n"); grid = -1; return; }
        if (hipOccupancyMaxActiveBlocksPerMultiprocessor(&per_cu, (const void*)mega, 512, LDS_BYTES) != hipSuccess || per_cu < 1) {
            fprintf(stderr, "kernel_launch: occupancy query says %d blocks per CU\n", per_cu); }
        (void)hipGetLastError();
        grid = cus;
    }
    if (grid < 0) return;
    (void)hipMemsetAsync((char*)d_ws + WS_CTL, 0, CTL_BYTES, stream);
    Params p{};
    p.x = (const float*)d_in[0]; p.norm_mix = (const float*)d_in[1]; p.w_in = (const float*)d_in[2]; p.conv_w = (const float*)d_in[3];
    p.w_conv_out = (const float*)d_in[4]; p.w_attn_out = (const float*)d_in[5]; p.w_o = (const float*)d_in[6]; p.norm_ffn = (const float*)d_in[7];
    p.w_router = (const float*)d_in[8]; p.b_router = (const float*)d_in[9]; p.w_gate = (const float*)d_in[10]; p.b_gate = (const float*)d_in[11];
    p.w_up = (const float*)d_in[12]; p.b_up = (const float*)d_in[13]; p.w_down = (const float*)d_in[14]; p.b_down = (const float*)d_in[15];
    p.norm_final = (const float*)d_in[16];
    p.out = (float*)d_out; p.ws = (unsigned char*)d_ws;
#if MK_FUSED
    p.ph_lo = 0; p.ph_hi = N_PHASES;
    hipLaunchKernelGGL(mega, dim3(grid), dim3(512), LDS_BYTES, stream, p);
#if PROBE_REP >= 0
    { static bool once = false; if (!once) { once = true; (void)hipFuncSetAttribute((const void*)probe_k, hipFuncAttributeMaxDynamicSharedMemorySize, LDS_BYTES); }
      hipLaunchKernelGGL(probe_k, dim3(grid), dim3(512), LDS_BYTES, stream, p); }
#endif
#else
    for (int ph = 0; ph < N_PHASES; ++ph) { p.ph_lo = ph; p.ph_hi = ph + 1; hipLaunchKernelGGL(mega, dim3(grid), dim3(512), LDS_BYTES, stream, p); }
#endif
}
```

```cpp
#include <hip/hip_runtime.h>
#include <cstdint>
#include <cstdio>

typedef unsigned short bf16_t;
typedef short bf16x8 __attribute__((ext_vector_type(8)));
typedef short s16x4 __attribute__((ext_vector_type(4)));
typedef float f32x4 __attribute__((ext_vector_type(4)));
typedef float f32x16 __attribute__((ext_vector_type(16)));
typedef unsigned u32x4 __attribute__((ext_vector_type(4)));
typedef unsigned u32x2 __attribute__((ext_vector_type(2)));
typedef float f32x2 __attribute__((ext_vector_type(2)));
#define LAS __attribute__((address_space(3)))
#define GAS __attribute__((address_space(1)))

constexpr int DM = 2048, SEQ = 4096, NTOK = 8192, NHEAD = 16, HDIM = 128, NEXP = 32, INC = 16384;
constexpr float NORM_EPS = 1e-5f;
constexpr int N_PHASES = 10;
#ifndef PROBE_REP
#define PROBE_REP -1
#endif
#ifndef PROBE_ABL
#define PROBE_ABL 0
#endif
#ifndef G_DMAPOS
#define G_DMAPOS 2
#endif
#ifndef G_BT
#define G_BT 1
#endif
#ifndef G_PRIO
#define G_PRIO 1
#endif
#ifndef MK_FUSED
#define MK_FUSED 1
#endif

constexpr size_t MiB = 1u << 20;
constexpr size_t WS_CTL = 0, CTL_BYTES = 1 * MiB;
constexpr size_t WS_ROPE = 1 * MiB;
constexpr size_t WS_KMSUM = 256 * 1024;
constexpr size_t WS_SB = 36 * MiB;
constexpr size_t WS_SLOT = 2 * MiB;
constexpr size_t WS_TOKW = 2 * MiB + 128 * 1024;
constexpr size_t WS_EROWS = 2 * MiB + 256 * 1024;
constexpr size_t WS_XN = 4 * MiB;
constexpr size_t WS_BG = 36 * MiB, WS_CG = 68 * MiB, WS_HC = 100 * MiB, WS_GC = 132 * MiB, WS_GA = 164 * MiB;
constexpr size_t WS_Q = 196 * MiB, WS_K = 228 * MiB, WS_V = 260 * MiB;
constexpr size_t WS_CONV = 292 * MiB, WS_ATT = 324 * MiB, WS_MRG = 356 * MiB;
constexpr size_t WS_H1 = 388 * MiB;
constexpr size_t WS_HID = 452 * MiB;
constexpr size_t WS_YB = 612 * MiB;
constexpr size_t WS_W16IN = 772 * MiB;
constexpr size_t WS_W16C = 836 * MiB, WS_W16A = 844 * MiB, WS_W16O = 852 * MiB;
constexpr size_t WS_END = 860 * MiB;
constexpr int CW_BAR = 4096;
constexpr int CW_CNT = 16384;

constexpr int LDS_MAIN = 131072;
constexpr int MISC_OFF = LDS_MAIN;
constexpr int LDS_BYTES = LDS_MAIN + 4096;

__device__ __forceinline__ unsigned cvtpk(float lo, float hi) { unsigned r; asm("v_cvt_pk_bf16_f32 %0, %1, %2" : "=v"(r) : "v"(lo), "v"(hi)); return r; }
__device__ __forceinline__ float bf_lo(unsigned w) { return __uint_as_float(w << 16); }
__device__ __forceinline__ float bf_hi(unsigned w) { return __uint_as_float(w & 0xffff0000u); }
__device__ __forceinline__ float wave_sum(float v) {
#pragma unroll
    for (int o = 1; o < 64; o <<= 1) v += __shfl_xor(v, o);
    return v;
}
__device__ __forceinline__ float fast_exp(float x) { return __builtin_amdgcn_exp2f(x * 1.4426950408889634f); }
__device__ __forceinline__ float sigmoidf_(float x) { return __builtin_amdgcn_rcpf(1.f + fast_exp(-x)); }

#define XB_TMO      128
#define XB_XCNT(j)  (256  + 64 * (j))
#define XB_XSUB(j)  (1280 + 64 * (j))
#define XB_XGEN(j)  (2304 + 64 * (j))
#define XB_TOP      3328
#define XB_TOPGEN   3392
#define XCD_BAR_WORDS 3456
#define XB_SPIN_CAP (1u << 18)
__device__ __forceinline__ unsigned xb_ld(unsigned* p)              { return __hip_atomic_load(p, __ATOMIC_RELAXED, __HIP_MEMORY_SCOPE_AGENT); }
__device__ __forceinline__ unsigned xb_add(unsigned* p, unsigned v) { return __hip_atomic_fetch_add(p, v, __ATOMIC_RELAXED, __HIP_MEMORY_SCOPE_AGENT); }
__device__ __forceinline__ unsigned xb_xcc_id() { return (unsigned)__builtin_amdgcn_s_getreg((3 << 11) | 20) & 0xFu; }
#define XB_SPIN(cond, bar) do { unsigned _sp = 0; while (cond) { __builtin_amdgcn_s_sleep(1); \
    if ((++_sp & 255u) == 0u) { if (xb_ld(&(bar)[XB_TMO])) break; if (_sp > XB_SPIN_CAP) { atomicAdd(&(bar)[XB_TMO], 1u); break; } } } } while (0)
struct XcdBarrier { unsigned* bar; volatile LAS unsigned* st; };
__device__ __forceinline__ XcdBarrier xcd_barrier_post(unsigned* bar, volatile LAS unsigned* st) {
    XcdBarrier b; b.bar = bar; b.st = st;
    if (threadIdx.x == 0) (void)xb_add(&bar[XB_XCNT(xb_xcc_id())], 1u);
    return b;
}
__device__ __forceinline__ void xcd_barrier_complete(unsigned* bar, unsigned x, unsigned& nloc, unsigned& nx) {
    const unsigned G = gridDim.x * gridDim.y * gridDim.z;
    unsigned sum, cnt, mine, sp = 0u;
    for (;;) {
        sum = 0u; cnt = 0u; mine = 0u;
#pragma unroll
        for (unsigned j = 0; j < 16; ++j) { const unsigned c = xb_ld(&bar[XB_XCNT(j)]); sum += c; cnt += (c > 0u) ? 1u : 0u; mine = (j == x) ? c : mine; }
        if (sum == G) break;
        __builtin_amdgcn_s_sleep(1);
        if ((++sp & 255u) == 0u) { if (xb_ld(&bar[XB_TMO])) break; if (sp > XB_SPIN_CAP) { atomicAdd(&bar[XB_TMO], 1u); break; } }
    }
    nloc = mine > 0u ? mine : 1u; nx = cnt > 0u ? cnt : 1u;
}
__device__ __forceinline__ void xcd_barrier(const XcdBarrier& b) {
    asm volatile("s_waitcnt vmcnt(0)" ::: "memory");
    __syncthreads();
    if (threadIdx.x == 0) {
        unsigned* bar = b.bar; const unsigned bx_ = xb_xcc_id();
        __builtin_amdgcn_s_waitcnt(0);
        unsigned nloc = b.st[0], nx = b.st[1];
        if (nloc == 0u) { xcd_barrier_complete(bar, bx_, nloc, nx); b.st[0] = nloc; b.st[1] = nx; }
        const unsigned old = xb_add(&bar[XB_XSUB(bx_)], 1u);
        const unsigned gen = old / nloc;
        if (old + 1u == (gen + 1u) * nloc) {
            __builtin_amdgcn_fence(__ATOMIC_RELEASE, "agent");
            asm volatile("s_waitcnt vmcnt(0)" ::: "memory");
            const unsigned og = xb_add(&bar[XB_TOP], 1u);
            const unsigned tg = og / nx;
            if (og + 1u == (tg + 1u) * nx) xb_add(&bar[XB_TOPGEN], 1u);
            else XB_SPIN(xb_ld(&bar[XB_TOPGEN]) == tg, bar);
            __builtin_amdgcn_fence(__ATOMIC_ACQUIRE, "agent");
            xb_add(&bar[XB_XGEN(bx_)], 1u);
            asm volatile("s_waitcnt vmcnt(0)" ::: "memory");
        } else {
            XB_SPIN(xb_ld(&bar[XB_XGEN(bx_)]) == gen, bar);
            __builtin_amdgcn_fence(__ATOMIC_ACQUIRE, "agent");
            asm volatile("s_waitcnt vmcnt(0)" ::: "memory");
        }
    }
    __syncthreads();
}

namespace gm {
constexpr int HTB = 16384, SB0 = 65536, NT = 32;
__device__ __forceinline__ int lds_byte(int r, int c) { const int st = (r >> 4) * 2 + (c >> 5), rr = r & 15, cc = c & 31, ob = rr * 64 + cc * 2; return st * 1024 + (ob ^ (((ob >> 9) & 1) << 5)); }
__device__ __forceinline__ void stage_rc(int b, int& R, int& C) { const int st = b / 1024, sb = b % 1024, swz = sb ^ (((sb >> 9) & 1) << 5); R = (st >> 1) * 16 + swz / 64; C = (st & 1) * 32 + (swz % 64) / 2; }
__device__ __forceinline__ int inv_perm32(int q) { return 16 * ((q >> 2) & 1) + 4 * (q >> 3) + (q & 3); }
__device__ __forceinline__ int perm32(int rho) { const int n = rho >> 4, i = rho & 15; return 8 * (i >> 2) + 4 * n + (i & 3); }
__device__ __forceinline__ int bswz(int R) { return ((R >> 1) & 7) ^ ((R >> 4) & 1); }

typedef __amdgpu_buffer_rsrc_t rsrc_t;
__device__ __forceinline__ rsrc_t mk_rsrc(const void* base, unsigned bytes) { return __builtin_amdgcn_make_buffer_rsrc((void*)base, 0, bytes, 0x00020000); }

struct Unit {
    unsigned aS;
    unsigned bS0;
    int pm;
    int code;
    __device__ __forceinline__ int pn() const { return code & 255; }
    __device__ __forceinline__ int e() const { return (code >> 8) & 255; }
    __device__ __forceinline__ int aux() const { return (code >> 16) & 255; }
    __device__ __forceinline__ int keep() const { return (code >> 24) & 1; }
};
__device__ __forceinline__ int mk_code(int pn, int e, int aux, int keep) { return pn | (e << 8) | (aux << 16) | (keep << 24); }

template <class P, int ABL = 0>
__device__ __forceinline__ void gemm_stream(LAS unsigned char* lds, const P& S) {
    const int tid = threadIdx.x, wid = __builtin_amdgcn_readfirstlane(tid >> 6), lane = tid & 63;
    const int wr = wid >> 2, wc = wid & 3, fr = lane & 15, fq = lane >> 4;
    constexpr unsigned LDB4 = (unsigned)P::LDB * 4u;
    constexpr unsigned TSTEP = 64u * LDB4;
    int R0, C0, R1, C1; stage_rc(tid * 16, R0, C0); stage_rc(tid * 16 + 8192, R1, C1);
    const unsigned ldsw = (unsigned)wid * 1024u;
    const int aoff = lds_byte(wr * 64 + fr, fq * 8);
    const int bquad = (lane & 7) + 8 * (lane >> 4), bpar = (lane >> 3) & 1;
    unsigned bw0;
    { const int q = 4 * bquad; const int R = P::PERM ? ((q & ~31) + inv_perm32(q & 31)) : q; bw0 = (unsigned)(SB0 + R * 128 + ((wid ^ bswz(R)) << 4) + bpar * 8); }
    const unsigned brow = (unsigned)(SB0 + (wc * 32 + fr) * 128 + ((fq ^ (fr >> 1)) << 4));
    const unsigned boffs = (unsigned)(8 * wid + 4 * bpar) * LDB4 + (unsigned)bquad * 16u;
    constexpr bool B16 = P::B16;
    constexpr unsigned LDB2 = (unsigned)P::LDB * 2u, TSTEP16 = 64u * LDB2;
    const int boct = (lane & 7) + 8 * (lane >> 4);
    const unsigned boffs16 = (unsigned)(8 * wid + 4 * bpar) * LDB2 + (unsigned)boct * 16u;
    const unsigned bw16 = P::PERM ? (unsigned)(SB0 + 4096 * (boct >> 2) + 512 * (boct & 3) + (((wid ^ (2 * (boct & 3)) ^ ((boct >> 2) & 1)) & 7) << 4) + bpar * 8)
                                  : (unsigned)(SB0 + 1024 * boct + (((wid ^ (4 * (boct & 1)) ^ (2 * ((boct >> 1) & 1)) ^ ((boct >> 2) & 1)) & 7) << 4) + bpar * 8);
    const unsigned brow16 = brow ^ (unsigned)((wc & 1) << 4);
    const rsrc_t rA = S.adesc();
    constexpr bool BT = P::BT;
    const int boffT = lds_byte(wc * 32 + fr, fq * 8);
    const unsigned vb = (unsigned)((P::PERM ? ((R0 & ~31) + perm32(R0 & 31)) : R0) * 4096 + C0 * 2);

#define G_SA(b, h) (((b) * 2 + (h)) * HTB)
#define G_DMA(bufoff, soff, o) do { if (ABL != 3) __builtin_amdgcn_raw_ptr_buffer_load_lds(rA, (LAS void*)(lds + (bufoff) + ldsw), 16, (o), (soff), 0, 0); } while (0)
#define G_VO(h, i) (P::GATHER ? vo[2 * (h) + (i)] : vo[0])
#define G_SO(soff, h, i) (P::GATHER ? (soff) : (soff) + (unsigned)(128 * (h) + 64 * (i)) * (unsigned)P::LDA2)
#define G_DMAP(b, h, i, soff) G_DMA(G_SA(b, h) + 8192 * (i), G_SO(soff, h, i), G_VO(h, i))
#define G_LDA(dst, b, h) do { if (ABL == 4) { _Pragma("unroll") for (int m = 0; m < 4; ++m) _Pragma("unroll") for (int k = 0; k < 2; ++k) asm volatile("" : "+v"(dst[m][k])); break; } _Pragma("unroll") for (int m = 0; m < 4; ++m) _Pragma("unroll") for (int k = 0; k < 2; ++k) dst[m][k] = *(const LAS bf16x8*)(lds + G_SA(b, h) + aoff + m * 2048 + k * 1024); } while (0)
#define G_LDB(dst, b, bj) do { if (ABL == 4) { _Pragma("unroll") for (int n = 0; n < 2; ++n) _Pragma("unroll") for (int k = 0; k < 2; ++k) asm volatile("" : "+v"(dst[n][k])); break; } _Pragma("unroll") for (int n = 0; n < 2; ++n) _Pragma("unroll") for (int k = 0; k < 2; ++k) dst[n][k] = *(const LAS bf16x8*)(lds + ((brow ^ (unsigned)((k << 6) | (n << 4))) + n * 2048 + (bj) * 16384 + (b) * 32768)); } while (0)
#define G_MMA(ai, bj, At, Bt, DMA_STMT) do { if (ABL == 1) { _Pragma("unroll") for (int m = 0; m < 4; ++m) _Pragma("unroll") for (int k = 0; k < 2; ++k) asm volatile("" :: "v"(At[m][k])); _Pragma("unroll") for (int n = 0; n < 2; ++n) _Pragma("unroll") for (int k = 0; k < 2; ++k) asm volatile("" :: "v"(Bt[n][k])); DMA_STMT; break; } \
        if (G_PRIO == 1) __builtin_amdgcn_s_setprio(1); \
        _Pragma("unroll") for (int m = 0; m < 2; ++m) _Pragma("unroll") for (int n = 0; n < 2; ++n) _Pragma("unroll") for (int k = 0; k < 2; ++k) acc[ai][bj][m][n] = __builtin_amdgcn_mfma_f32_16x16x32_bf16(Bt[n][k], At[m][k], acc[ai][bj][m][n], 0, 0, 0); \
        G_SCHED; DMA_STMT; G_SCHED; \
        _Pragma("unroll") for (int m = 2; m < 4; ++m) _Pragma("unroll") for (int n = 0; n < 2; ++n) _Pragma("unroll") for (int k = 0; k < 2; ++k) acc[ai][bj][m][n] = __builtin_amdgcn_mfma_f32_16x16x32_bf16(Bt[n][k], At[m][k], acc[ai][bj][m][n], 0, 0, 0); \
        if (G_PRIO == 1) __builtin_amdgcn_s_setprio(0); } while (0)
#define G_DMAB(bufoff, desc, soff) __builtin_amdgcn_raw_ptr_buffer_load_lds((desc), (LAS void*)(lds + (bufoff) + ldsw), 16, vb, (soff), 0, 0)
#define G_STB(b, bj, desc, so) do { const rsrc_t _d = (desc); const unsigned _s = (so) + (unsigned)(bj) * 524288u; G_DMAB(SB0 + (b) * 32768 + (bj) * 16384, _d, _s); G_DMAB(SB0 + (b) * 32768 + (bj) * 16384 + 8192, _d, _s + 262144u); } while (0)
#define G_STA(b, h, so) do { G_DMAP(b, h, 0, so); G_DMAP(b, h, 1, so); } while (0)
#define G_LDBT(dst, b, bj) do { _Pragma("unroll") for (int n = 0; n < 2; ++n) _Pragma("unroll") for (int k = 0; k < 2; ++k) dst[n][k] = *(const LAS bf16x8*)(lds + SB0 + (b) * 32768 + (bj) * 16384 + boffT + n * 2048 + k * 1024); } while (0)
#define G_WAIT_V0 asm volatile("s_waitcnt vmcnt(0)" ::: "memory")
#define G_WAIT_L0 asm volatile("s_waitcnt lgkmcnt(0)" ::: "memory")
#define G_WAIT_B(first) do { if (first) asm volatile("; first load segment of a unit (peel: its counted wait may leave the epilogue's stores in flight)" ::: "memory"); } while (0)
#define G_BAR __builtin_amdgcn_s_barrier()
#define G_SCHED __builtin_amdgcn_sched_barrier(0)
#define G_BLOAD(desc, soff) do { if (ABL == 2) { asm volatile("" : "+v"(br[0]), "+v"(br[1]), "+v"(br[2]), "+v"(br[3])); break; } const rsrc_t _d = (desc); const unsigned _s = (soff); _Pragma("unroll") for (int i = 0; i < 4; ++i) br[i] = __builtin_amdgcn_raw_buffer_load_b128(_d, boffs, _s + (unsigned)i * LDB4, 0); } while (0)
#define G_LDB16(dst, b, bj) do { _Pragma("unroll") for (int n = 0; n < 2; ++n) _Pragma("unroll") for (int k = 0; k < 2; ++k) dst[n][k] = *(const LAS bf16x8*)(lds + ((brow16 ^ (unsigned)((k << 6) | (n << (P::PERM ? 4 : 5)))) + n * 2048 + (bj) * 16384 + (b) * 32768)); } while (0)
#define G_BLOAD16(desc, soff) do { const rsrc_t _d = (desc); const unsigned _s = (soff); _Pragma("unroll") for (int i = 0; i < 4; ++i) br[i] = __builtin_amdgcn_raw_buffer_load_b128(_d, boffs16, _s + (unsigned)i * LDB2, 0); } while (0)
#define G_BWRITE16(b) do { _Pragma("unroll") for (int c = 0; c < 8; ++c) { const unsigned sel_ = (c & 1) ? 0x07060302u : 0x05040100u; u32x2 w_; \
        w_.x = __builtin_amdgcn_perm(br[1][c >> 1], br[0][c >> 1], sel_); w_.y = __builtin_amdgcn_perm(br[3][c >> 1], br[2][c >> 1], sel_); \
        const unsigned ad_ = P::PERM ? ((bw16 ^ (unsigned)(((((c >> 1) & 1) ^ (c >> 2)) & 1) << 4)) + 2048u * (c >> 2) + 128u * (c & 3)) : ((bw16 ^ (unsigned)((c >> 1) << 4)) + 128u * c); \
        *(LAS u32x2*)(lds + ad_ + (b) * 32768) = w_; } } while (0)
#define G_WAITV(n) asm volatile("s_waitcnt vmcnt(" #n ")" ::: "memory")
#define G_F(x) __uint_as_float(x)
#define G_BWRITE(b, bj) do { if (ABL == 5) break; _Pragma("unroll") for (int j = 0; j < 4; ++j) { u32x2 w_; w_.x = cvtpk(G_F(br[0][j]), G_F(br[1][j])); w_.y = cvtpk(G_F(br[2][j]), G_F(br[3][j])); \
        *(LAS u32x2*)(lds + (bw0 ^ (unsigned)((j >> 1) << 4)) + j * 128 + (bj) * 16384 + (b) * 32768) = w_; } } while (0)

    Unit cur, nxt; int ui = 0;
    if (!S.next(0, cur)) return;
    f32x4 acc[2][2][4][2];
#pragma unroll
    for (int a = 0; a < 2; ++a)
#pragma unroll
        for (int b = 0; b < 2; ++b)
#pragma unroll
            for (int m = 0; m < 4; ++m)
#pragma unroll
                for (int n = 0; n < 2; ++n) acc[a][b][m][n] = (f32x4){0.f, 0.f, 0.f, 0.f};
    if constexpr (P::ACCINIT) S.acc_init(acc, cur, wr, wc, fr, fq);
    bf16x8 At[4][2], Bf0[2][2], Bf1[2][2];
    u32x4 br[4];
    unsigned vo[4];
    S.aoff(cur, vo, R0, C0, R1, C1);
    if constexpr (BT) {
    { const rsrc_t rB = S.bdesc(cur.aux(), 0);
      G_STB(0, 0, rB, cur.bS0); G_STB(0, 1, rB, cur.bS0); G_STA(0, 0, cur.aS); G_STA(0, 1, cur.aS);
      G_STB(1, 0, rB, cur.bS0 + 128u); G_STA(1, 0, cur.aS + 128u); G_STB(1, 1, rB, cur.bS0 + 128u); }
    G_WAITV(6); G_BAR;
    if (wr == 1) G_BAR;
    } else if constexpr (B16) {
    G_BLOAD16(S.bdesc(cur.aux(), 0), cur.bS0);
    G_DMAP(0, 0, 0, cur.aS); G_DMAP(0, 0, 1, cur.aS); G_DMAP(0, 1, 0, cur.aS); G_DMAP(0, 1, 1, cur.aS);
    G_WAIT_V0; G_BWRITE16(0); G_SCHED;
    G_BLOAD16(S.bdesc(cur.aux(), 0), cur.bS0 + TSTEP16); G_WAIT_V0; G_BWRITE16(1); G_SCHED;
    G_BLOAD16(S.bdesc(cur.aux(), 0), cur.bS0 + 2u * TSTEP16);
    G_DMAP(1, 0, 0, cur.aS + 128u); G_DMAP(1, 0, 1, cur.aS + 128u);
    G_WAIT_L0; G_BAR;
    if (wr == 1) G_BAR;
    } else {
    G_BLOAD(S.bdesc(cur.aux(), 0), cur.bS0);
    G_DMAP(0, 0, 0, cur.aS); G_DMAP(0, 0, 1, cur.aS); G_DMAP(0, 1, 0, cur.aS); G_DMAP(0, 1, 1, cur.aS);
    G_WAIT_B(true); G_BWRITE(0, 0); G_SCHED;
    G_BLOAD(S.bdesc(cur.aux(), 1), cur.bS0 + P::B1OFF); G_WAIT_B(true); G_BWRITE(0, 1); G_SCHED;
    G_BLOAD(S.bdesc(cur.aux(), 0), cur.bS0 + TSTEP); G_WAIT_B(true); G_BWRITE(1, 0); G_SCHED;
    G_BLOAD(S.bdesc(cur.aux(), 1), cur.bS0 + P::B1OFF + TSTEP);
    G_DMAP(1, 0, 0, cur.aS + 128u); G_DMAP(1, 0, 1, cur.aS + 128u);
    G_WAIT_L0; G_BAR;
    if (wr == 1) G_BAR;
    }
    for (;;) {
        const bool has_next = S.next(ui + 1, nxt);
        if (!has_next) nxt = cur;
        if constexpr (BT) {
        for (int t = 0; t < NT; t += 2) {
            const bool last = (t == NT - 2);
            const unsigned a1 = cur.aS + (unsigned)(t + 1) * 128u;
            const unsigned a2 = last ? nxt.aS : cur.aS + (unsigned)(t + 2) * 128u;
            const unsigned a3 = a2 + 128u;
            const unsigned b2 = last ? nxt.bS0 : cur.bS0 + (unsigned)(t + 2) * 128u;
            const unsigned b3 = b2 + 128u;
            const int bsl = last ? nxt.aux() : cur.aux();
            G_LDBT(Bf0, 0, 0); G_LDBT(Bf1, 0, 1); G_SCHED; G_LDA(At, 0, 0); G_SCHED; G_STA(1, 1, a1);
            G_WAITV(8); G_WAIT_L0; G_BAR; G_MMA(0, 0, At, Bf0, (void)0); G_MMA(0, 1, At, Bf1, (void)0); G_BAR; G_SCHED;
            G_LDA(At, 0, 1); G_SCHED; G_STB(0, 0, S.bdesc(bsl, 0), b2); G_STB(0, 1, S.bdesc(bsl, 0), b2); G_STA(0, 0, a2);
            G_WAITV(8); G_WAIT_L0; G_BAR; G_MMA(1, 0, At, Bf0, (void)0); G_MMA(1, 1, At, Bf1, (void)0); G_BAR; G_SCHED;
            G_LDBT(Bf0, 1, 0); G_LDBT(Bf1, 1, 1); G_SCHED; G_LDA(At, 1, 0); G_SCHED; G_STA(0, 1, a2);
            G_WAITV(8); G_WAIT_L0; G_BAR; G_MMA(0, 0, At, Bf0, (void)0); G_MMA(0, 1, At, Bf1, (void)0); G_BAR; G_SCHED;
            G_LDA(At, 1, 1); G_SCHED; G_STB(1, 0, S.bdesc(bsl, 0), b3); G_STB(1, 1, S.bdesc(bsl, 0), b3); G_STA(1, 0, a3);
            G_WAITV(8); G_WAIT_L0; G_BAR; G_MMA(1, 0, At, Bf0, (void)0); G_MMA(1, 1, At, Bf1, (void)0); G_BAR; G_SCHED;
        }
        } else if constexpr (B16) {
        for (int t = 0; t < NT; t += 2) {
            const bool last = (t == NT - 2), nx4 = (t + 4 >= NT);
            const unsigned a1 = cur.aS + (unsigned)(t + 1) * 128u;
            const unsigned a2 = last ? nxt.aS : cur.aS + (unsigned)(t + 2) * 128u;
            const unsigned a3 = a2 + 128u;
            const unsigned b3 = last ? nxt.bS0 + TSTEP16 : cur.bS0 + (unsigned)(t + 3) * TSTEP16;
            const unsigned b4 = nx4 ? nxt.bS0 + (unsigned)(t + 4 - NT) * TSTEP16 : cur.bS0 + (unsigned)(t + 4) * TSTEP16;
            const int sel3 = last ? nxt.aux() : cur.aux(), sel4 = nx4 ? nxt.aux() : cur.aux();
#define G_DL0(b, h, so) do { if (G_DMAPOS >= 1) G_DMAP(b, h, 0, so); } while (0)
#define G_DL1(b, h, so) do { if (G_DMAPOS == 1) G_DMAP(b, h, 1, so); } while (0)
#define G_DM0(b, h, so) do { if (G_DMAPOS == 0) G_DMAP(b, h, 0, so); } while (0)
#define G_DM1(b, h, so) do { if (G_DMAPOS != 1) G_DMAP(b, h, 1, so); } while (0)
            G_WAITV(6); G_LDB16(Bf0, 0, 0); G_LDB16(Bf1, 0, 1); G_SCHED; G_LDA(At, 0, 0); G_SCHED; G_DL0(1, 1, a1); G_DL1(1, 1, a1);
            G_WAIT_L0; G_BAR; G_MMA(0, 0, At, Bf0, G_DM0(1, 1, a1)); G_MMA(0, 1, At, Bf1, G_DM1(1, 1, a1)); G_BAR; G_SCHED;
            G_WAITV(2); G_BWRITE16(0); G_SCHED; G_BLOAD16(S.bdesc(sel3, 0), b3); G_SCHED;
            G_LDA(At, 0, 1); G_SCHED; G_DL0(0, 0, a2); G_DL1(0, 0, a2);
            G_WAIT_L0; G_BAR; G_MMA(1, 0, At, Bf0, G_DM0(0, 0, a2)); G_MMA(1, 1, At, Bf1, G_DM1(0, 0, a2)); G_BAR; G_SCHED;
            G_WAITV(6); G_LDB16(Bf0, 1, 0); G_LDB16(Bf1, 1, 1); G_SCHED; G_LDA(At, 1, 0); G_SCHED; G_DL0(0, 1, a2); G_DL1(0, 1, a2);
            G_WAIT_L0; G_BAR; G_MMA(0, 0, At, Bf0, G_DM0(0, 1, a2)); G_MMA(0, 1, At, Bf1, G_DM1(0, 1, a2)); G_BAR; G_SCHED;
            G_WAITV(2); G_BWRITE16(1); G_SCHED; G_BLOAD16(S.bdesc(sel4, 0), b4); G_SCHED;
            G_LDA(At, 1, 1); G_SCHED; G_DL0(1, 0, a3); G_DL1(1, 0, a3);
            G_WAIT_L0; G_BAR; G_MMA(1, 0, At, Bf0, G_DM0(1, 0, a3)); G_MMA(1, 1, At, Bf1, G_DM1(1, 0, a3)); G_BAR; G_SCHED;
#undef G_DL0
#undef G_DL1
#undef G_DM0
#undef G_DM1
        }
        } else {
        for (int t = 0; t < NT; t += 2) {
            const bool last = (t == NT - 2);
            const unsigned a1 = cur.aS + (unsigned)(t + 1) * 128u;
            const unsigned a2 = last ? nxt.aS : cur.aS + (unsigned)(t + 2) * 128u;
            const unsigned a3 = a2 + 128u;
            const unsigned b20 = last ? nxt.bS0 : cur.bS0 + (unsigned)(t + 2) * TSTEP;
            const unsigned b21 = b20 + P::B1OFF;
            const int bsl = last ? nxt.aux() : cur.aux();
            G_WAIT_B(t == 0); G_BWRITE(1, 1); G_SCHED; G_BLOAD(S.bdesc(bsl, 0), b20); G_SCHED;
            G_LDB(Bf0, 0, 0); G_SCHED; G_LDA(At, 0, 0);
            G_WAIT_L0; G_BAR; G_LDB(Bf1, 0, 1); G_SCHED; G_MMA(0, 0, At, Bf0, G_DMAP(1, 1, 0, a1)); G_MMA(0, 1, At, Bf1, G_DMAP(1, 1, 1, a1)); G_BAR; G_SCHED;
            if (P::GATHER) { if (last) { int tz = threadIdx.x; asm volatile("" : "+v"(tz)); int r0, c0, r1, c1; stage_rc(tz * 16, r0, c0); stage_rc(tz * 16 + 8192, r1, c1); S.aoff(nxt, vo, r0, c0, r1, c1); } }
            G_WAIT_B(P::GATHER && last); G_BWRITE(0, 0); G_SCHED; G_BLOAD(S.bdesc(bsl, 1), b21); G_SCHED;
            G_LDA(At, 0, 1); G_SCHED;
            G_WAIT_L0; G_BAR; G_MMA(1, 0, At, Bf0, G_DMAP(0, 0, 0, a2)); G_MMA(1, 1, At, Bf1, G_DMAP(0, 0, 1, a2)); G_BAR; G_SCHED;
            G_WAIT_B(false); G_BWRITE(0, 1); G_SCHED; G_BLOAD(S.bdesc(bsl, 0), b20 + TSTEP); G_SCHED;
            G_LDB(Bf0, 1, 0); G_SCHED; G_LDA(At, 1, 0);
            G_WAIT_L0; G_BAR; G_LDB(Bf1, 1, 1); G_SCHED; G_MMA(0, 0, At, Bf0, G_DMAP(0, 1, 0, a2)); G_MMA(0, 1, At, Bf1, G_DMAP(0, 1, 1, a2)); G_BAR; G_SCHED;
            G_WAIT_B(false); G_BWRITE(1, 0); G_SCHED; G_BLOAD(S.bdesc(bsl, 1), b21 + TSTEP); G_SCHED;
            G_LDA(At, 1, 1); G_SCHED;
            G_WAIT_L0; G_BAR; G_MMA(1, 0, At, Bf0, G_DMAP(1, 0, 0, a3)); G_MMA(1, 1, At, Bf1, G_DMAP(1, 0, 1, a3)); G_BAR; G_SCHED;
        }
        }
        if (wr == 0) G_BAR;
        if (ABL == 0) S.epi(acc, cur, wr, wc, fr, fq);
        else {
#pragma unroll
            for (int a = 0; a < 2; ++a)
#pragma unroll
                for (int b = 0; b < 2; ++b)
#pragma unroll
                    for (int m = 0; m < 4; ++m)
#pragma unroll
                        for (int n = 0; n < 2; ++n) asm volatile("" :: "v"(acc[a][b][m][n]));
        }
        if (!cur.keep()) {
#pragma unroll
            for (int a = 0; a < 2; ++a)
#pragma unroll
                for (int b = 0; b < 2; ++b)
#pragma unroll
                    for (int m = 0; m < 4; ++m)
#pragma unroll
                        for (int n = 0; n < 2; ++n) acc[a][b][m][n] = (f32x4){0.f, 0.f, 0.f, 0.f};
        }
        if (!has_next) break;
        if constexpr (P::ACCINIT) S.acc_init(acc, nxt, wr, wc, fr, fq);
        cur = nxt;
        ++ui;
        if (wr == 1) G_BAR;
    }
    G_WAIT_V0;
    asm volatile("" :: "v"(br[0]), "v"(br[1]), "v"(br[2]), "v"(br[3]));
    G_BAR;
#undef G_SA
#undef G_STAGE
#undef G_DMA
#undef G_DMAP
#undef G_VO
#undef G_SO
#undef G_WAIT_B
#undef G_LDA
#undef G_LDB
#undef G_MMA
#undef G_WAIT_V0
#undef G_WAIT_L0
#undef G_BAR
#undef G_SCHED
#undef G_BLOAD
#undef G_DMAB
#undef G_STB
#undef G_STA
#undef G_LDBT
#undef G_BLOAD16
#undef G_BWRITE16
#undef G_LDB16
#undef G_WAITV
#undef G_BWRITE
#undef G_F
}

__device__ __forceinline__ bool static_tile(int L, int nM, int nN, int& pm, int& pn) {
    const int nwg = nM * nN; if (L >= nwg) return false;
    int wgid = L; { const int q = nwg / 8, r = nwg % 8, xcd = wgid % 8, off = wgid / 8; wgid = (xcd < r ? xcd * (q + 1) : r * (q + 1) + (xcd - r) * q) + off; }
    const int nig = 8 * nN, gid = wgid / nig, fm = gid * 8, gsz = (nM - fm) < 8 ? (nM - fm) : 8;
    pm = fm + ((wgid % nig) % gsz); pn = (wgid % nig) / gsz; return true;
}
__device__ __forceinline__ void plain_aoff(unsigned (&v)[4], int lda2, int R0, int C0, int R1, int C1) {
    v[0] = (unsigned)(R0 * lda2 + C0 * 2); v[1] = (unsigned)(R1 * lda2 + C1 * 2);
    v[2] = (unsigned)((128 + R0) * lda2 + C0 * 2); v[3] = (unsigned)((128 + R1) * lda2 + C1 * 2);
}
}

__device__ __forceinline__ int in_rowmap(int col) {
    const int g = col >> 11, c = col & 2047;
    if (g == 3 || g == 4 || g == 5 || g == 7) { const int gi = g == 7 ? 3 : g - 3; return (32 + gi * 8 + (c >> 8)) * 256 + (c & 255); }
    const int pn = c >> 6, ch = c & 63, bj = (g == 2 || g == 6) ? 1 : 0, n = (g == 1 || g == 6) ? 1 : 0;
    return pn * 256 + 128 * bj + 32 * (ch >> 4) + 8 * ((ch >> 2) & 3) + 4 * n + (ch & 3);
}
template <bool MAPIN = false>
__device__ __forceinline__ void p0_transpose_item(const float* W, int N, bf16_t* WT, LAS float* scr, int item, int lane) {
    const int nblk = N / 32, kb = item / nblk, nb = item % nblk, k0 = 64 * kb, n0 = 32 * nb;
    const GAS float* Wg = (const GAS float*)W;
#pragma unroll 8
    for (int i = 0; i < 32; ++i) { const int kk = 2 * i + (lane >> 5); scr[kk * 33 + (lane & 31)] = Wg[(size_t)(k0 + kk) * N + n0 + (lane & 31)]; }
    asm volatile("s_waitcnt lgkmcnt(0)" ::: "memory");
    const int c = lane & 7;
#pragma unroll
    for (int j = 0; j < 4; ++j) { const int n = (lane >> 3) + 8 * j; const LAS float* sp = scr + (8 * c) * 33 + n;
        u32x4 o; o.x = cvtpk(sp[0], sp[33]); o.y = cvtpk(sp[66], sp[99]); o.z = cvtpk(sp[132], sp[165]); o.w = cvtpk(sp[198], sp[231]);
        *(GAS u32x4*)(WT + (size_t)(MAPIN ? in_rowmap(n0 + n) : n0 + n) * 2048 + k0 + 8 * c) = o; }
    asm volatile("s_waitcnt lgkmcnt(0)" ::: "memory");
}

struct Params {
    const float* x; const float* norm_mix; const float* w_in; const float* conv_w; const float* w_conv_out; const float* w_attn_out; const float* w_o;
    const float* norm_ffn; const float* w_router; const float* b_router; const float* w_gate; const float* b_gate; const float* w_up; const float* b_up;
    const float* w_down; const float* b_down; const float* norm_final;
    float* out; unsigned char* ws;
    int ph_lo, ph_hi;
};

struct ProbIn {
    static constexpr bool B16 = true; static constexpr int LDA2 = 4096; static constexpr bool PERM = true, GATHER = false; static constexpr int LDB = INC; static constexpr unsigned B1OFF = 512; static constexpr bool BT = (G_BT != 0); static constexpr bool ACCINIT = false;
    const unsigned char* ws; const float* w_in; int G, c; LAS unsigned char* lds; const float* conv_w;
    __device__ __forceinline__ bool next(int i, gm::Unit& u) const {
        int pm, pn; if (!gm::static_tile(i * G + c, 32, 64, pm, pn)) return false;
        pm = __builtin_amdgcn_readfirstlane(pm); pn = __builtin_amdgcn_readfirstlane(pn);
        u.aS = (unsigned)(WS_XN + (size_t)pm * MiB); u.bS0 = G_BT ? ((unsigned)pn << 20) : (unsigned)pn * 512u; u.pm = pm; u.code = gm::mk_code(pn, 0, 0, 0); return true;
    }
    __device__ __forceinline__ gm::rsrc_t adesc() const { return gm::mk_rsrc(ws, (unsigned)WS_END); }
    __device__ __forceinline__ gm::rsrc_t bdesc(int, int) const { return gm::mk_rsrc(ws + WS_W16IN, 2048u * 16384u * 2u); }
    __device__ __forceinline__ void aoff(const gm::Unit&, unsigned (&v)[4], int R0, int C0, int R1, int C1) const { gm::plain_aoff(v, 4096, R0, C0, R1, C1); }
    __device__ __forceinline__ void epi(f32x4 (&acc)[2][2][4][2], const gm::Unit& u, int wr, int wc, int fr, int fq) const {
        const int row0 = u.pm * 256 + wr * 64 + fr;
        if (u.pn() < 32) {
            bf16_t* CONV = (bf16_t*)(ws + WS_CONV); bf16_t* GCb = (bf16_t*)(ws + WS_GC); float* SB = (float*)(ws + WS_SB) + (size_t)u.pm * (6 * 2048);
            const int chl = 16 * wc + 4 * fq, ch = 64 * u.pn() + chl;
            LAS float* halo = (LAS float*)(lds + MISC_OFF + 1024);
#pragma unroll
            for (int ai = 0; ai < 2; ++ai) {
                const f32x4 u3 = acc[ai][0][3][1] * acc[ai][1][3][0];
                if (fr >= 14) { *(LAS f32x4*)(halo + ((ai * 2 + wr) * 2 + (fr - 14)) * 64 + chl) = u3;
                    if (ai == 1 && wr == 1) *(GAS f32x4*)(SB + (fr - 14) * 2048 + ch) = u3; }
            }
            asm volatile("s_waitcnt lgkmcnt(0)" ::: "memory");
            __builtin_amdgcn_s_barrier();
            const f32x4 w0 = *(const GAS f32x4*)(conv_w + ch), w1 = *(const GAS f32x4*)(conv_w + 2048 + ch), w2 = *(const GAS f32x4*)(conv_w + 4096 + ch);
#pragma unroll
            for (int ai = 0; ai < 2; ++ai) {
                f32x4 h14 = {0.f, 0.f, 0.f, 0.f}, h15 = h14;
                if (wr == 1 || ai == 1) { const LAS float* hp = halo + ((wr == 1 ? ai * 2 : 1) * 2) * 64 + chl; h14 = *(const LAS f32x4*)hp; h15 = *(const LAS f32x4*)(hp + 64); }
                f32x4 prev = {0.f, 0.f, 0.f, 0.f};
#pragma unroll
                for (int m = 0; m < 4; ++m) {
                    const int row = row0 + ai * 128 + m * 16;
                    const f32x4 bg = acc[ai][0][m][0], uu = acc[ai][0][m][1] * acc[ai][1][m][0], gc = acc[ai][1][m][1];
                    f32x4 u1, u2;
#pragma unroll
                    for (int i = 0; i < 4; ++i) {
                        const float r1 = __int_as_float(__builtin_amdgcn_update_dpp(0, __float_as_int(uu[i]), 0x111, 0xf, 0xf, true));
                        const float r2 = __int_as_float(__builtin_amdgcn_update_dpp(0, __float_as_int(uu[i]), 0x112, 0xf, 0xf, true));
                        float p1, p2;
                        if (m == 0) { p1 = h15[i]; p2 = fr == 0 ? h14[i] : h15[i]; }
                        else { p1 = __int_as_float(__builtin_amdgcn_update_dpp(0, __float_as_int(prev[i]), 0x10f, 0xf, 0xf, true));
                               p2 = __int_as_float(__builtin_amdgcn_update_dpp(0, __float_as_int(prev[i]), 0x10e, 0xf, 0xf, true)); }
                        u1[i] = fr >= 1 ? r1 : p1; u2[i] = fr >= 2 ? r2 : p2;
                    }
                    const f32x4 y = bg * (w0 * u2 + w1 * u1 + w2 * uu);
                    u32x2 o; o.x = cvtpk(y[0], y[1]); o.y = cvtpk(y[2], y[3]);
                    *(GAS u32x2*)(CONV + (size_t)row * 2048 + ch) = o;
                    u32x2 g2; g2.x = cvtpk(gc[0], gc[1]); g2.y = cvtpk(gc[2], gc[3]);
                    *(GAS u32x2*)(GCb + (size_t)row * 2048 + ch) = g2;
                    if (ai == 0 && m == 0 && wr == 0 && fr < 2) { *(GAS f32x4*)(SB + (2 + 2 * fr) * 2048 + ch) = bg; *(GAS f32x4*)(SB + (3 + 2 * fr) * 2048 + ch) = uu; }
                    prev = uu;
                }
            }
            return;
        }
        const int q_ = u.pn() - 32, gi_ = q_ >> 3, grp = gi_ == 3 ? 7 : 3 + gi_, ct = q_ & 7;
        if (grp >= 3 && grp <= 5) {
            bf16_t* buf = (bf16_t*)(ws + (grp == 3 ? WS_Q : (grp == 4 ? WS_K : WS_V)));
            const bool rope = (grp != 5) && (wc == 0);
            const float* COS = (const float*)(ws + WS_ROPE); const float* SIN = COS + 4096 * 16;
            f32x4 ks[2][2] = {{{0.f, 0.f, 0.f, 0.f}, {0.f, 0.f, 0.f, 0.f}}, {{0.f, 0.f, 0.f, 0.f}, {0.f, 0.f, 0.f, 0.f}}};
            if (rope) {
#pragma unroll
                for (int ai = 0; ai < 2; ++ai) {
                    f32x4 cs[4][4];
#pragma unroll
                    for (int m = 0; m < 4; ++m) { const int s = (row0 + ai * 128 + m * 16) & 4095;
                        const GAS f32x4* cp = (const GAS f32x4*)(COS + s * 16 + 8 * (fq & 1)); const GAS f32x4* sp = (const GAS f32x4*)(SIN + s * 16 + 8 * (fq & 1));
                        cs[m][0] = cp[0]; cs[m][1] = cp[1]; cs[m][2] = sp[0]; cs[m][3] = sp[1]; }
                    __builtin_amdgcn_sched_barrier(0);
#pragma unroll
                    for (int m = 0; m < 4; ++m) {
                        const int row = row0 + ai * 128 + m * 16; const int b = row >> 12, s = row & 4095;
                        const f32x4 c0 = cs[m][0], c1 = cs[m][1]; f32x4 s0 = cs[m][2], s1 = cs[m][3]; if (fq < 2) { s0 = -s0; s1 = -s1; }
#pragma unroll
                        for (int bj = 0; bj < 2; ++bj) {
                            f32x4 v0 = acc[ai][bj][m][0], v1 = acc[ai][bj][m][1]; f32x4 p0, p1;
#pragma unroll
                            for (int i = 0; i < 4; ++i) { p0[i] = __shfl_xor(v0[i], 32); p1[i] = __shfl_xor(v1[i], 32); }
                            v0 = v0 * c0 + p0 * s0; v1 = v1 * c1 + p1 * s1;
                            ks[bj][0] += v0; ks[bj][1] += v1;
                            const int head = ct * 2 + bj;
                            u32x4 w; w.x = cvtpk(v0[0], v0[1]); w.y = cvtpk(v0[2], v0[3]); w.z = cvtpk(v1[0], v1[1]); w.w = cvtpk(v1[2], v1[3]);
                            *(GAS u32x4*)(buf + ((size_t)((b * 16 + head) * 4096 + s)) * 128 + wc * 32 + 8 * fq) = w;
                        }
                    }
                }
            } else {
#pragma unroll
                for (int ai = 0; ai < 2; ++ai)
#pragma unroll
                    for (int m = 0; m < 4; ++m) {
                        const int row = row0 + ai * 128 + m * 16; const int b = row >> 12, s = row & 4095;
#pragma unroll
                        for (int bj = 0; bj < 2; ++bj) {
                            const f32x4 v0 = acc[ai][bj][m][0], v1 = acc[ai][bj][m][1];
                            ks[bj][0] += v0; ks[bj][1] += v1;
                            const int head = ct * 2 + bj;
                            u32x4 w; w.x = cvtpk(v0[0], v0[1]); w.y = cvtpk(v0[2], v0[3]); w.z = cvtpk(v1[0], v1[1]); w.w = cvtpk(v1[2], v1[3]);
                            *(GAS u32x4*)(buf + ((size_t)((b * 16 + head) * 4096 + s)) * 128 + wc * 32 + 8 * fq) = w;
                        }
                    }
            }
            if (grp == 4) {
                float* KS = (float*)(ws + WS_KMSUM) + ((size_t)(((u.pm >> 4) * 16 + ct * 2) * 16 + (u.pm & 15))) * 128 + wc * 32 + 8 * fq;
#pragma unroll
                for (int bj = 0; bj < 2; ++bj)
#pragma unroll
                    for (int h = 0; h < 2; ++h)
#pragma unroll
                        for (int i = 0; i < 4; ++i) { float t = ks[bj][h][i];
                            t += __shfl_xor(t, 1); t += __shfl_xor(t, 2); t += __shfl_xor(t, 4); t += __shfl_xor(t, 8);
                            if (fr == 0) (void)__hip_atomic_fetch_add(KS + (size_t)bj * 16 * 128 + 4 * h + i, t, __ATOMIC_RELAXED, __HIP_MEMORY_SCOPE_AGENT); }
            }
        } else {
            const size_t off = WS_GA;
            bf16_t* buf = (bf16_t*)(ws + off);
#pragma unroll
            for (int ai = 0; ai < 2; ++ai)
#pragma unroll
                for (int m = 0; m < 4; ++m) {
                    const int row = row0 + ai * 128 + m * 16;
#pragma unroll
                    for (int bj = 0; bj < 2; ++bj) {
                        const f32x4 v0 = acc[ai][bj][m][0], v1 = acc[ai][bj][m][1];
                        u32x4 w; w.x = cvtpk(v0[0], v0[1]); w.y = cvtpk(v0[2], v0[3]); w.z = cvtpk(v1[0], v1[1]); w.w = cvtpk(v1[2], v1[3]);
                        *(GAS u32x4*)(buf + (size_t)row * 2048 + ct * 256 + bj * 128 + wc * 32 + 8 * fq) = w;
                    }
                }
        }
    }
};

struct ProbMerge {
    static constexpr bool B16 = true; static constexpr int LDA2 = 4096; static constexpr bool PERM = true, GATHER = false; static constexpr int LDB = 2048; static constexpr unsigned B1OFF = 512; static constexpr bool BT = (G_BT != 0); static constexpr bool ACCINIT = false;
    const unsigned char* ws; const float* wc_out; const float* wa_out; int G, c;
    __device__ __forceinline__ bool next(int i, gm::Unit& u) const {
        int pm, pn; if (!gm::static_tile((i >> 1) * G + c, 32, 8, pm, pn)) return false;
        pm = __builtin_amdgcn_readfirstlane(pm); pn = __builtin_amdgcn_readfirstlane(pn);
        const int seg = i & 1;
        u.aS = (unsigned)((seg ? WS_ATT : WS_CONV) + (size_t)pm * MiB); u.bS0 = G_BT ? ((unsigned)pn << 20) : (unsigned)pn * 512u;
        u.pm = pm; u.code = gm::mk_code(pn, 0, seg, seg ? 0 : 1); return true;
    }
    __device__ __forceinline__ gm::rsrc_t adesc() const { return gm::mk_rsrc(ws, (unsigned)WS_END); }
    __device__ __forceinline__ gm::rsrc_t bdesc(int sel, int) const { return gm::mk_rsrc(ws + (sel ? WS_W16A : WS_W16C), 2048u * 2048u * 2u); }
    __device__ __forceinline__ void aoff(const gm::Unit&, unsigned (&v)[4], int R0, int C0, int R1, int C1) const { gm::plain_aoff(v, 4096, R0, C0, R1, C1); }
    __device__ __forceinline__ void epi(f32x4 (&acc)[2][2][4][2], const gm::Unit& u, int wr, int wc, int fr, int fq) const {
        const bf16_t* GC = (const bf16_t*)(ws + WS_GC); const bf16_t* GA = (const bf16_t*)(ws + WS_GA); bf16_t* MRG = (bf16_t*)(ws + WS_MRG);
        const int row0 = u.pm * 256 + wr * 64 + fr, col0 = u.pn() * 256 + wc * 32 + 8 * fq; const int seg = u.aux();
        if (seg == 0) {
#pragma unroll
            for (int ai = 0; ai < 2; ++ai) {
                u32x4 ga[4][2], gc[4][2];
#pragma unroll
                for (int m = 0; m < 4; ++m)
#pragma unroll
                    for (int bj = 0; bj < 2; ++bj) { const size_t idx = (size_t)(row0 + ai * 128 + m * 16) * 2048 + col0 + bj * 128;
                        ga[m][bj] = *(const GAS u32x4*)(GA + idx); gc[m][bj] = *(const GAS u32x4*)(GC + idx); }
                __builtin_amdgcn_sched_barrier(0);
#pragma unroll
                for (int m = 0; m < 4; ++m)
#pragma unroll
                    for (int bj = 0; bj < 2; ++bj) {
                        const u32x4 a = ga[m][bj], c = gc[m][bj];
                        const float fa[8] = {bf_lo(a.x), bf_hi(a.x), bf_lo(a.y), bf_hi(a.y), bf_lo(a.z), bf_hi(a.z), bf_lo(a.w), bf_hi(a.w)};
                        const float fc[8] = {bf_lo(c.x), bf_hi(c.x), bf_lo(c.y), bf_hi(c.y), bf_lo(c.z), bf_hi(c.z), bf_lo(c.w), bf_hi(c.w)};
#pragma unroll
                        for (int i = 0; i < 8; ++i) { const float r = (1.f + fast_exp(-fa[i])) * __builtin_amdgcn_rcpf(1.f + fast_exp(-fc[i])); acc[ai][bj][m][i >> 2][i & 3] *= r; }
                    }
            }
        } else {
#pragma unroll
            for (int ai = 0; ai < 2; ++ai) {
                u32x4 ga[4][2];
#pragma unroll
                for (int m = 0; m < 4; ++m)
#pragma unroll
                    for (int bj = 0; bj < 2; ++bj) ga[m][bj] = *(const GAS u32x4*)(GA + (size_t)(row0 + ai * 128 + m * 16) * 2048 + col0 + bj * 128);
                __builtin_amdgcn_sched_barrier(0);
#pragma unroll
                for (int m = 0; m < 4; ++m)
#pragma unroll
                    for (int bj = 0; bj < 2; ++bj) {
                        const size_t idx = (size_t)(row0 + ai * 128 + m * 16) * 2048 + col0 + bj * 128;
                        const u32x4 a = ga[m][bj];
                        const float fa[8] = {bf_lo(a.x), bf_hi(a.x), bf_lo(a.y), bf_hi(a.y), bf_lo(a.z), bf_hi(a.z), bf_lo(a.w), bf_hi(a.w)};
                        float o[8];
#pragma unroll
                        for (int i = 0; i < 8; ++i) o[i] = acc[ai][bj][m][i >> 2][i & 3] * sigmoidf_(fa[i]);
                        u32x4 w; w.x = cvtpk(o[0], o[1]); w.y = cvtpk(o[2], o[3]); w.z = cvtpk(o[4], o[5]); w.w = cvtpk(o[6], o[7]);
                        *(GAS u32x4*)(MRG + idx) = w;
                    }
            }
        }
    }
};

struct ProbWo {
    static constexpr bool B16 = true; static constexpr int LDA2 = 4096; static constexpr bool PERM = false, GATHER = false; static constexpr int LDB = 2048; static constexpr unsigned B1OFF = 512; static constexpr bool BT = (G_BT != 0); static constexpr bool ACCINIT = true;
    const unsigned char* ws; const float* w_o; const float* x; int G, c;
    __device__ __forceinline__ bool next(int i, gm::Unit& u) const {
        int pm, pn; if (!gm::static_tile(i * G + c, 32, 8, pm, pn)) return false;
        pm = __builtin_amdgcn_readfirstlane(pm); pn = __builtin_amdgcn_readfirstlane(pn);
        u.aS = (unsigned)(WS_MRG + (size_t)pm * MiB); u.bS0 = G_BT ? ((unsigned)pn << 20) : (unsigned)pn * 512u; u.pm = pm; u.code = gm::mk_code(pn, 0, 0, 0); return true;
    }
    __device__ __forceinline__ gm::rsrc_t adesc() const { return gm::mk_rsrc(ws, (unsigned)WS_END); }
    __device__ __forceinline__ gm::rsrc_t bdesc(int, int) const { return gm::mk_rsrc(ws + WS_W16O, 2048u * 2048u * 2u); }
    __device__ __forceinline__ void aoff(const gm::Unit&, unsigned (&v)[4], int R0, int C0, int R1, int C1) const { gm::plain_aoff(v, 4096, R0, C0, R1, C1); }
    __device__ __forceinline__ void acc_init(f32x4 (&acc)[2][2][4][2], const gm::Unit& u, int wr, int wc, int fr, int fq) const {
        const int row0 = u.pm * 256 + wr * 64 + fr, col0 = u.pn() * 256 + wc * 32 + 4 * fq;
#pragma unroll
        for (int ai = 0; ai < 2; ++ai)
#pragma unroll
            for (int m = 0; m < 4; ++m)
#pragma unroll
                for (int bj = 0; bj < 2; ++bj)
#pragma unroll
                    for (int n = 0; n < 2; ++n)
                        acc[ai][bj][m][n] = *(const GAS f32x4*)(x + (size_t)(row0 + ai * 128 + m * 16) * 2048 + col0 + bj * 128 + n * 16);
    }
    __device__ __forceinline__ void epi(f32x4 (&acc)[2][2][4][2], const gm::Unit& u, int wr, int wc, int fr, int fq) const {
        float* H1 = (float*)(ws + WS_H1);
        const int row0 = u.pm * 256 + wr * 64 + fr, col0 = u.pn() * 256 + wc * 32 + 4 * fq;
#pragma unroll
        for (int ai = 0; ai < 2; ++ai)
#pragma unroll
            for (int m = 0; m < 4; ++m) {
                const int row = row0 + ai * 128 + m * 16;
#pragma unroll
                for (int bj = 0; bj < 2; ++bj)
#pragma unroll
                    for (int n = 0; n < 2; ++n) {
                        const size_t idx = (size_t)row * 2048 + col0 + bj * 128 + n * 16;
                        *(GAS f32x4*)(H1 + idx) = acc[ai][bj][m][n];
                    }
            }
    }
};

struct MoeTab { const LAS int* pre; const LAS int* cnt; };
__device__ __forceinline__ bool moe_decode(const MoeTab& T, int L, int ntn, int& e, int& mt, int& pn) {
    const int tot = T.pre[32];
    if (L >= tot * ntn) return false;
    int ee = 0;
    while (ee < 31 && L >= ntn * T.pre[ee + 1]) ++ee;
    const int v = L - ntn * T.pre[ee], te = T.pre[ee + 1] - T.pre[ee];
    e = __builtin_amdgcn_readfirstlane(ee); pn = __builtin_amdgcn_readfirstlane(v / te); mt = __builtin_amdgcn_readfirstlane(v % te);
    return true;
}
struct ProbMoe1 {
    static constexpr bool B16 = false; static constexpr int LDA2 = 4096; static constexpr bool PERM = true, GATHER = true; static constexpr int LDB = 2048; static constexpr unsigned B1OFF = 0; static constexpr bool BT = false; static constexpr bool ACCINIT = false;
    const unsigned char* ws; const float* w_gate; const float* w_up; const float* b_gate; const float* b_up; MoeTab T; int G, vcu;
    __device__ __forceinline__ bool next(int i, gm::Unit& u) const {
        int e, mt, pn; if (!moe_decode(T, i * G + vcu, 16, e, mt, pn)) return false;
        u.aS = (unsigned)WS_XN; u.bS0 = (unsigned)e * (2048u * 2048u * 4u) + (unsigned)pn * 512u;
        u.pm = __builtin_amdgcn_readfirstlane(T.pre[e]) + mt; u.code = gm::mk_code(pn, e, mt, 0); return true;
    }
    __device__ __forceinline__ gm::rsrc_t adesc() const { return gm::mk_rsrc(ws, (unsigned)WS_END); }
    __device__ __forceinline__ gm::rsrc_t bdesc(int, int h) const { return gm::mk_rsrc(h ? w_up : w_gate, 32u * 2048u * 2048u * 4u); }
    __device__ __forceinline__ void aoff(const gm::Unit& u, unsigned (&v)[4], int R0, int C0, int R1, int C1) const {
        const int* er = (const int*)(ws + WS_EROWS) + u.e() * 8192; const int cnt = T.cnt[u.e()]; const int base = u.aux() * 256;
        int i0 = base + R0, i1 = base + R1, i2 = base + 128 + R0, i3 = base + 128 + R1;
        i0 = i0 < cnt ? i0 : cnt - 1; i1 = i1 < cnt ? i1 : cnt - 1; i2 = i2 < cnt ? i2 : cnt - 1; i3 = i3 < cnt ? i3 : cnt - 1;
        const int t0 = __hip_atomic_load(er + i0, __ATOMIC_RELAXED, __HIP_MEMORY_SCOPE_AGENT), t1 = __hip_atomic_load(er + i1, __ATOMIC_RELAXED, __HIP_MEMORY_SCOPE_AGENT);
        const int t2 = __hip_atomic_load(er + i2, __ATOMIC_RELAXED, __HIP_MEMORY_SCOPE_AGENT), t3 = __hip_atomic_load(er + i3, __ATOMIC_RELAXED, __HIP_MEMORY_SCOPE_AGENT);
        v[0] = (unsigned)(t0 * 4096 + C0 * 2); v[1] = (unsigned)(t1 * 4096 + C1 * 2); v[2] = (unsigned)(t2 * 4096 + C0 * 2); v[3] = (unsigned)(t3 * 4096 + C1 * 2);
    }
    __device__ __forceinline__ void epi(f32x4 (&acc)[2][2][4][2], const gm::Unit& u, int wr, int wc, int fr, int fq) const {
        bf16_t* HID = (bf16_t*)(ws + WS_HID);
        const int row0 = u.pm * 256 + wr * 64 + fr, col0 = u.pn() * 128 + wc * 32 + 8 * fq;
        const GAS f32x4* bgp = (const GAS f32x4*)(b_gate + u.e() * 2048 + col0); const GAS f32x4* bup = (const GAS f32x4*)(b_up + u.e() * 2048 + col0);
        const f32x4 bg0 = bgp[0], bg1 = bgp[1], bu0 = bup[0], bu1 = bup[1];
#pragma unroll
        for (int ai = 0; ai < 2; ++ai)
#pragma unroll
            for (int m = 0; m < 4; ++m) {
                const int row = row0 + ai * 128 + m * 16;
                float o[8];
#pragma unroll
                for (int i = 0; i < 8; ++i) {
                    float g = acc[ai][0][m][i >> 2][i & 3] + (i < 4 ? bg0[i & 3] : bg1[i & 3]);
                    float uu = acc[ai][1][m][i >> 2][i & 3] + (i < 4 ? bu0[i & 3] : bu1[i & 3]);
                    g = fminf(g, 7.f); uu = fminf(fmaxf(uu, -7.f), 7.f);
                    o[i] = (uu + 1.f) * (g * sigmoidf_(1.702f * g));
                }
                u32x4 w; w.x = cvtpk(o[0], o[1]); w.y = cvtpk(o[2], o[3]); w.z = cvtpk(o[4], o[5]); w.w = cvtpk(o[6], o[7]);
                *(GAS u32x4*)(HID + (size_t)row * 2048 + col0) = w;
            }
    }
};
struct ProbMoe2 {
    static constexpr bool B16 = false; static constexpr int LDA2 = 4096; static constexpr bool PERM = true, GATHER = false; static constexpr int LDB = 2048; static constexpr unsigned B1OFF = 512; static constexpr bool BT = false; static constexpr bool ACCINIT = false;
    const unsigned char* ws; const float* w_down; const float* b_down; MoeTab T; int G, vcu;
    __device__ __forceinline__ bool next(int i, gm::Unit& u) const {
        int e, mt, pn; if (!moe_decode(T, i * G + vcu, 8, e, mt, pn)) return false;
        const int pm = __builtin_amdgcn_readfirstlane(T.pre[e]) + mt;
        u.aS = (unsigned)(WS_HID + (size_t)pm * MiB); u.bS0 = (unsigned)e * (2048u * 2048u * 4u) + (unsigned)pn * 1024u;
        u.pm = pm; u.code = gm::mk_code(pn, e, mt, 0); return true;
    }
    __device__ __forceinline__ gm::rsrc_t adesc() const { return gm::mk_rsrc(ws, (unsigned)WS_END); }
    __device__ __forceinline__ gm::rsrc_t bdesc(int, int) const { return gm::mk_rsrc(w_down, 32u * 2048u * 2048u * 4u); }
    __device__ __forceinline__ void aoff(const gm::Unit&, unsigned (&v)[4], int R0, int C0, int R1, int C1) const { gm::plain_aoff(v, 4096, R0, C0, R1, C1); }
    __device__ __forceinline__ void epi(f32x4 (&acc)[2][2][4][2], const gm::Unit& u, int wr, int wc, int fr, int fq) const {
        bf16_t* YB = (bf16_t*)(ws + WS_YB);
        const int row0 = u.pm * 256 + wr * 64 + fr, col0 = u.pn() * 256 + wc * 32 + 8 * fq;
#pragma unroll
        for (int bj = 0; bj < 2; ++bj) {
            const GAS f32x4* bp = (const GAS f32x4*)(b_down + u.e() * 2048 + col0 + bj * 128);
            const f32x4 b0 = bp[0], b1 = bp[1];
#pragma unroll
            for (int ai = 0; ai < 2; ++ai)
#pragma unroll
                for (int m = 0; m < 4; ++m) {
                    const int row = row0 + ai * 128 + m * 16;
                    const f32x4 v0 = acc[ai][bj][m][0] + b0, v1 = acc[ai][bj][m][1] + b1;
                    u32x4 w; w.x = cvtpk(v0[0], v0[1]); w.y = cvtpk(v0[2], v0[3]); w.z = cvtpk(v1[0], v1[1]); w.w = cvtpk(v1[2], v1[3]);
                    *(GAS u32x4*)(YB + (size_t)row * 2048 + col0 + bj * 128) = w;
                }
        }
    }
};

namespace at {
constexpr int D = 128, NW = 8, QBLK = 32, KVBLK = 64, QB = 256, OSTR = 2048;
constexpr int SHM_V = KVBLK * D * 2, SHM_K = KVBLK * D * 2;
constexpr int GATE_OFF = 2 * SHM_V + 2 * SHM_K + NW * 64 * 4;
constexpr float SCALE = 0.08838834764831845f, THR = 8.f;
constexpr int WBIG = 1 << 30;
#define KSWZ(row, colB) ((row) * 256 + ((colB) ^ (((row) & 7) << 4)))
#define SBAR() __builtin_amdgcn_sched_barrier(0)
__device__ __forceinline__ int v_st(int k, int c) { const int kk = (k & ~0xC) | ((k & 4) << 1) | ((k & 8) >> 1); return ((kk >> 3) * 4 + (c >> 5)) * 512 + ((kk & 7) * 32 + (c & 31)) * 2; }
__device__ __forceinline__ int v_rd_base(int lane) { return ((lane & 3) << 3) | (((lane >> 2) & 3) << 6) | (((lane >> 4) & 1) << 5) | (((lane >> 5) & 1) << 8); }
constexpr int v_rd_off(int d0, int ks, int half) { return d0 * 512 + ks * 4096 + half * 2048; }
__device__ __forceinline__ int crow(int r, int hi) { return (r & 3) + 8 * (r >> 2) + 4 * hi; }
__device__ __forceinline__ unsigned cvtpkv(float lo, float hi) { unsigned r; asm volatile("v_cvt_pk_bf16_f32 %0, %1, %2" : "=v"(r) : "v"(lo), "v"(hi)); return r; }
__device__ __forceinline__ bf16x8 load8(const bf16_t* p) { return *reinterpret_cast<const bf16x8*>(p); }
__device__ __forceinline__ void mask_tile(f32x16& p0, f32x16& p1, int dq, unsigned W) {
    const float NEG = -__builtin_inff();
#pragma unroll
    for (int r = 0; r < 16; ++r) {
        const int c = (r & 3) + 8 * (r >> 2);
        if ((unsigned)(dq - c) >= W) p0[r] = NEG;
        if ((unsigned)(dq - c - 32) >= W) p1[r] = NEG;
    }
}
__device__ __forceinline__ void partialSM(f32x16& p0, f32x16& p1, float& m_reg, float& mn, float& alpha, bool rowsel) {
    float pmax = p0[0]; for (int r = 1; r < 16; ++r) pmax = fmaxf(pmax, p0[r]); for (int r = 0; r < 16; ++r) pmax = fmaxf(pmax, p1[r]);
    { auto rr = __builtin_amdgcn_permlane32_swap(__float_as_uint(pmax), __float_as_uint(pmax), false, false);
      pmax = fmaxf(__uint_as_float(rr[0]), __uint_as_float(rr[1])); }
    if (!rowsel) pmax = -__builtin_inff();
    constexpr float C2 = 1.4426950408889634f * SCALE;
    if (__builtin_expect(__all((pmax - m_reg) * SCALE <= THR), 1)) { mn = m_reg; alpha = 1.f; }
    else { mn = fmaxf(m_reg, pmax); alpha = __builtin_amdgcn_exp2f((m_reg - mn) * C2); m_reg = mn; }
    const float mnL = rowsel ? -mn * C2 : -__builtin_inff();
    for (int r = 0; r < 16; ++r) p0[r] = fmaf(p0[r], C2, mnL); for (int r = 0; r < 16; ++r) p1[r] = fmaf(p1[r], C2, mnL);
    for (int r = 0; r < 16; ++r) p0[r] = __builtin_amdgcn_exp2f(p0[r]);
}
__device__ __forceinline__ void finishSM(f32x16& p0, f32x16& p1, float alpha, float& l_reg, bf16x8& pa0, bf16x8& pa1, bf16x8& pa2, bf16x8& pa3) {
    for (int r = 0; r < 16; ++r) p1[r] = __builtin_amdgcn_exp2f(p1[r]);
    float ps = 0; for (int r = 0; r < 16; ++r) ps += p0[r]; for (int r = 0; r < 16; ++r) ps += p1[r];
    { auto rr = __builtin_amdgcn_permlane32_swap(__float_as_uint(ps), __float_as_uint(ps), false, false);
      ps = __uint_as_float(rr[0]) + __uint_as_float(rr[1]); }
    l_reg = l_reg * alpha + ps;
#define PK4(P, B_, OUT) do { unsigned a0 = cvtpkv(P[B_+0], P[B_+1]), a1 = cvtpkv(P[B_+2], P[B_+3]);                          \
        unsigned b0 = cvtpkv(P[B_+4], P[B_+5]), b1 = cvtpkv(P[B_+6], P[B_+7]);                                             \
        auto r0 = __builtin_amdgcn_permlane32_swap(a0, b0, false, false); auto r1 = __builtin_amdgcn_permlane32_swap(a1, b1, false, false); \
        u32x4 w = {r0[0], r1[0], r0[1], r1[1]}; OUT = *reinterpret_cast<bf16x8*>(&w); } while (0)
    PK4(p0, 0, pa0); PK4(p0, 8, pa1); PK4(p1, 0, pa2); PK4(p1, 8, pa3);
#undef PK4
}
template <int KB>
__device__ __forceinline__ void qkt(f32x16& p0, f32x16& p1, const char* K_lds, int r32, int hi, const bf16x8* qr) {
    p0 = f32x16{}; p1 = f32x16{};
    const char* kb[4];
#pragma unroll
    for (int dd = 0; dd < 4; ++dd) kb[dd] = K_lds + KB * SHM_K + KSWZ(r32, (dd * 16 + hi * 8) * 2);
#pragma unroll
    for (int d0 = 0; d0 < 8; ++d0) { const char* a = kb[d0 & 3] + (d0 >> 2) * 128;
        bf16x8 b0 = *reinterpret_cast<const bf16x8*>(a);
        bf16x8 b1 = *reinterpret_cast<const bf16x8*>(a + 32 * 256);
        p0 = __builtin_amdgcn_mfma_f32_32x32x16_bf16(b0, qr[d0], p0, 0, 0, 0);
        p1 = __builtin_amdgcn_mfma_f32_32x32x16_bf16(b1, qr[d0], p1, 0, 0, 0); }
}
__device__ __forceinline__ void gate_scores(f32x16& g, const char* G_lds, int r32, int hi, const bf16x8* qr) {
    g = f32x16{};
#pragma unroll
    for (int d0 = 0; d0 < 8; ++d0) { const char* a = G_lds + KSWZ(r32, ((d0 & 3) * 16 + hi * 8) * 2) + (d0 >> 2) * 128;
        bf16x8 b0 = *reinterpret_cast<const bf16x8*>(a);
        g = __builtin_amdgcn_mfma_f32_32x32x16_bf16(b0, qr[d0], g, 0, 0, 0); }
}
template <int VB>
__device__ __forceinline__ void pv_tile(f32x16* o, int vb0, bf16x8 pa0, bf16x8 pa1, bf16x8 pa2, bf16x8 pa3) {
#define TRRD(dst, off) asm volatile("ds_read_b64_tr_b16 %0, %1 offset:%2" : "=&v"(dst) : "v"(vb0), "i"(off) : "memory")
#define PV_D0(d0) do { s16x4 l0, l1, l2, l3, h0, h1, h2, h3; constexpr int b_ = VB * SHM_V + v_rd_off(d0, 0, 0); \
        TRRD(l0, b_); TRRD(h0, b_ + 2048); TRRD(l1, b_ + 4096); TRRD(h1, b_ + 6144); TRRD(l2, b_ + 8192); TRRD(h2, b_ + 10240); TRRD(l3, b_ + 12288); TRRD(h3, b_ + 14336); \
        asm volatile("s_waitcnt lgkmcnt(0)" ::: "memory"); SBAR();   \
        o[d0] = __builtin_amdgcn_mfma_f32_32x32x16_bf16(pa0, (bf16x8){l0[0], l0[1], l0[2], l0[3], h0[0], h0[1], h0[2], h0[3]}, o[d0], 0, 0, 0);   \
        o[d0] = __builtin_amdgcn_mfma_f32_32x32x16_bf16(pa1, (bf16x8){l1[0], l1[1], l1[2], l1[3], h1[0], h1[1], h1[2], h1[3]}, o[d0], 0, 0, 0);   \
        o[d0] = __builtin_amdgcn_mfma_f32_32x32x16_bf16(pa2, (bf16x8){l2[0], l2[1], l2[2], l2[3], h2[0], h2[1], h2[2], h2[3]}, o[d0], 0, 0, 0);   \
        o[d0] = __builtin_amdgcn_mfma_f32_32x32x16_bf16(pa3, (bf16x8){l3[0], l3[1], l3[2], l3[3], h3[0], h3[1], h3[2], h3[3]}, o[d0], 0, 0, 0); } while (0)
    PV_D0(0); PV_D0(1); PV_D0(2); PV_D0(3);
#undef PV_D0
#undef TRRD
}

struct BlockRef { unsigned q, k, v, o, km; int P0; };
struct Seam { bf16x8 qr[8]; bf16x8 st_v0, st_v1, st_k0, st_k1; };
typedef __amdgpu_buffer_rsrc_t rs_t;
__device__ __forceinline__ bf16x8 bl8(rs_t rs, unsigned voff, unsigned soff) { u32x4 t = __builtin_amdgcn_raw_buffer_load_b128(rs, voff, soff, 0); return *reinterpret_cast<bf16x8*>(&t); }
#define VMW() asm volatile("s_waitcnt vmcnt(0)" ::: "memory")
#define VMWN(n) asm volatile("s_waitcnt vmcnt(%0)" :: "i"(n) : "memory")
#define SLOAD_H(Ko, Vo, k0) do { const unsigned kb__ = (unsigned)(k0) * 256u; S.st_v0 = bl8(rs, kvo, (Vo) + kb__); S.st_v1 = bl8(rs, kvo, (Vo) + kb__ + 8192u);              \
                         S.st_k0 = bl8(rs, kvo, (Ko) + kb__); S.st_k1 = bl8(rs, kvo, (Ko) + kb__ + 8192u); } while (0)
#define SWRITE_HK(bf) do { *(bf16x8*)(K_lds + (bf) * SHM_K + kws) = S.st_k0; *(bf16x8*)(K_lds + (bf) * SHM_K + kws + 32 * 256) = S.st_k1; } while (0)
#define SWRITE_HV(bf) do { *(bf16x8*)(V_lds + (bf) * SHM_V + vst0) = S.st_v0; *(bf16x8*)(V_lds + (bf) * SHM_V + vst1) = S.st_v1; } while (0)
#define SWRITE_H(bf) do { SWRITE_HV(bf); SWRITE_HK(bf); } while (0)
#define QLOAD(qo) do { _Pragma("unroll") for (int d0 = 0; d0 < 8; ++d0) S.qr[d0] = bl8(rs, qvo + d0 * 32, (qo)); } while (0)
__device__ __forceinline__ void moba_prime(const BlockRef& cur, rs_t rs, char* lds, Seam& S) {
    const int tid = threadIdx.x, wid = __builtin_amdgcn_readfirstlane(tid >> 6), lane = tid & 63, r32 = lane & 31, hi = lane >> 5;
    const int sr = tid >> 4, sc = (tid & 15) * 8, kws = KSWZ(sr, sc * 2); char* K_lds = lds + 2 * SHM_V;
    const unsigned kvo = (unsigned)(sr * 128 + sc) * 2u, qvo = (unsigned)((wid * QBLK + r32) * 128 + hi * 8) * 2u;
    QLOAD(cur.q);
    SLOAD_H(cur.k, cur.v, 0); VMW(); SWRITE_HK(0);
    __syncthreads();
}
__device__ __forceinline__ void moba_block(const BlockRef& cur, const BlockRef& nxt, rs_t rs, char* lds, Seam& S) {
    const int tid = threadIdx.x, wid = __builtin_amdgcn_readfirstlane(tid >> 6), lane = tid & 63, r32 = lane & 31, hi = lane >> 5;
    const int own = cur.P0 >> 8;
    const int NT = 4 * own + 4;
    const int qlo = cur.P0 + wid * QBLK, qm = qlo + r32 - 4 * hi;
    char* V_lds = lds; char* K_lds = lds + 2 * SHM_V; char* G_lds = lds + GATE_OFF;
    float* ws = (float*)(lds + 2 * SHM_V + 2 * SHM_K) + wid * 64; float* li_l = ws, * al_l = ws + 32;
    const int sr = tid >> 4, sc = (tid & 15) * 8, vst0 = v_st(sr, sc), vst1 = v_st(32 + sr, sc), kws = KSWZ(sr, sc * 2);
    const unsigned kvo = (unsigned)(sr * 128 + sc) * 2u, qvo = (unsigned)((wid * QBLK + r32) * 128 + hi * 8) * 2u;
    { bf16x8 z = {0, 0, 0, 0, 0, 0, 0, 0};
      if (tid < 256) { const u32x4 s0 = __builtin_amdgcn_raw_buffer_load_b128(rs, 2u * kvo, cur.km, 0), s1 = __builtin_amdgcn_raw_buffer_load_b128(rs, 2u * kvo + 16u, cur.km, 0);
          const float q = 1.f / 256.f; u32x4 w;
          w.x = cvtpkv(__uint_as_float(s0.x) * q, __uint_as_float(s0.y) * q); w.y = cvtpkv(__uint_as_float(s0.z) * q, __uint_as_float(s0.w) * q);
          w.z = cvtpkv(__uint_as_float(s1.x) * q, __uint_as_float(s1.y) * q); w.w = cvtpkv(__uint_as_float(s1.z) * q, __uint_as_float(s1.w) * q); z = *reinterpret_cast<bf16x8*>(&w); }
      *(bf16x8*)(G_lds + KSWZ(sr, sc * 2)) = z; }
    __syncthreads();
    unsigned selmask = 0;
    { f32x16 g; gate_scores(g, G_lds, r32, hi, S.qr);
      float s[16];
#pragma unroll
      for (int r = 0; r < 8; ++r) { const float mine = g[r], oth = __shfl_xor(mine, 32);
          const float lo = hi ? oth : mine, hv = hi ? mine : oth;
          s[(r & 3) + 8 * (r >> 2)] = lo; s[(r & 3) + 8 * (r >> 2) + 4] = hv; }
      const float NEGI = -__builtin_inff();
#pragma unroll
      for (int j = 0; j < 16; ++j) if (j >= own) s[j] = NEGI;
#pragma unroll
      for (int k = 0; k < 3; ++k) { float best = NEGI; int bi = -1;
#pragma unroll
          for (int j = 0; j < 16; ++j) { const bool tk = s[j] > best; best = tk ? s[j] : best; bi = tk ? j : bi; }
          if (bi >= 0) { selmask |= 1u << bi;
#pragma unroll
              for (int j = 0; j < 16; ++j) if (j == bi) s[j] = NEGI; } }
    }
    float m_reg = -1e30f, l_reg = 0; f32x16 o[4] = {};
    const int vb0 = (int)(uintptr_t)V_lds + v_rd_base(lane);
    const unsigned Kh = cur.k, Vh = cur.v;
#define RESC(a) do { if (__any((a) < 1.f)) { if (hi == 0) al_l[r32] = (a); asm volatile("s_waitcnt lgkmcnt(0)" ::: "memory");              \
                     for (int d_ = 0; d_ < 4; ++d_) for (int r = 0; r < 16; ++r) o[d_][r] *= al_l[crow(r, hi)]; } } while (0)
#define KBASE(t) ((t) * KVBLK)
#define ROWSEL(t) ((((t) >> 2) >= own) || ((selmask >> ((t) >> 2)) & 1u))
#define MASKT(P0_, P1_, t) do { const int kb_ = KBASE(t); if (kb_ + KVBLK - 1 > qlo) mask_tile(P0_, P1_, qm - kb_, (unsigned)WBIG); } while (0)
    constexpr int NQL = 8;
#define SEAM_K0() do { VMWN(NQL); SWRITE_HK(0); SBAR(); } while (0)
    f32x16 pA0, pA1, pB0, pB1; float mnA, mnB, alA, alB; bf16x8 pa0, pa1, pa2, pa3;
    SWRITE_HV(0); SBAR();
    if (NT > 1) { SLOAD_H(Kh, Vh, KBASE(1)); }
    SBAR(); qkt<0>(pA0, pA1, K_lds, r32, hi, S.qr);
    MASKT(pA0, pA1, 0); partialSM(pA0, pA1, m_reg, mnA, alA, ROWSEL(0));
    if (NT > 1) { VMW(); SWRITE_H(1); }
    __syncthreads();
#define HALF_STEP(PX0, PX1, mnX, alX, PY0, PY1, alY, t, KB, VB, SB) do {                                                      \
        SBAR(); qkt<KB>(PX0, PX1, K_lds, r32, hi, S.qr);                                                                      \
        finishSM(PY0, PY1, alY, l_reg, pa0, pa1, pa2, pa3); SBAR();                                                           \
        if ((t) + 1 < NT) { SLOAD_H(Kh, Vh, KBASE((t) + 1)); SBAR(); }                                                        \
        pv_tile<VB>(o, vb0, pa0, pa1, pa2, pa3); MASKT(PX0, PX1, (t)); partialSM(PX0, PX1, m_reg, mnX, alX, ROWSEL(t));       \
        __syncthreads();                                                                                                      \
        if ((t) + 1 < NT) { VMW(); SWRITE_H(SB); }                                                                            \
        RESC(alX); __syncthreads(); } while (0)
    for (int t = 1; t + 1 < NT; t += 2) {
        HALF_STEP(pB0, pB1, mnB, alB, pA0, pA1, alA, t, 1, 0, 0);
        HALF_STEP(pA0, pA1, mnA, alA, pB0, pB1, alB, t + 1, 0, 1, 1);
    }
    SBAR(); qkt<1>(pB0, pB1, K_lds, r32, hi, S.qr); SBAR();
    SLOAD_H(nxt.k, nxt.v, 0); SBAR();
    QLOAD(nxt.q);
    SBAR();
    finishSM(pA0, pA1, alA, l_reg, pa0, pa1, pa2, pa3); SBAR();
    pv_tile<0>(o, vb0, pa0, pa1, pa2, pa3);
    MASKT(pB0, pB1, NT - 1); partialSM(pB0, pB1, m_reg, mnB, alB, true); __syncthreads(); RESC(alB);
    finishSM(pB0, pB1, alB, l_reg, pa0, pa1, pa2, pa3); SBAR(); pv_tile<1>(o, vb0, pa0, pa1, pa2, pa3);
    SBAR(); SEAM_K0();
    if (hi == 0) li_l[r32] = l_reg; asm volatile("s_waitcnt lgkmcnt(0)" ::: "memory");
    float rli[16];
#pragma unroll
    for (int r = 0; r < 16; ++r) rli[r] = __builtin_amdgcn_rcpf(li_l[crow(r, hi)]);
    int tz = threadIdx.x; asm volatile("" : "+v"(tz));
    const int r32e = tz & 31, hie = (tz >> 5) & 1;
    const unsigned osoff = cur.o + (unsigned)(wid * QBLK) * (unsigned)(OSTR * 2);
#pragma unroll
    for (int r = 0; r < 16; ++r) { const unsigned ob = (unsigned)(crow(r, hie) * OSTR + r32e) * 2u;
#pragma unroll
        for (int d0 = 0; d0 < 4; ++d0) { const float v = o[d0][r] * rli[r];
            const float vn = __shfl_xor(v, 1);
            if ((r32e & 1) == 0) __builtin_amdgcn_raw_buffer_store_b32(cvtpkv(v, vn), rs, ob + d0 * 64, osoff, 0); } }
    __syncthreads();
#undef RESC
#undef KBASE
#undef ROWSEL
#undef MASKT
#undef SEAM_K0
#undef HALF_STEP
}
#undef QLOAD
#undef VMW
#undef VMWN
#undef SLOAD_H
#undef SWRITE_HK
#undef SWRITE_HV
#undef SWRITE_H
}

__device__ __constant__ double ROPE_INVF[16] = {1.0, 0.4403666026717805, 0.1939227447486858, 0.08539710028576561, 0.03760603093086394, 0.016560440080994443,
    0.007292664737217109, 0.0032114459947525913, 0.0014142135623730955, 0.0006227724219145962, 0.00027424817567620724, 0.00012076973741146502,
    5.318295896944988e-05, 2.3419998961409345e-05, 1.0313385377212461e-05, 4.541670480607871e-06};

__device__ __forceinline__ void sincos_d(double a, double& sn, double& cs) {
    const double k = __builtin_rint(a * 0.63661977236758134308);
    double y = __builtin_fma(-k, 1.57079632679489655800e+00, a); y = __builtin_fma(-k, 6.12323399573676603587e-17, y);
    const double z = y * y;
    double s = -7.6471637318198164759e-13; s = s * z + 1.6059043836821614599e-10; s = s * z - 2.5052108385441718775e-08; s = s * z + 2.7557319223985890653e-06;
    s = s * z - 1.9841269841269841270e-04; s = s * z + 8.3333333333333333333e-03; s = s * z - 1.6666666666666666667e-01; s = y + y * z * s;
    double c = 4.7794773323873852974e-14; c = c * z - 1.1470745597729724714e-11; c = c * z + 2.0876756987868098979e-09; c = c * z - 2.7557319223985890653e-07;
    c = c * z + 2.4801587301587301587e-05; c = c * z - 1.3888888888888888889e-03; c = c * z + 4.1666666666666666667e-02; c = c * z - 0.5; c = 1.0 + z * c;
    const int q = ((int)k) & 3;
    sn = (q == 0) ? s : (q == 1) ? c : (q == 2) ? -s : -c;
    cs = (q == 0) ? c : (q == 1) ? -s : (q == 2) ? -c : s;
}

typedef const __attribute__((address_space(4))) Params* KP;
__device__ __forceinline__ KP kparams() { KP k = (KP)__builtin_amdgcn_kernarg_segment_ptr(); asm volatile("" : "+s"(k)); return k; }

__global__ void __launch_bounds__(512, 2) mega(Params p_unused) {
    extern __shared__ __attribute__((aligned(16))) unsigned char lds_raw[];
    LAS unsigned char* lds = (LAS unsigned char*)lds_raw;
#define PH_IDS int tid = threadIdx.x; asm volatile("" : "+v"(tid)); const int lane = tid & 63, wave = __builtin_amdgcn_readfirstlane(tid >> 6); (void)lane; (void)wave
    const int G = gridDim.x, bx = blockIdx.x;
    const int vcu = (G % 8 == 0) ? (bx % 8) * (G / 8) + bx / 8 : bx;
    unsigned char* ws; int lo, hi;
    { KP k = kparams(); ws = k->ws; lo = k->ph_lo; hi = k->ph_hi; }
    unsigned* ctl = (unsigned*)(ws + WS_CTL);
    volatile LAS unsigned* MISC = (volatile LAS unsigned*)(lds + MISC_OFF);
    { PH_IDS; for (int u = tid; u < (LDS_BYTES - MISC_OFF) / 4; u += 512) MISC[u] = 0u; }
    __syncthreads();
    XcdBarrier bar; bar.bar = ctl + CW_BAR; bar.st = MISC;
    if (hi - lo > 1) bar = xcd_barrier_post(ctl + CW_BAR, MISC);
#ifndef PH_MASK
#define PH_MASK 0x3ff
#endif
#define IN(k) ((((PH_MASK) >> (k)) & 1) && lo <= (k) && (k) < hi)
#define SEAM(k) do { if (IN(k) && IN((k) + 1)) xcd_barrier(bar); } while (0)
    LAS int* pre = (LAS int*)(lds + MISC_OFF + 64);
    LAS int* cntl = (LAS int*)(lds + MISC_OFF + 256);

    if (IN(0)) {
        PH_IDS; KP kp = kparams(); const float* px = kp->x; const float* pnm = kp->norm_mix;
        const int gw = vcu * 8 + wave, NGW = G * 8;
        bf16_t* XN = (bf16_t*)(ws + WS_XN);
        for (int m = gw; m < NTOK; m += NGW) {
            const GAS f32x4* xr = (const GAS f32x4*)(px + (size_t)m * DM) + lane;
            f32x4 v[8]; float s = 0.f;
#pragma unroll
            for (int j = 0; j < 8; ++j) { v[j] = xr[64 * j]; s += (v[j].x * v[j].x + v[j].y * v[j].y) + (v[j].z * v[j].z + v[j].w * v[j].w); }
            const float rs = 1.f / sqrtf(wave_sum(s) * (1.f / DM) + NORM_EPS);
            GAS u32x2* o8 = (GAS u32x2*)(XN + (size_t)m * DM) + lane;
#pragma unroll
            for (int j = 0; j < 8; ++j) { const f32x4 g = *((const GAS f32x4*)pnm + lane + 64 * j);
                u32x2 w; w.x = cvtpk(v[j].x * rs * g.x, v[j].y * rs * g.y); w.y = cvtpk(v[j].z * rs * g.z, v[j].w * rs * g.w); o8[64 * j] = w; }
        }
        if (G_BT) {
            LAS float* scr = (LAS float*)(lds + wave * 8448);
            for (int it = gw; it < 16384 + 3 * 2048; it += NGW) {
                int r = it; const float* W; size_t off; int N;
                if (r < 16384) { W = kp->w_in; off = WS_W16IN; N = 16384; }
                else { r -= 16384; const int q = r >> 11; r &= 2047; W = q == 0 ? kp->w_conv_out : (q == 1 ? kp->w_attn_out : kp->w_o); off = q == 0 ? WS_W16C : (q == 1 ? WS_W16A : WS_W16O); N = 2048; }
                if (N == 16384) p0_transpose_item<true>(W, N, (bf16_t*)(ws + off), scr, r, lane); else p0_transpose_item<false>(W, N, (bf16_t*)(ws + off), scr, r, lane);
            }
        } else
        { const float* srcs[4] = {kp->w_in, kp->w_conv_out, kp->w_attn_out, kp->w_o};
          const size_t offs[4] = {WS_W16IN, WS_W16C, WS_W16A, WS_W16O}; const int n8s[4] = {2048 * 16384 / 8, 2048 * 2048 / 8, 2048 * 2048 / 8, 2048 * 2048 / 8};
#pragma unroll
          for (int q = 0; q < 4; ++q) { const GAS f32x4* sp = (const GAS f32x4*)srcs[q]; GAS u32x4* dp = (GAS u32x4*)(ws + offs[q]);
              for (int i = vcu * 512 + tid; i < n8s[q]; i += G * 512) { const f32x4 a = sp[2 * i], b = sp[2 * i + 1];
                  u32x4 w; w.x = cvtpk(a.x, a.y); w.y = cvtpk(a.z, a.w); w.z = cvtpk(b.x, b.y); w.w = cvtpk(b.z, b.w); dp[i] = w; } } }
        float* COS = (float*)(ws + WS_ROPE); float* SIN = COS + 4096 * 16;
        for (int i = vcu * 512 + tid; i < 4096 * 16; i += G * 512) { const int pos = i >> 4, f = i & 15;
            double sn, cs; sincos_d((double)pos * ROPE_INVF[f], sn, cs); COS[i] = (float)cs; SIN[i] = (float)sn; }
    }
    SEAM(0);
    if (IN(1)) { KP kp = kparams(); ProbIn P{ws, kp->w_in, G, bx, lds, kp->conv_w}; gm::gemm_stream<ProbIn>(lds, P); }
    SEAM(1);
    if (IN(3)) {
        const at::rs_t rs = __builtin_amdgcn_make_buffer_rsrc((void*)ws, 0, (unsigned)WS_END, 0x00020000);
        { PH_IDS;
          KP kp = kparams(); const float* pcw = kp->conv_w; const float* SBp = (const float*)(ws + WS_SB); bf16_t* CONV = (bf16_t*)(ws + WS_CONV);
          for (int it = vcu * 512 + tid; it < 32 * 2 * 512; it += G * 512) {
              const int c4 = (it & 511) * 4, r01 = (it >> 9) & 1, pm = it >> 10;
              if ((pm & 15) != 0) {
                  const float* cur = SBp + (size_t)pm * (6 * 2048) + c4; const float* prv = SBp + (size_t)(pm - 1) * (6 * 2048) + c4;
                  const f32x4 w0 = *(const GAS f32x4*)(pcw + c4), w1 = *(const GAS f32x4*)(pcw + 2048 + c4), w2 = *(const GAS f32x4*)(pcw + 4096 + c4);
                  const f32x4 p254 = *(const GAS f32x4*)prv, p255 = *(const GAS f32x4*)(prv + 2048);
                  const f32x4 bg0 = *(const GAS f32x4*)(cur + 2 * 2048), u0 = *(const GAS f32x4*)(cur + 3 * 2048), bg1 = *(const GAS f32x4*)(cur + 4 * 2048), u1 = *(const GAS f32x4*)(cur + 5 * 2048);
                  const f32x4 y = r01 == 0 ? bg0 * (w0 * p254 + w1 * p255 + w2 * u0) : bg1 * (w0 * p255 + w1 * u0 + w2 * u1);
                  u32x2 o; o.x = cvtpk(y[0], y[1]); o.y = cvtpk(y[2], y[3]);
                  *(GAS u32x2*)(CONV + (size_t)(pm * 256 + r01) * 2048 + c4) = o;
              }
          } }
        int L = vcu;
        if (L < 256) {
            int pass = 0;
#define MK_REF(r, L_, p_) do { const int bh = (L_) >> 3, x_ = (L_) & 7, qb = (p_) ? 15 - x_ : x_; const int b_ = bh >> 4, h_ = bh & 15; \
                r.q = (unsigned)(WS_Q + ((size_t)bh * 4096 + qb * 256) * 256); r.k = (unsigned)(WS_K + (size_t)bh * MiB); r.v = (unsigned)(WS_V + (size_t)bh * MiB); \
                r.o = (unsigned)(WS_ATT + ((size_t)(b_ * 4096 + qb * 256)) * 4096 + h_ * 256); r.km = (unsigned)(WS_KMSUM + (size_t)bh * 8192); r.P0 = qb * 256; } while (0)
            at::BlockRef cur, nxt; MK_REF(cur, L, 0);
            at::Seam S;
            at::moba_prime(cur, rs, (char*)lds_raw, S);
            for (;;) {
                const bool more_pass = (pass == 0), more_item = (L + G < 256), last = !more_pass && !more_item;
                int passn = pass + 1, Ln = L;
                if (!more_pass) { passn = 0; Ln = more_item ? L + G : L; }
                if (last) nxt = cur; else MK_REF(nxt, Ln, passn);
                at::moba_block(cur, nxt, rs, (char*)lds_raw, S);
                if (last) break;
                cur = nxt; pass = passn; L = Ln;
            }
#undef MK_REF
        }
    }
    SEAM(3);
    if (IN(4)) { KP kp = kparams(); ProbMerge P{ws, kp->w_conv_out, kp->w_attn_out, G, bx}; gm::gemm_stream<ProbMerge>(lds, P); }
    SEAM(4);
    if (IN(5)) { KP kp = kparams(); ProbWo P{ws, kp->w_o, kp->x, G, bx}; gm::gemm_stream<ProbWo>(lds, P); }
    SEAM(5);
    if (IN(6)) {
        PH_IDS;
        const float* H1 = (const float*)(ws + WS_H1); bf16_t* XN2 = (bf16_t*)(ws + WS_XN);
        KP kp = kparams(); const float* pnf = kp->norm_ffn; const float* pwr = kp->w_router; const float* pbr = kp->b_router;
        int* SLOT = (int*)(ws + WS_SLOT); float* TOKW = (float*)(ws + WS_TOKW); int* EROWS = (int*)(ws + WS_EROWS);
        LAS float* rs_l = (LAS float*)lds;
        LAS float* part = (LAS float*)(lds + 1024);
        LAS float* lg = (LAS float*)(lds + 1024 + 32768);
        for (int rb = vcu; rb < NTOK / 32; rb += G) {
#pragma unroll 1
            for (int rr = 0; rr < 4; ++rr) {
                const int rl = wave * 4 + rr, m = rb * 32 + rl;
                const GAS f32x4* xr = (const GAS f32x4*)(H1 + (size_t)m * DM) + lane;
                f32x4 v[8]; float s = 0.f;
#pragma unroll
                for (int j = 0; j < 8; ++j) { v[j] = xr[64 * j]; s += (v[j].x * v[j].x + v[j].y * v[j].y) + (v[j].z * v[j].z + v[j].w * v[j].w); }
                const float rs = 1.f / sqrtf(wave_sum(s) * (1.f / DM) + NORM_EPS);
                GAS u32x2* o8 = (GAS u32x2*)(XN2 + (size_t)m * DM) + lane;
#pragma unroll
                for (int j = 0; j < 8; ++j) { const f32x4 gg = *((const GAS f32x4*)pnf + lane + 64 * j);
                    u32x2 w; w.x = cvtpk(v[j].x * rs * gg.x, v[j].y * rs * gg.y); w.y = cvtpk(v[j].z * rs * gg.z, v[j].w * rs * gg.w); o8[64 * j] = w; }
                if (lane == 0) rs_l[rl] = rs;
            }
            { const int row = lane & 31, kk = lane >> 5;
              const GAS float* hp = (const GAS float*)H1 + (size_t)(rb * 32 + row) * DM + 256 * wave + kk;
              const GAS float* wp = (const GAS float*)pwr + (size_t)(256 * wave + kk) * 32 + row;
              const GAS float* gp = (const GAS float*)pnf + 256 * wave + kk;
              f32x16 acc = {};
#pragma unroll 8
              for (int st = 0; st < 128; ++st) { const float a = hp[2 * st]; const float bb = wp[(size_t)(2 * st) * 32] * gp[2 * st];
                  acc = __builtin_amdgcn_mfma_f32_32x32x2f32(a, bb, acc, 0, 0, 0); }
#pragma unroll
              for (int r = 0; r < 16; ++r) part[(wave * 32 + ((r & 3) + 8 * (r >> 2) + 4 * kk)) * 32 + row] = acc[r];
            }
            __syncthreads();
            for (int idx = tid; idx < 1024; idx += 512) { float sum = 0.f;
#pragma unroll
                for (int w8 = 0; w8 < 8; ++w8) sum += part[w8 * 1024 + idx];
                lg[idx] = sum * rs_l[idx >> 5] + pbr[idx & 31]; }
            __syncthreads();
            if (tid < 32) {
                const int m = rb * 32 + tid; float l[32];
#pragma unroll
                for (int e = 0; e < 32; ++e) l[e] = lg[tid * 32 + e];
                int se[4]; float sv[4];
#pragma unroll
                for (int k = 0; k < 4; ++k) { float best = -__builtin_inff(); int bi = 0;
#pragma unroll
                    for (int e = 0; e < 32; ++e) { const bool tk = l[e] > best; best = tk ? l[e] : best; bi = tk ? e : bi; }
                    se[k] = bi; sv[k] = best;
#pragma unroll
                    for (int e = 0; e < 32; ++e) if (e == bi) l[e] = -__builtin_inff(); }
                const float e1 = fast_exp(sv[1] - sv[0]), e2 = fast_exp(sv[2] - sv[0]), e3 = fast_exp(sv[3] - sv[0]);
                const float inv = 1.f / (1.f + e1 + e2 + e3);
                const float wgt[4] = {inv, e1 * inv, e2 * inv, e3 * inv};
#pragma unroll
                for (int k = 0; k < 4; ++k) {
                    const int pos = (int)__hip_atomic_fetch_add(ctl + CW_CNT + 64 * se[k], 1u, __ATOMIC_RELAXED, __HIP_MEMORY_SCOPE_AGENT);
                    EROWS[se[k] * 8192 + pos] = m; SLOT[m * 4 + k] = (se[k] << 16) | pos; TOKW[m * 4 + k] = wgt[k];
                }
            }
            __syncthreads();
        }
    }
    SEAM(6);
    if (IN(7) || IN(8) || IN(9)) {
        PH_IDS;
        if (tid < 32) cntl[tid] = (int)__hip_atomic_load(ctl + CW_CNT + 64 * tid, __ATOMIC_RELAXED, __HIP_MEMORY_SCOPE_AGENT);
        __syncthreads();
        if (tid == 0) { int a = 0; for (int e = 0; e < 32; ++e) { pre[e] = a; a += (cntl[e] + 255) >> 8; } pre[32] = a; }
        __syncthreads();
    }
    const MoeTab MT{pre, cntl};
    if (IN(7)) { KP kp = kparams(); ProbMoe1 P{ws, kp->w_gate, kp->w_up, kp->b_gate, kp->b_up, MT, G, vcu}; gm::gemm_stream<ProbMoe1>(lds, P); }
    SEAM(7);
    if (IN(8)) { KP kp = kparams(); ProbMoe2 P{ws, kp->w_down, kp->b_down, MT, G, vcu}; gm::gemm_stream<ProbMoe2>(lds, P); }
    SEAM(8);
    if (IN(9)) {
        PH_IDS;
        const float* H1 = (const float*)(ws + WS_H1); const bf16_t* YB = (const bf16_t*)(ws + WS_YB);
        const int* SLOT = (const int*)(ws + WS_SLOT); const float* TOKW = (const float*)(ws + WS_TOKW);
        KP kp = kparams(); const float* pfin = kp->norm_final; float* pout = kp->out;
        const int gw = vcu * 8 + wave, NGW = G * 8;
        for (int m = gw; m < NTOK; m += NGW) {
            const GAS u32x4* yr[4]; float wk[4];
#pragma unroll
            for (int k = 0; k < 4; ++k) { const int sl = SLOT[m * 4 + k]; const int e = sl >> 16, pos = sl & 0xffff; wk[k] = TOKW[m * 4 + k];
                yr[k] = (const GAS u32x4*)(YB + ((size_t)pre[e] * 256 + pos) * 2048) + lane; }
            const GAS f32x4* xr = (const GAS f32x4*)(H1 + (size_t)m * DM) + 2 * lane;
            f32x4 v[4][2]; float s = 0.f;
#pragma unroll
            for (int j = 0; j < 4; ++j) { v[j][0] = xr[128 * j]; v[j][1] = xr[128 * j + 1];
#pragma unroll
                for (int k = 0; k < 4; ++k) { const u32x4 y = yr[k][64 * j];
                    v[j][0].x += wk[k] * bf_lo(y.x); v[j][0].y += wk[k] * bf_hi(y.x); v[j][0].z += wk[k] * bf_lo(y.y); v[j][0].w += wk[k] * bf_hi(y.y);
                    v[j][1].x += wk[k] * bf_lo(y.z); v[j][1].y += wk[k] * bf_hi(y.z); v[j][1].z += wk[k] * bf_lo(y.w); v[j][1].w += wk[k] * bf_hi(y.w); }
#pragma unroll
                for (int h = 0; h < 2; ++h) s += (v[j][h].x * v[j][h].x + v[j][h].y * v[j][h].y) + (v[j][h].z * v[j][h].z + v[j][h].w * v[j][h].w); }
            const float rs = 1.f / sqrtf(wave_sum(s) * (1.f / DM) + NORM_EPS);
            GAS f32x4* orow = (GAS f32x4*)(pout + (size_t)m * DM) + 2 * lane;
#pragma unroll
            for (int j = 0; j < 4; ++j)
#pragma unroll
                for (int h = 0; h < 2; ++h) { const f32x4 gg = *((const GAS f32x4*)pfin + 2 * lane + 128 * j + h);
                    orow[128 * j + h] = (f32x4){v[j][h].x * rs * gg.x, v[j][h].y * rs * gg.y, v[j][h].z * rs * gg.z, v[j][h].w * rs * gg.w}; }
        }
    }
#undef IN
#undef SEAM
}


#if PROBE_REP >= 0
__global__ void __launch_bounds__(512, 2) probe_k(Params p_unused) {
    extern __shared__ __attribute__((aligned(16))) unsigned char lds_raw[];
    LAS unsigned char* lds = (LAS unsigned char*)lds_raw;
    const int G = gridDim.x, bx = blockIdx.x;
    const int vcu = (G % 8 == 0) ? (bx % 8) * (G / 8) + bx / 8 : bx;
    KP kp = kparams(); unsigned char* ws = kp->ws; unsigned* ctl = (unsigned*)(ws + WS_CTL);
    LAS int* pre = (LAS int*)(lds + MISC_OFF + 64);
    LAS int* cntl = (LAS int*)(lds + MISC_OFF + 256);
    { const int tid = threadIdx.x;
      if (tid < 32) cntl[tid] = (int)__hip_atomic_load(ctl + CW_CNT + 64 * tid, __ATOMIC_RELAXED, __HIP_MEMORY_SCOPE_AGENT);
      __syncthreads();
      if (tid == 0) { int a = 0; for (int e = 0; e < 32; ++e) { pre[e] = a; a += (cntl[e] + 255) >> 8; } pre[32] = a; }
      __syncthreads(); }
    const MoeTab MT{pre, cntl};
    if (PROBE_REP == 1) { ProbIn P{ws, kp->w_in, G, bx, lds, kp->conv_w}; gm::gemm_stream<ProbIn, PROBE_ABL>(lds, P); }
    if (PROBE_REP == 7) { ProbMoe1 P{ws, kp->w_gate, kp->w_up, kp->b_gate, kp->b_up, MT, G, vcu}; gm::gemm_stream<ProbMoe1, PROBE_ABL>(lds, P); }
    if (PROBE_REP == 8) { ProbMoe2 P{ws, kp->w_down, kp->b_down, MT, G, vcu}; gm::gemm_stream<ProbMoe2, PROBE_ABL>(lds, P); }
}
#endif

extern "C" void kernel_launch(void* const* d_in, const int* in_sizes, int n_in, void* d_out, int out_size, void* d_ws, size_t ws_size, hipStream_t stream) {
    static int grid = 0;
    if (grid == 0) {
        if (n_in != 17 || in_sizes[0] != NTOK * DM || out_size != NTOK * DM || ws_size < WS_END) {
            fprintf(stderr, "kernel_launch: unexpected shapes (n_in %d, in0 %d, out %d, ws %zu); nothing launched\n", n_in, n_in > 0 ? in_sizes[0] : -1, out_size, ws_size); grid = -1; return; }
        int dev = 0, cus = 0, per_cu = 0;
        if (hipGetDevice(&dev) != hipSuccess || hipDeviceGetAttribute(&cus, hipDeviceAttributeMultiprocessorCount, dev) != hipSuccess) { grid = -1; return; }
        if (hipFuncSetAttribute((const void*)mega, hipFuncAttributeMaxDynamicSharedMemorySize, LDS_BYTES) != hipSuccess) { fprintf(stderr, "kernel_launch: hipFuncSetAttribute failed\n"); grid = -1; return; }
        if (hipOccupancyMaxActiveBlocksPerMultiprocessor(&per_cu, (const void*)mega, 512, LDS_BYTES) != hipSuccess || per_cu < 1) {
            fprintf(stderr, "kernel_launch: occupancy query says %d blocks per CU\n", per_cu); }
        (void)hipGetLastError();
        grid = cus;
    }
    if (grid < 0) return;
    (void)hipMemsetAsync((char*)d_ws + WS_CTL, 0, CTL_BYTES, stream);
    Params p{};
    p.x = (const float*)d_in[0]; p.norm_mix = (const float*)d_in[1]; p.w_in = (const float*)d_in[2]; p.conv_w = (const float*)d_in[3];
    p.w_conv_out = (const float*)d_in[4]; p.w_attn_out = (const float*)d_in[5]; p.w_o = (const float*)d_in[6]; p.norm_ffn = (const float*)d_in[7];
    p.w_router = (const float*)d_in[8]; p.b_router = (const float*)d_in[9]; p.w_gate = (const float*)d_in[10]; p.b_gate = (const float*)d_in[11];
    p.w_up = (const float*)d_in[12]; p.b_up = (const float*)d_in[13]; p.w_down = (const float*)d_in[14]; p.b_down = (const float*)d_in[15];
    p.norm_final = (const float*)d_in[16];
    p.out = (float*)d_out; p.ws = (unsigned char*)d_ws;
#if MK_FUSED
    p.ph_lo = 0; p.ph_hi = N_PHASES;
    hipLaunchKernelGGL(mega, dim3(grid), dim3(512), LDS_BYTES, stream, p);
#if PROBE_REP >= 0
    { static bool once = false; if (!once) { once = true; (void)hipFuncSetAttribute((const void*)probe_k, hipFuncAttributeMaxDynamicSharedMemorySize, LDS_BYTES); }
      hipLaunchKernelGGL(probe_k, dim3(grid), dim3(512), LDS_BYTES, stream, p); }
#endif
#else
    for (int ph = 0; ph < N_PHASES; ++ph) { p.ph_lo = ph; p.ph_hi = ph + 1; hipLaunchKernelGGL(mega, dim3(grid), dim3(512), LDS_BYTES, stream, p); }
#endif
}
```

```cpp
#include <hip/hip_runtime.h>
#include <cstdint>
#include <cstdio>

typedef unsigned short bf16_t;
typedef short bf16x8 __attribute__((ext_vector_type(8)));
typedef short s16x4 __attribute__((ext_vector_type(4)));
typedef float f32x4 __attribute__((ext_vector_type(4)));
typedef float f32x16 __attribute__((ext_vector_type(16)));
typedef unsigned u32x4 __attribute__((ext_vector_type(4)));
typedef unsigned u32x2 __attribute__((ext_vector_type(2)));
typedef float f32x2 __attribute__((ext_vector_type(2)));
#define LAS __attribute__((address_space(3)))
#define GAS __attribute__((address_space(1)))

constexpr int DM = 2048, SEQ = 4096, NTOK = 8192, NHEAD = 16, HDIM = 128, NEXP = 32, INC = 16384;
constexpr float NORM_EPS = 1e-5f;
constexpr int N_PHASES = 10;
#ifndef PROBE_REP
#define PROBE_REP -1
#endif
#ifndef PROBE_ABL
#define PROBE_ABL 0
#endif
#ifndef G_DMAPOS
#define G_DMAPOS 2
#endif
#ifndef G_BT
#define G_BT 1
#endif
#ifndef G_PRIO
#define G_PRIO 1
#endif
#ifndef MK_FUSED
#define MK_FUSED 1
#endif

constexpr size_t MiB = 1u << 20;
constexpr size_t WS_CTL = 0, CTL_BYTES = 1 * MiB;
constexpr size_t WS_ROPE = 1 * MiB;
constexpr size_t WS_KMSUM = 256 * 1024;
constexpr size_t WS_SB = 36 * MiB;
constexpr size_t WS_SLOT = 2 * MiB;
constexpr size_t WS_TOKW = 2 * MiB + 128 * 1024;
constexpr size_t WS_EROWS = 2 * MiB + 256 * 1024;
constexpr size_t WS_XN = 4 * MiB;
constexpr size_t WS_BG = 36 * MiB, WS_CG = 68 * MiB, WS_HC = 100 * MiB, WS_GC = 132 * MiB, WS_GA = 164 * MiB;
constexpr size_t WS_Q = 196 * MiB, WS_K = 228 * MiB, WS_V = 260 * MiB;
constexpr size_t WS_CONV = 292 * MiB, WS_ATT = 324 * MiB, WS_MRG = 356 * MiB;
constexpr size_t WS_H1 = 388 * MiB;
constexpr size_t WS_HID = 452 * MiB;
constexpr size_t WS_YB = 612 * MiB;
constexpr size_t WS_W16IN = 772 * MiB;
constexpr size_t WS_W16C = 836 * MiB, WS_W16A = 844 * MiB, WS_W16O = 852 * MiB;
constexpr size_t WS_END = 860 * MiB;
constexpr int CW_BAR = 4096;
constexpr int CW_CNT = 16384;

constexpr int LDS_MAIN = 131072;
constexpr int MISC_OFF = LDS_MAIN;
constexpr int IDS_OFF = LDS_MAIN + 4096;
constexpr int LDS_BYTES = LDS_MAIN + 4096 + 8192;

__device__ __forceinline__ unsigned cvtpk(float lo, float hi) { unsigned r; asm("v_cvt_pk_bf16_f32 %0, %1, %2" : "=v"(r) : "v"(lo), "v"(hi)); return r; }
__device__ __forceinline__ float bf_lo(unsigned w) { return __uint_as_float(w << 16); }
__device__ __forceinline__ float bf_hi(unsigned w) { return __uint_as_float(w & 0xffff0000u); }
__device__ __forceinline__ float wave_sum(float v) {
#pragma unroll
    for (int o = 1; o < 64; o <<= 1) v += __shfl_xor(v, o);
    return v;
}
__device__ __forceinline__ float fast_exp(float x) { return __builtin_amdgcn_exp2f(x * 1.4426950408889634f); }
__device__ __forceinline__ float sigmoidf_(float x) { return __builtin_amdgcn_rcpf(1.f + fast_exp(-x)); }

#define XB_TMO      128
#define XB_XCNT(j)  (256  + 64 * (j))
#define XB_XSUB(j)  (1280 + 64 * (j))
#define XB_XGEN(j)  (2304 + 64 * (j))
#define XB_TOP      3328
#define XB_TOPGEN   3392
#define XCD_BAR_WORDS 3456
#define XB_SPIN_CAP (1u << 18)
__device__ __forceinline__ unsigned xb_ld(unsigned* p)              { return __hip_atomic_load(p, __ATOMIC_RELAXED, __HIP_MEMORY_SCOPE_AGENT); }
__device__ __forceinline__ unsigned xb_add(unsigned* p, unsigned v) { return __hip_atomic_fetch_add(p, v, __ATOMIC_RELAXED, __HIP_MEMORY_SCOPE_AGENT); }
__device__ __forceinline__ unsigned xb_xcc_id() { return (unsigned)__builtin_amdgcn_s_getreg((3 << 11) | 20) & 0xFu; }
#define XB_SPIN(cond, bar) do { unsigned _sp = 0; while (cond) { __builtin_amdgcn_s_sleep(1); \
    if ((++_sp & 255u) == 0u) { if (xb_ld(&(bar)[XB_TMO])) break; if (_sp > XB_SPIN_CAP) { atomicAdd(&(bar)[XB_TMO], 1u); break; } } } } while (0)
struct XcdBarrier { unsigned* bar; volatile LAS unsigned* st; };
__device__ __forceinline__ XcdBarrier xcd_barrier_post(unsigned* bar, volatile LAS unsigned* st) {
    XcdBarrier b; b.bar = bar; b.st = st;
    if (threadIdx.x == 0) (void)xb_add(&bar[XB_XCNT(xb_xcc_id())], 1u);
    return b;
}
__device__ __forceinline__ void xcd_barrier_complete(unsigned* bar, unsigned x, unsigned& nloc, unsigned& nx) {
    const unsigned G = gridDim.x * gridDim.y * gridDim.z;
    unsigned sum, cnt, mine, sp = 0u;
    for (;;) {
        sum = 0u; cnt = 0u; mine = 0u;
#pragma unroll
        for (unsigned j = 0; j < 16; ++j) { const unsigned c = xb_ld(&bar[XB_XCNT(j)]); sum += c; cnt += (c > 0u) ? 1u : 0u; mine = (j == x) ? c : mine; }
        if (sum == G) break;
        __builtin_amdgcn_s_sleep(1);
        if ((++sp & 255u) == 0u) { if (xb_ld(&bar[XB_TMO])) break; if (sp > XB_SPIN_CAP) { atomicAdd(&bar[XB_TMO], 1u); break; } }
    }
    nloc = mine > 0u ? mine : 1u; nx = cnt > 0u ? cnt : 1u;
}
__device__ __forceinline__ void xcd_barrier(const XcdBarrier& b) {
    asm volatile("s_waitcnt vmcnt(0)" ::: "memory");
    __syncthreads();
    if (threadIdx.x == 0) {
        unsigned* bar = b.bar; const unsigned bx_ = xb_xcc_id();
        __builtin_amdgcn_s_waitcnt(0);
        unsigned nloc = b.st[0], nx = b.st[1];
        if (nloc == 0u) { xcd_barrier_complete(bar, bx_, nloc, nx); b.st[0] = nloc; b.st[1] = nx; }
        const unsigned old = xb_add(&bar[XB_XSUB(bx_)], 1u);
        const unsigned gen = old / nloc;
        if (old + 1u == (gen + 1u) * nloc) {
            __builtin_amdgcn_fence(__ATOMIC_RELEASE, "agent");
            asm volatile("s_waitcnt vmcnt(0)" ::: "memory");
            const unsigned og = xb_add(&bar[XB_TOP], 1u);
            const unsigned tg = og / nx;
            if (og + 1u == (tg + 1u) * nx) xb_add(&bar[XB_TOPGEN], 1u);
            else XB_SPIN(xb_ld(&bar[XB_TOPGEN]) == tg, bar);
            __builtin_amdgcn_fence(__ATOMIC_ACQUIRE, "agent");
            xb_add(&bar[XB_XGEN(bx_)], 1u);
            asm volatile("s_waitcnt vmcnt(0)" ::: "memory");
        } else {
            XB_SPIN(xb_ld(&bar[XB_XGEN(bx_)]) == gen, bar);
            __builtin_amdgcn_fence(__ATOMIC_ACQUIRE, "agent");
            asm volatile("s_waitcnt vmcnt(0)" ::: "memory");
        }
    }
    __syncthreads();
}

namespace gm {
constexpr int HTB = 16384, SB0 = 65536, NT = 32;
__device__ __forceinline__ int lds_byte(int r, int c) { const int st = (r >> 4) * 2 + (c >> 5), rr = r & 15, cc = c & 31, ob = rr * 64 + cc * 2; return st * 1024 + (ob ^ (((ob >> 9) & 1) << 5)); }
__device__ __forceinline__ void stage_rc(int b, int& R, int& C) { const int st = b / 1024, sb = b % 1024, swz = sb ^ (((sb >> 9) & 1) << 5); R = (st >> 1) * 16 + swz / 64; C = (st & 1) * 32 + (swz % 64) / 2; }
__device__ __forceinline__ int inv_perm32(int q) { return 16 * ((q >> 2) & 1) + 4 * (q >> 3) + (q & 3); }
__device__ __forceinline__ int perm32(int rho) { const int n = rho >> 4, i = rho & 15; return 8 * (i >> 2) + 4 * n + (i & 3); }
__device__ __forceinline__ int bswz(int R) { return ((R >> 1) & 7) ^ ((R >> 4) & 1); }

typedef __amdgpu_buffer_rsrc_t rsrc_t;
__device__ __forceinline__ rsrc_t mk_rsrc(const void* base, unsigned bytes) { return __builtin_amdgcn_make_buffer_rsrc((void*)base, 0, bytes, 0x00020000); }

struct Unit {
    unsigned aS;
    unsigned bS0;
    int pm;
    int code;
    __device__ __forceinline__ int pn() const { return code & 255; }
    __device__ __forceinline__ int e() const { return (code >> 8) & 255; }
    __device__ __forceinline__ int aux() const { return (code >> 16) & 255; }
    __device__ __forceinline__ int par() const { return (code >> 25) & 1; }
    __device__ __forceinline__ int keep() const { return (code >> 24) & 1; }
};
__device__ __forceinline__ int mk_code(int pn, int e, int aux, int keep) { return pn | (e << 8) | (aux << 16) | (keep << 24); }

template <class P, int ABL = 0>
__device__ __forceinline__ void gemm_stream(LAS unsigned char* lds, const P& S) {
    const int tid = threadIdx.x, wid = __builtin_amdgcn_readfirstlane(tid >> 6), lane = tid & 63;
    const int wr = wid >> 2, wc = wid & 3, fr = lane & 15, fq = lane >> 4;
    constexpr unsigned LDB4 = (unsigned)P::LDB * 4u;
    constexpr unsigned TSTEP = 64u * LDB4;
    int R0, C0, R1, C1; stage_rc(tid * 16, R0, C0); stage_rc(tid * 16 + 8192, R1, C1);
    const unsigned ldsw = (unsigned)wid * 1024u;
    const int aoff = lds_byte(wr * 64 + fr, fq * 8);
    const int bquad = (lane & 7) + 8 * (lane >> 4), bpar = (lane >> 3) & 1;
    unsigned bw0;
    { const int q = 4 * bquad; const int R = P::PERM ? ((q & ~31) + inv_perm32(q & 31)) : q; bw0 = (unsigned)(SB0 + R * 128 + ((wid ^ bswz(R)) << 4) + bpar * 8); }
    const unsigned brow = (unsigned)(SB0 + (wc * 32 + fr) * 128 + ((fq ^ (fr >> 1)) << 4));
    const unsigned boffs = (unsigned)(8 * wid + 4 * bpar) * LDB4 + (unsigned)bquad * 16u;
    constexpr bool B16 = P::B16;
    constexpr unsigned LDB2 = (unsigned)P::LDB * 2u, TSTEP16 = 64u * LDB2;
    const int boct = (lane & 7) + 8 * (lane >> 4);
    const unsigned boffs16 = (unsigned)(8 * wid + 4 * bpar) * LDB2 + (unsigned)boct * 16u;
    const unsigned bw16 = P::PERM ? (unsigned)(SB0 + 4096 * (boct >> 2) + 512 * (boct & 3) + (((wid ^ (2 * (boct & 3)) ^ ((boct >> 2) & 1)) & 7) << 4) + bpar * 8)
                                  : (unsigned)(SB0 + 1024 * boct + (((wid ^ (4 * (boct & 1)) ^ (2 * ((boct >> 1) & 1)) ^ ((boct >> 2) & 1)) & 7) << 4) + bpar * 8);
    const unsigned brow16 = brow ^ (unsigned)((wc & 1) << 4);
    const rsrc_t rA = S.adesc();
    constexpr bool BT = P::BT;
    const int boffT = lds_byte(wc * 32 + fr, fq * 8);
    const unsigned vb = (unsigned)((P::PERM ? ((R0 & ~31) + perm32(R0 & 31)) : R0) * 4096 + C0 * 2);

#define G_SA(b, h) (((b) * 2 + (h)) * HTB)
#define G_DMA(bufoff, soff, o) do { if (ABL != 3) __builtin_amdgcn_raw_ptr_buffer_load_lds(rA, (LAS void*)(lds + (bufoff) + ldsw), 16, (o), (soff), 0, 0); } while (0)
#define G_VO(h, i) (P::GATHER ? vo[2 * (h) + (i)] : vo[0])
#define G_SO(soff, h, i) (P::GATHER ? (soff) : (soff) + (unsigned)(128 * (h) + 64 * (i)) * (unsigned)P::LDA2)
#define G_DMAP(b, h, i, soff) G_DMA(G_SA(b, h) + 8192 * (i), G_SO(soff, h, i), G_VO(h, i))
#define G_LDA(dst, b, h) do { if (ABL == 4) { _Pragma("unroll") for (int m = 0; m < 4; ++m) _Pragma("unroll") for (int k = 0; k < 2; ++k) asm volatile("" : "+v"(dst[m][k])); break; } _Pragma("unroll") for (int m = 0; m < 4; ++m) _Pragma("unroll") for (int k = 0; k < 2; ++k) dst[m][k] = *(const LAS bf16x8*)(lds + G_SA(b, h) + aoff + m * 2048 + k * 1024); } while (0)
#define G_LDB(dst, b, bj) do { if (ABL == 4) { _Pragma("unroll") for (int n = 0; n < 2; ++n) _Pragma("unroll") for (int k = 0; k < 2; ++k) asm volatile("" : "+v"(dst[n][k])); break; } _Pragma("unroll") for (int n = 0; n < 2; ++n) _Pragma("unroll") for (int k = 0; k < 2; ++k) dst[n][k] = *(const LAS bf16x8*)(lds + ((brow ^ (unsigned)((k << 6) | (n << 4))) + n * 2048 + (bj) * 16384 + (b) * 32768)); } while (0)
#define G_MMA(ai, bj, At, Bt, DMA_STMT) do { if (ABL == 1) { _Pragma("unroll") for (int m = 0; m < 4; ++m) _Pragma("unroll") for (int k = 0; k < 2; ++k) asm volatile("" :: "v"(At[m][k])); _Pragma("unroll") for (int n = 0; n < 2; ++n) _Pragma("unroll") for (int k = 0; k < 2; ++k) asm volatile("" :: "v"(Bt[n][k])); DMA_STMT; break; } \
        if (G_PRIO == 1) __builtin_amdgcn_s_setprio(1); \
        _Pragma("unroll") for (int m = 0; m < 2; ++m) _Pragma("unroll") for (int n = 0; n < 2; ++n) _Pragma("unroll") for (int k = 0; k < 2; ++k) acc[ai][bj][m][n] = __builtin_amdgcn_mfma_f32_16x16x32_bf16(Bt[n][k], At[m][k], acc[ai][bj][m][n], 0, 0, 0); \
        G_SCHED; DMA_STMT; G_SCHED; \
        _Pragma("unroll") for (int m = 2; m < 4; ++m) _Pragma("unroll") for (int n = 0; n < 2; ++n) _Pragma("unroll") for (int k = 0; k < 2; ++k) acc[ai][bj][m][n] = __builtin_amdgcn_mfma_f32_16x16x32_bf16(Bt[n][k], At[m][k], acc[ai][bj][m][n], 0, 0, 0); \
        if (G_PRIO == 1) __builtin_amdgcn_s_setprio(0); } while (0)
#define G_DMAB(bufoff, desc, soff) __builtin_amdgcn_raw_ptr_buffer_load_lds((desc), (LAS void*)(lds + (bufoff) + ldsw), 16, vb, (soff), 0, 0)
#define G_STB(b, bj, desc, so) do { const rsrc_t _d = (desc); const unsigned _s = (so) + (unsigned)(bj) * 524288u; G_DMAB(SB0 + (b) * 32768 + (bj) * 16384, _d, _s); G_DMAB(SB0 + (b) * 32768 + (bj) * 16384 + 8192, _d, _s + 262144u); } while (0)
#define G_STA(b, h, so) do { G_DMAP(b, h, 0, so); G_DMAP(b, h, 1, so); } while (0)
#define G_LDBT(dst, b, bj) do { _Pragma("unroll") for (int n = 0; n < 2; ++n) _Pragma("unroll") for (int k = 0; k < 2; ++k) dst[n][k] = *(const LAS bf16x8*)(lds + SB0 + (b) * 32768 + (bj) * 16384 + boffT + n * 2048 + k * 1024); } while (0)
#define G_WAIT_V0 asm volatile("s_waitcnt vmcnt(0)" ::: "memory")
#define G_WAIT_L0 asm volatile("s_waitcnt lgkmcnt(0)" ::: "memory")
#define G_WAIT_B(first) do { if (first) asm volatile("; first load segment of a unit (peel: its counted wait may leave the epilogue's stores in flight)" ::: "memory"); } while (0)
#define G_BAR __builtin_amdgcn_s_barrier()
#define G_SCHED __builtin_amdgcn_sched_barrier(0)
#define G_BLOAD_R(R, desc, soff) do { const rsrc_t _d = (desc); const unsigned _s = (soff); _Pragma("unroll") for (int i = 0; i < 4; ++i) R[i] = __builtin_amdgcn_raw_buffer_load_b128(_d, boffs, _s + (unsigned)i * LDB4, 0); } while (0)
#define G_BLOAD(desc, soff) do { if (ABL == 2) { asm volatile("" : "+v"(br[0]), "+v"(br[1]), "+v"(br[2]), "+v"(br[3])); break; } const rsrc_t _d = (desc); const unsigned _s = (soff); _Pragma("unroll") for (int i = 0; i < 4; ++i) br[i] = __builtin_amdgcn_raw_buffer_load_b128(_d, boffs, _s + (unsigned)i * LDB4, 0); } while (0)
#define G_LDB16(dst, b, bj) do { _Pragma("unroll") for (int n = 0; n < 2; ++n) _Pragma("unroll") for (int k = 0; k < 2; ++k) dst[n][k] = *(const LAS bf16x8*)(lds + ((brow16 ^ (unsigned)((k << 6) | (n << (P::PERM ? 4 : 5)))) + n * 2048 + (bj) * 16384 + (b) * 32768)); } while (0)
#define G_BLOAD16(desc, soff) do { const rsrc_t _d = (desc); const unsigned _s = (soff); _Pragma("unroll") for (int i = 0; i < 4; ++i) br[i] = __builtin_amdgcn_raw_buffer_load_b128(_d, boffs16, _s + (unsigned)i * LDB2, 0); } while (0)
#define G_BWRITE16(b) do { _Pragma("unroll") for (int c = 0; c < 8; ++c) { const unsigned sel_ = (c & 1) ? 0x07060302u : 0x05040100u; u32x2 w_; \
        w_.x = __builtin_amdgcn_perm(br[1][c >> 1], br[0][c >> 1], sel_); w_.y = __builtin_amdgcn_perm(br[3][c >> 1], br[2][c >> 1], sel_); \
        const unsigned ad_ = P::PERM ? ((bw16 ^ (unsigned)(((((c >> 1) & 1) ^ (c >> 2)) & 1) << 4)) + 2048u * (c >> 2) + 128u * (c & 3)) : ((bw16 ^ (unsigned)((c >> 1) << 4)) + 128u * c); \
        *(LAS u32x2*)(lds + ad_ + (b) * 32768) = w_; } } while (0)
#define G_WAITV(n) asm volatile("s_waitcnt vmcnt(" #n ")" ::: "memory")
#define G_F(x) __uint_as_float(x)
#define G_BWRITE_R(R, b, bj) do { _Pragma("unroll") for (int j = 0; j < 4; ++j) { u32x2 w_; w_.x = cvtpk(G_F(R[0][j]), G_F(R[1][j])); w_.y = cvtpk(G_F(R[2][j]), G_F(R[3][j])); \
        *(LAS u32x2*)(lds + (bw0 ^ (unsigned)((j >> 1) << 4)) + j * 128 + (bj) * 16384 + (b) * 32768) = w_; } } while (0)
#define G_BWRITE(b, bj) do { if (ABL == 5) break; _Pragma("unroll") for (int j = 0; j < 4; ++j) { u32x2 w_; w_.x = cvtpk(G_F(br[0][j]), G_F(br[1][j])); w_.y = cvtpk(G_F(br[2][j]), G_F(br[3][j])); \
        *(LAS u32x2*)(lds + (bw0 ^ (unsigned)((j >> 1) << 4)) + j * 128 + (bj) * 16384 + (b) * 32768) = w_; } } while (0)

    Unit cur, nxt; int ui = 0;
    if (!S.next(0, cur)) return;
    f32x4 acc[2][2][4][2];
    bool zfirst = !P::ACCINIT;
#define G_ZERO(ai) do { if (zc) { _Pragma("unroll") for (int b_ = 0; b_ < 2; ++b_) _Pragma("unroll") for (int m_ = 0; m_ < 4; ++m_) _Pragma("unroll") for (int n_ = 0; n_ < 2; ++n_) acc[ai][b_][m_][n_] = (f32x4){0.f, 0.f, 0.f, 0.f}; } } while (0)
    if constexpr (P::ACCINIT) S.acc_init(acc, cur, wr, wc, fr, fq);
    bf16x8 At[4][2], Bf0[2][2], Bf1[2][2];
    u32x4 br[4];
    unsigned vo[4];
    S.aoff(cur, vo, R0, C0, R1, C1);
    if constexpr (BT) {
    { const rsrc_t rB = S.bdesc(cur.aux(), 0);
      G_STB(0, 0, rB, cur.bS0); G_STB(0, 1, rB, cur.bS0); G_STA(0, 0, cur.aS); G_STA(0, 1, cur.aS);
      G_STB(1, 0, rB, cur.bS0 + 128u); G_STA(1, 0, cur.aS + 128u); G_STB(1, 1, rB, cur.bS0 + 128u); }
    G_WAITV(6); G_BAR;
    if (wr == 1) G_BAR;
    } else if constexpr (B16) {
    G_BLOAD16(S.bdesc(cur.aux(), 0), cur.bS0);
    G_DMAP(0, 0, 0, cur.aS); G_DMAP(0, 0, 1, cur.aS); G_DMAP(0, 1, 0, cur.aS); G_DMAP(0, 1, 1, cur.aS);
    G_WAIT_V0; G_BWRITE16(0); G_SCHED;
    G_BLOAD16(S.bdesc(cur.aux(), 0), cur.bS0 + TSTEP16); G_WAIT_V0; G_BWRITE16(1); G_SCHED;
    G_BLOAD16(S.bdesc(cur.aux(), 0), cur.bS0 + 2u * TSTEP16);
    G_DMAP(1, 0, 0, cur.aS + 128u); G_DMAP(1, 0, 1, cur.aS + 128u);
    G_WAIT_L0; G_BAR;
    if (wr == 1) G_BAR;
    } else {
    { u32x4 pa[4], pb[4], pc[4];
      G_BLOAD_R(pa, S.bdesc(cur.aux(), 0), cur.bS0); G_BLOAD_R(pb, S.bdesc(cur.aux(), 1), cur.bS0 + P::B1OFF); G_BLOAD_R(pc, S.bdesc(cur.aux(), 0), cur.bS0 + TSTEP);
      G_BLOAD(S.bdesc(cur.aux(), 1), cur.bS0 + P::B1OFF + TSTEP);
      G_DMAP(0, 0, 0, cur.aS); G_DMAP(0, 0, 1, cur.aS); G_DMAP(0, 1, 0, cur.aS); G_DMAP(0, 1, 1, cur.aS);
      G_DMAP(1, 0, 0, cur.aS + 128u); G_DMAP(1, 0, 1, cur.aS + 128u);
      G_BWRITE_R(pa, 0, 0); G_BWRITE_R(pb, 0, 1); G_BWRITE_R(pc, 1, 0); }
    asm volatile("s_waitcnt vmcnt(2)" ::: "memory");
    G_WAIT_L0; G_BAR;
    if (wr == 1) G_BAR;
    }
    for (;;) {
        const bool has_next = S.next(ui + 1, nxt);
        if (!has_next) nxt = cur;
        if constexpr (BT) {
        for (int t = 0; t < NT; t += 2) {
            const bool last = (t == NT - 2);
            const bool zc = zfirst && (t == 0);
            const unsigned a1 = cur.aS + (unsigned)(t + 1) * 128u;
            const unsigned a2 = last ? nxt.aS : cur.aS + (unsigned)(t + 2) * 128u;
            const unsigned a3 = a2 + 128u;
            const unsigned b2 = last ? nxt.bS0 : cur.bS0 + (unsigned)(t + 2) * 128u;
            const unsigned b3 = b2 + 128u;
            const int bsl = last ? nxt.aux() : cur.aux();
            G_LDBT(Bf0, 0, 0); G_LDBT(Bf1, 0, 1); G_SCHED; G_LDA(At, 0, 0); G_SCHED; G_STA(1, 1, a1); G_ZERO(0);
            G_WAITV(8); G_WAIT_L0; G_BAR; G_MMA(0, 0, At, Bf0, (void)0); G_MMA(0, 1, At, Bf1, (void)0); G_BAR; G_SCHED;
            G_LDA(At, 0, 1); G_SCHED; G_STB(0, 0, S.bdesc(bsl, 0), b2); G_STB(0, 1, S.bdesc(bsl, 0), b2); G_STA(0, 0, a2); G_ZERO(1);
            G_WAITV(8); G_WAIT_L0; G_BAR; G_MMA(1, 0, At, Bf0, (void)0); G_MMA(1, 1, At, Bf1, (void)0); G_BAR; G_SCHED;
            G_LDBT(Bf0, 1, 0); G_LDBT(Bf1, 1, 1); G_SCHED; G_LDA(At, 1, 0); G_SCHED; G_STA(0, 1, a2);
            G_WAITV(8); G_WAIT_L0; G_BAR; G_MMA(0, 0, At, Bf0, (void)0); G_MMA(0, 1, At, Bf1, (void)0); G_BAR; G_SCHED;
            G_LDA(At, 1, 1); G_SCHED; G_STB(1, 0, S.bdesc(bsl, 0), b3); G_STB(1, 1, S.bdesc(bsl, 0), b3); G_STA(1, 0, a3);
            G_WAITV(8); G_WAIT_L0; G_BAR; G_MMA(1, 0, At, Bf0, (void)0); G_MMA(1, 1, At, Bf1, (void)0); G_BAR; G_SCHED;
        }
        } else if constexpr (B16) {
        for (int t = 0; t < NT; t += 2) {
            const bool last = (t == NT - 2), nx4 = (t + 4 >= NT);
            const bool zc = zfirst && (t == 0);
            const unsigned a1 = cur.aS + (unsigned)(t + 1) * 128u;
            const unsigned a2 = last ? nxt.aS : cur.aS + (unsigned)(t + 2) * 128u;
            const unsigned a3 = a2 + 128u;
            const unsigned b3 = last ? nxt.bS0 + TSTEP16 : cur.bS0 + (unsigned)(t + 3) * TSTEP16;
            const unsigned b4 = nx4 ? nxt.bS0 + (unsigned)(t + 4 - NT) * TSTEP16 : cur.bS0 + (unsigned)(t + 4) * TSTEP16;
            const int sel3 = last ? nxt.aux() : cur.aux(), sel4 = nx4 ? nxt.aux() : cur.aux();
#define G_DL0(b, h, so) do { if (G_DMAPOS >= 1) G_DMAP(b, h, 0, so); } while (0)
#define G_DL1(b, h, so) do { if (G_DMAPOS == 1) G_DMAP(b, h, 1, so); } while (0)
#define G_DM0(b, h, so) do { if (G_DMAPOS == 0) G_DMAP(b, h, 0, so); } while (0)
#define G_DM1(b, h, so) do { if (G_DMAPOS != 1) G_DMAP(b, h, 1, so); } while (0)
            G_WAITV(6); G_LDB16(Bf0, 0, 0); G_LDB16(Bf1, 0, 1); G_SCHED; G_LDA(At, 0, 0); G_SCHED; G_DL0(1, 1, a1); G_DL1(1, 1, a1); G_ZERO(0);
            G_WAIT_L0; G_BAR; G_MMA(0, 0, At, Bf0, G_DM0(1, 1, a1)); G_MMA(0, 1, At, Bf1, G_DM1(1, 1, a1)); G_BAR; G_SCHED;
            G_WAITV(2); G_BWRITE16(0); G_SCHED; G_BLOAD16(S.bdesc(sel3, 0), b3); G_SCHED;
            G_LDA(At, 0, 1); G_SCHED; G_DL0(0, 0, a2); G_DL1(0, 0, a2); G_ZERO(1);
            G_WAIT_L0; G_BAR; G_MMA(1, 0, At, Bf0, G_DM0(0, 0, a2)); G_MMA(1, 1, At, Bf1, G_DM1(0, 0, a2)); G_BAR; G_SCHED;
            G_WAITV(6); G_LDB16(Bf0, 1, 0); G_LDB16(Bf1, 1, 1); G_SCHED; G_LDA(At, 1, 0); G_SCHED; G_DL0(0, 1, a2); G_DL1(0, 1, a2);
            G_WAIT_L0; G_BAR; G_MMA(0, 0, At, Bf0, G_DM0(0, 1, a2)); G_MMA(0, 1, At, Bf1, G_DM1(0, 1, a2)); G_BAR; G_SCHED;
            G_WAITV(2); G_BWRITE16(1); G_SCHED; G_BLOAD16(S.bdesc(sel4, 0), b4); G_SCHED;
            G_LDA(At, 1, 1); G_SCHED; G_DL0(1, 0, a3); G_DL1(1, 0, a3);
            G_WAIT_L0; G_BAR; G_MMA(1, 0, At, Bf0, G_DM0(1, 0, a3)); G_MMA(1, 1, At, Bf1, G_DM1(1, 0, a3)); G_BAR; G_SCHED;
#undef G_DL0
#undef G_DL1
#undef G_DM0
#undef G_DM1
        }
        } else {
        for (int t = 0; t < NT; t += 2) {
            const bool last = (t == NT - 2);
            const bool zc = zfirst && (t == 0);
            const unsigned a1 = cur.aS + (unsigned)(t + 1) * 128u;
            const unsigned a2 = last ? nxt.aS : cur.aS + (unsigned)(t + 2) * 128u;
            const unsigned a3 = a2 + 128u;
            const unsigned b20 = last ? nxt.bS0 : cur.bS0 + (unsigned)(t + 2) * TSTEP;
            const unsigned b21 = b20 + P::B1OFF;
            const int bsl = last ? nxt.aux() : cur.aux();
            G_WAIT_B(t == 0); G_BWRITE(1, 1); G_SCHED; G_BLOAD(S.bdesc(bsl, 0), b20); G_SCHED;
            if constexpr (P::PREF) { if (t == 0) S.prefetch(cur, nxt, lds, wid, lane); }
            G_LDB(Bf0, 0, 0); G_SCHED; G_LDA(At, 0, 0); G_SCHED; G_ZERO(0);
            G_WAIT_L0; G_BAR; G_LDB(Bf1, 0, 1); G_SCHED; G_MMA(0, 0, At, Bf0, G_DMAP(1, 1, 0, a1)); G_MMA(0, 1, At, Bf1, G_DMAP(1, 1, 1, a1)); G_BAR; G_SCHED;
            if constexpr (P::GATHER) { if (last) { int tz = threadIdx.x; asm volatile("" : "+v"(tz)); int r0, c0, r1, c1; stage_rc(tz * 16, r0, c0); stage_rc(tz * 16 + 8192, r1, c1); S.aoff_lds(nxt, vo, lds, tz, r0, c0, r1, c1); } }
            G_WAIT_B(P::GATHER && last); G_BWRITE(0, 0); G_SCHED; G_BLOAD(S.bdesc(bsl, 1), b21); G_SCHED;
            G_LDA(At, 0, 1); G_SCHED; G_ZERO(1);
            G_WAIT_L0; G_BAR; G_MMA(1, 0, At, Bf0, G_DMAP(0, 0, 0, a2)); G_MMA(1, 1, At, Bf1, G_DMAP(0, 0, 1, a2)); G_BAR; G_SCHED;
            G_WAIT_B(false); G_BWRITE(0, 1); G_SCHED; G_BLOAD(S.bdesc(bsl, 0), b20 + TSTEP); G_SCHED;
            G_LDB(Bf0, 1, 0); G_SCHED; G_LDA(At, 1, 0);
            G_WAIT_L0; G_BAR; G_LDB(Bf1, 1, 1); G_SCHED; G_MMA(0, 0, At, Bf0, G_DMAP(0, 1, 0, a2)); G_MMA(0, 1, At, Bf1, G_DMAP(0, 1, 1, a2)); G_BAR; G_SCHED;
            G_WAIT_B(false); G_BWRITE(1, 0); G_SCHED; G_BLOAD(S.bdesc(bsl, 1), b21 + TSTEP); G_SCHED;
            G_LDA(At, 1, 1); G_SCHED;
            G_WAIT_L0; G_BAR; G_MMA(1, 0, At, Bf0, G_DMAP(1, 0, 0, a3)); G_MMA(1, 1, At, Bf1, G_DMAP(1, 0, 1, a3)); G_BAR; G_SCHED;
        }
        }
        if (wr == 0) G_BAR;
        if (ABL == 0) S.epi(acc, cur, wr, wc, fr, fq);
        else {
#pragma unroll
            for (int a = 0; a < 2; ++a)
#pragma unroll
                for (int b = 0; b < 2; ++b)
#pragma unroll
                    for (int m = 0; m < 4; ++m)
#pragma unroll
                        for (int n = 0; n < 2; ++n) asm volatile("" :: "v"(acc[a][b][m][n]));
        }
        zfirst = !P::ACCINIT && !cur.keep();
        if (!has_next) break;
        if constexpr (P::ACCINIT) S.acc_init(acc, nxt, wr, wc, fr, fq);
        cur = nxt;
        ++ui;
        if (wr == 1) G_BAR;
    }
    G_WAIT_V0;
    asm volatile("" :: "v"(br[0]), "v"(br[1]), "v"(br[2]), "v"(br[3]));
    G_BAR;
#undef G_SA
#undef G_STAGE
#undef G_DMA
#undef G_DMAP
#undef G_VO
#undef G_SO
#undef G_WAIT_B
#undef G_LDA
#undef G_LDB
#undef G_MMA
#undef G_ZERO
#undef G_WAIT_V0
#undef G_WAIT_L0
#undef G_BAR
#undef G_SCHED
#undef G_BLOAD
#undef G_BLOAD_R
#undef G_BWRITE_R
#undef G_DMAB
#undef G_STB
#undef G_STA
#undef G_LDBT
#undef G_BLOAD16
#undef G_BWRITE16
#undef G_LDB16
#undef G_WAITV
#undef G_BWRITE
#undef G_F
}

__device__ __forceinline__ bool static_tile(int L, int nM, int nN, int& pm, int& pn) {
    const int nwg = nM * nN; if (L >= nwg) return false;
    int wgid = L; { const int q = nwg / 8, r = nwg % 8, xcd = wgid % 8, off = wgid / 8; wgid = (xcd < r ? xcd * (q + 1) : r * (q + 1) + (xcd - r) * q) + off; }
    const int nig = 8 * nN, gid = wgid / nig, fm = gid * 8, gsz = (nM - fm) < 8 ? (nM - fm) : 8;
    pm = fm + ((wgid % nig) % gsz); pn = (wgid % nig) / gsz; return true;
}
__device__ __forceinline__ void plain_aoff(unsigned (&v)[4], int lda2, int R0, int C0, int R1, int C1) {
    v[0] = (unsigned)(R0 * lda2 + C0 * 2); v[1] = (unsigned)(R1 * lda2 + C1 * 2);
    v[2] = (unsigned)((128 + R0) * lda2 + C0 * 2); v[3] = (unsigned)((128 + R1) * lda2 + C1 * 2);
}
}

__device__ __forceinline__ int in_rowmap(int col) {
    const int g = col >> 11, c = col & 2047;
    if (g == 3 || g == 4 || g == 5 || g == 7) { const int gi = g == 7 ? 3 : g - 3; return (32 + gi * 8 + (c >> 8)) * 256 + (c & 255); }
    const int pn = c >> 6, ch = c & 63, bj = (g == 2 || g == 6) ? 1 : 0, n = (g == 1 || g == 6) ? 1 : 0;
    return pn * 256 + 128 * bj + 32 * (ch >> 4) + 8 * ((ch >> 2) & 3) + 4 * n + (ch & 3);
}
template <bool MAPIN = false>
__device__ __forceinline__ void p0_transpose_item(const float* W, int N, bf16_t* WT, LAS float* scr, int item, int lane) {
    const int nblk = N / 32, kb = item / nblk, nb = item % nblk, k0 = 64 * kb, n0 = 32 * nb;
    const GAS float* Wg = (const GAS float*)W;
#pragma unroll 8
    for (int i = 0; i < 32; ++i) { const int kk = 2 * i + (lane >> 5); scr[kk * 33 + (lane & 31)] = Wg[(size_t)(k0 + kk) * N + n0 + (lane & 31)]; }
    asm volatile("s_waitcnt lgkmcnt(0)" ::: "memory");
    const int c = lane & 7;
#pragma unroll
    for (int j = 0; j < 4; ++j) { const int n = (lane >> 3) + 8 * j; const LAS float* sp = scr + (8 * c) * 33 + n;
        u32x4 o; o.x = cvtpk(sp[0], sp[33]); o.y = cvtpk(sp[66], sp[99]); o.z = cvtpk(sp[132], sp[165]); o.w = cvtpk(sp[198], sp[231]);
        *(GAS u32x4*)(WT + (size_t)(MAPIN ? in_rowmap(n0 + n) : n0 + n) * 2048 + k0 + 8 * c) = o; }
    asm volatile("s_waitcnt lgkmcnt(0)" ::: "memory");
}

struct Params {
    const float* x; const float* norm_mix; const float* w_in; const float* conv_w; const float* w_conv_out; const float* w_attn_out; const float* w_o;
    const float* norm_ffn; const float* w_router; const float* b_router; const float* w_gate; const float* b_gate; const float* w_up; const float* b_up;
    const float* w_down; const float* b_down; const float* norm_final;
    float* out; unsigned char* ws;
    int ph_lo, ph_hi;
};

struct ProbIn {
    static constexpr bool B16 = true; static constexpr int LDA2 = 4096; static constexpr bool PERM = true, GATHER = false; static constexpr int LDB = INC; static constexpr unsigned B1OFF = 512; static constexpr bool BT = (G_BT != 0); static constexpr bool ACCINIT = false; static constexpr bool PREF = false;
    const unsigned char* ws; const float* w_in; int G, c; LAS unsigned char* lds; const float* conv_w;
    __device__ __forceinline__ bool next(int i, gm::Unit& u) const {
        int pm, pn; if (!gm::static_tile(i * G + c, 32, 64, pm, pn)) return false;
        pm = __builtin_amdgcn_readfirstlane(pm); pn = __builtin_amdgcn_readfirstlane(pn);
        if (G == 256 && (i & 1)) pn ^= 32;
        u.aS = (unsigned)(WS_XN + (size_t)pm * MiB); u.bS0 = G_BT ? ((unsigned)pn << 20) : (unsigned)pn * 512u; u.pm = pm; u.code = gm::mk_code(pn, 0, 0, 0); return true;
    }
    __device__ __forceinline__ gm::rsrc_t adesc() const { return gm::mk_rsrc(ws, (unsigned)WS_END); }
    __device__ __forceinline__ gm::rsrc_t bdesc(int, int) const { return gm::mk_rsrc(ws + WS_W16IN, 2048u * 16384u * 2u); }
    __device__ __forceinline__ void aoff(const gm::Unit&, unsigned (&v)[4], int R0, int C0, int R1, int C1) const { gm::plain_aoff(v, 4096, R0, C0, R1, C1); }
    __device__ __forceinline__ void epi(f32x4 (&acc)[2][2][4][2], const gm::Unit& u, int wr, int wc, int fr, int fq) const {
        const int row0 = u.pm * 256 + wr * 64 + fr;
        if (u.pn() < 32) {
            bf16_t* CONV = (bf16_t*)(ws + WS_CONV); bf16_t* GCb = (bf16_t*)(ws + WS_GC); float* SB = (float*)(ws + WS_SB) + (size_t)u.pm * (6 * 2048);
            const int chl = 16 * wc + 4 * fq, ch = 64 * u.pn() + chl;
            LAS float* halo = (LAS float*)(lds + MISC_OFF + 1024);
            const f32x4 w0 = *(const GAS f32x4*)(conv_w + ch), w1 = *(const GAS f32x4*)(conv_w + 2048 + ch), w2 = *(const GAS f32x4*)(conv_w + 4096 + ch);
#pragma unroll
            for (int ai = 0; ai < 2; ++ai) {
                const f32x4 u3 = acc[ai][0][3][1] * acc[ai][1][3][0];
                if (fr >= 14) { *(LAS f32x4*)(halo + ((ai * 2 + wr) * 2 + (fr - 14)) * 64 + chl) = u3;
                    if (ai == 1 && wr == 1) *(GAS f32x4*)(SB + (fr - 14) * 2048 + ch) = u3; }
            }
            asm volatile("s_waitcnt lgkmcnt(0)" ::: "memory");
            __builtin_amdgcn_s_barrier();
#pragma unroll
            for (int ai = 0; ai < 2; ++ai) {
                f32x4 h14 = {0.f, 0.f, 0.f, 0.f}, h15 = h14;
                if (wr == 1 || ai == 1) { const LAS float* hp = halo + ((wr == 1 ? ai * 2 : 1) * 2) * 64 + chl; h14 = *(const LAS f32x4*)hp; h15 = *(const LAS f32x4*)(hp + 64); }
                f32x4 prev = {0.f, 0.f, 0.f, 0.f};
#pragma unroll
                for (int m = 0; m < 4; ++m) {
                    const int row = row0 + ai * 128 + m * 16;
                    const f32x4 bg = acc[ai][0][m][0], uu = acc[ai][0][m][1] * acc[ai][1][m][0], gc = acc[ai][1][m][1];
                    f32x4 u1, u2;
#pragma unroll
                    for (int i = 0; i < 4; ++i) {
                        const float r1 = __int_as_float(__builtin_amdgcn_update_dpp(0, __float_as_int(uu[i]), 0x111, 0xf, 0xf, true));
                        const float r2 = __int_as_float(__builtin_amdgcn_update_dpp(0, __float_as_int(uu[i]), 0x112, 0xf, 0xf, true));
                        float p1, p2;
                        if (m == 0) { p1 = h15[i]; p2 = fr == 0 ? h14[i] : h15[i]; }
                        else { p1 = __int_as_float(__builtin_amdgcn_update_dpp(0, __float_as_int(prev[i]), 0x10f, 0xf, 0xf, true));
                               p2 = __int_as_float(__builtin_amdgcn_update_dpp(0, __float_as_int(prev[i]), 0x10e, 0xf, 0xf, true)); }
                        u1[i] = fr >= 1 ? r1 : p1; u2[i] = fr >= 2 ? r2 : p2;
                    }
                    const f32x4 y = bg * (w0 * u2 + w1 * u1 + w2 * uu);
                    u32x2 o; o.x = cvtpk(y[0], y[1]); o.y = cvtpk(y[2], y[3]);
                    *(GAS u32x2*)(CONV + (size_t)row * 2048 + ch) = o;
                    u32x2 g2; g2.x = cvtpk(gc[0], gc[1]); g2.y = cvtpk(gc[2], gc[3]);
                    *(GAS u32x2*)(GCb + (size_t)row * 2048 + ch) = g2;
                    if (ai == 0 && m == 0 && wr == 0 && fr < 2) { *(GAS f32x4*)(SB + (2 + 2 * fr) * 2048 + ch) = bg; *(GAS f32x4*)(SB + (3 + 2 * fr) * 2048 + ch) = uu; }
                    prev = uu;
                }
            }
            return;
        }
        const int q_ = u.pn() - 32, gi_ = q_ >> 3, grp = gi_ == 3 ? 7 : 3 + gi_, ct = q_ & 7;
        if (grp >= 3 && grp <= 5) {
            bf16_t* buf = (bf16_t*)(ws + (grp == 3 ? WS_Q : (grp == 4 ? WS_K : WS_V)));
            const bool rope = (grp != 5) && (wc == 0);
            const float* COS = (const float*)(ws + WS_ROPE); const float* SIN = COS + 4096 * 16;
            f32x4 ks[2][2] = {{{0.f, 0.f, 0.f, 0.f}, {0.f, 0.f, 0.f, 0.f}}, {{0.f, 0.f, 0.f, 0.f}, {0.f, 0.f, 0.f, 0.f}}};
            if (rope) {
#pragma unroll
                for (int ai = 0; ai < 2; ++ai) {
                    f32x4 cs[4][4];
#pragma unroll
                    for (int m = 0; m < 4; ++m) { const int s = (row0 + ai * 128 + m * 16) & 4095;
                        const GAS f32x4* cp = (const GAS f32x4*)(COS + s * 16 + 8 * (fq & 1)); const GAS f32x4* sp = (const GAS f32x4*)(SIN + s * 16 + 8 * (fq & 1));
                        cs[m][0] = cp[0]; cs[m][1] = cp[1]; cs[m][2] = sp[0]; cs[m][3] = sp[1]; }
                    __builtin_amdgcn_sched_barrier(0);
#pragma unroll
                    for (int m = 0; m < 4; ++m) {
                        const int row = row0 + ai * 128 + m * 16; const int b = row >> 12, s = row & 4095;
                        const f32x4 c0 = cs[m][0], c1 = cs[m][1]; f32x4 s0 = cs[m][2], s1 = cs[m][3]; if (fq < 2) { s0 = -s0; s1 = -s1; }
#pragma unroll
                        for (int bj = 0; bj < 2; ++bj) {
                            f32x4 v0 = acc[ai][bj][m][0], v1 = acc[ai][bj][m][1]; f32x4 p0, p1;
#pragma unroll
                            for (int i = 0; i < 4; ++i) { p0[i] = __shfl_xor(v0[i], 32); p1[i] = __shfl_xor(v1[i], 32); }
                            v0 = v0 * c0 + p0 * s0; v1 = v1 * c1 + p1 * s1;
                            ks[bj][0] += v0; ks[bj][1] += v1;
                            const int head = ct * 2 + bj;
                            u32x4 w; w.x = cvtpk(v0[0], v0[1]); w.y = cvtpk(v0[2], v0[3]); w.z = cvtpk(v1[0], v1[1]); w.w = cvtpk(v1[2], v1[3]);
                            *(GAS u32x4*)(buf + ((size_t)((b * 16 + head) * 4096 + s)) * 128 + wc * 32 + 8 * fq) = w;
                        }
                    }
                }
            } else {
#pragma unroll
                for (int ai = 0; ai < 2; ++ai)
#pragma unroll
                    for (int m = 0; m < 4; ++m) {
                        const int row = row0 + ai * 128 + m * 16; const int b = row >> 12, s = row & 4095;
#pragma unroll
                        for (int bj = 0; bj < 2; ++bj) {
                            const f32x4 v0 = acc[ai][bj][m][0], v1 = acc[ai][bj][m][1];
                            ks[bj][0] += v0; ks[bj][1] += v1;
                            const int head = ct * 2 + bj;
                            u32x4 w; w.x = cvtpk(v0[0], v0[1]); w.y = cvtpk(v0[2], v0[3]); w.z = cvtpk(v1[0], v1[1]); w.w = cvtpk(v1[2], v1[3]);
                            *(GAS u32x4*)(buf + ((size_t)((b * 16 + head) * 4096 + s)) * 128 + wc * 32 + 8 * fq) = w;
                        }
                    }
            }
            if (grp == 4) {
                float* KS = (float*)(ws + WS_KMSUM) + ((size_t)(((u.pm >> 4) * 16 + ct * 2) * 16 + (u.pm & 15))) * 128 + wc * 32 + 8 * fq;
#pragma unroll
                for (int bj = 0; bj < 2; ++bj)
#pragma unroll
                    for (int h = 0; h < 2; ++h)
#pragma unroll
                        for (int i = 0; i < 4; ++i) { float t = ks[bj][h][i];
                            t += __shfl_xor(t, 1); t += __shfl_xor(t, 2); t += __shfl_xor(t, 4); t += __shfl_xor(t, 8);
                            if (fr == 0) (void)__hip_atomic_fetch_add(KS + (size_t)bj * 16 * 128 + 4 * h + i, t, __ATOMIC_RELAXED, __HIP_MEMORY_SCOPE_AGENT); }
            }
        } else {
            const size_t off = WS_GA;
            bf16_t* buf = (bf16_t*)(ws + off);
#pragma unroll
            for (int ai = 0; ai < 2; ++ai)
#pragma unroll
                for (int m = 0; m < 4; ++m) {
                    const int row = row0 + ai * 128 + m * 16;
#pragma unroll
                    for (int bj = 0; bj < 2; ++bj) {
                        const f32x4 v0 = acc[ai][bj][m][0], v1 = acc[ai][bj][m][1];
                        u32x4 w; w.x = cvtpk(v0[0], v0[1]); w.y = cvtpk(v0[2], v0[3]); w.z = cvtpk(v1[0], v1[1]); w.w = cvtpk(v1[2], v1[3]);
                        *(GAS u32x4*)(buf + (size_t)row * 2048 + ct * 256 + bj * 128 + wc * 32 + 8 * fq) = w;
                    }
                }
        }
    }
};

struct ProbMerge {
    static constexpr bool B16 = true; static constexpr int LDA2 = 4096; static constexpr bool PERM = true, GATHER = false; static constexpr int LDB = 2048; static constexpr unsigned B1OFF = 512; static constexpr bool BT = (G_BT != 0); static constexpr bool ACCINIT = false; static constexpr bool PREF = false;
    const unsigned char* ws; const float* wc_out; const float* wa_out; int G, c;
    __device__ __forceinline__ bool next(int i, gm::Unit& u) const {
        int pm, pn; if (!gm::static_tile((i >> 1) * G + c, 32, 8, pm, pn)) return false;
        pm = __builtin_amdgcn_readfirstlane(pm); pn = __builtin_amdgcn_readfirstlane(pn);
        const int seg = i & 1;
        u.aS = (unsigned)((seg ? WS_ATT : WS_CONV) + (size_t)pm * MiB); u.bS0 = G_BT ? ((unsigned)pn << 20) : (unsigned)pn * 512u;
        u.pm = pm; u.code = gm::mk_code(pn, 0, seg, seg ? 0 : 1); return true;
    }
    __device__ __forceinline__ gm::rsrc_t adesc() const { return gm::mk_rsrc(ws, (unsigned)WS_END); }
    __device__ __forceinline__ gm::rsrc_t bdesc(int sel, int) const { return gm::mk_rsrc(ws + (sel ? WS_W16A : WS_W16C), 2048u * 2048u * 2u); }
    __device__ __forceinline__ void aoff(const gm::Unit&, unsigned (&v)[4], int R0, int C0, int R1, int C1) const { gm::plain_aoff(v, 4096, R0, C0, R1, C1); }
    __device__ __forceinline__ void epi(f32x4 (&acc)[2][2][4][2], const gm::Unit& u, int wr, int wc, int fr, int fq) const {
        const bf16_t* GC = (const bf16_t*)(ws + WS_GC); const bf16_t* GA = (const bf16_t*)(ws + WS_GA); bf16_t* MRG = (bf16_t*)(ws + WS_MRG);
        const int row0 = u.pm * 256 + wr * 64 + fr, col0 = u.pn() * 256 + wc * 32 + 8 * fq; const int seg = u.aux();
        if (seg == 0) {
            u32x4 ga[2][4], gc[2][4];
#define MG_LOAD(slot, c_) do { const int ai_ = (c_) >> 1, bj_ = (c_) & 1; _Pragma("unroll") for (int m = 0; m < 4; ++m) { const size_t idx = (size_t)(row0 + ai_ * 128 + m * 16) * 2048 + col0 + bj_ * 128; \
                ga[slot][m] = *(const GAS u32x4*)(GA + idx); gc[slot][m] = *(const GAS u32x4*)(GC + idx); } } while (0)
#define MG_COMP(slot, c_) do { const int ai_ = (c_) >> 1, bj_ = (c_) & 1; _Pragma("unroll") for (int m = 0; m < 4; ++m) { const u32x4 a = ga[slot][m], c = gc[slot][m]; const float NL2E = -1.4426950408889634f; \
                _Pragma("unroll") for (int q = 0; q < 4; ++q) { \
                    const f32x2 fa = {bf_lo(a[q]), bf_hi(a[q])}, fc = {bf_lo(c[q]), bf_hi(c[q])}; \
                    const f32x2 ta = fa * (f32x2){NL2E, NL2E}, tc = fc * (f32x2){NL2E, NL2E}; \
                    const f32x2 da = (f32x2){__builtin_amdgcn_exp2f(ta.x), __builtin_amdgcn_exp2f(ta.y)} + (f32x2){1.f, 1.f}; \
                    const f32x2 dc = (f32x2){__builtin_amdgcn_exp2f(tc.x), __builtin_amdgcn_exp2f(tc.y)} + (f32x2){1.f, 1.f}; \
                    const f32x2 r = da * (f32x2){__builtin_amdgcn_rcpf(dc.x), __builtin_amdgcn_rcpf(dc.y)}; \
                    f32x4& av = acc[ai_][bj_][m][q >> 1]; const int e0 = (q & 1) * 2; \
                    const f32x2 nv = (f32x2){av[e0], av[e0 + 1]} * r; av[e0] = nv.x; av[e0 + 1] = nv.y; } } } while (0)
            MG_LOAD(0, 0); MG_LOAD(1, 1); __builtin_amdgcn_sched_barrier(0);
            MG_COMP(0, 0); __builtin_amdgcn_sched_barrier(0); MG_LOAD(0, 2); __builtin_amdgcn_sched_barrier(0);
            MG_COMP(1, 1); __builtin_amdgcn_sched_barrier(0); MG_LOAD(1, 3); __builtin_amdgcn_sched_barrier(0);
            MG_COMP(0, 2); __builtin_amdgcn_sched_barrier(0);
            MG_COMP(1, 3);
#undef MG_LOAD
#undef MG_COMP
        } else {
            u32x4 ga[2][4][2];
#pragma unroll
            for (int ai = 0; ai < 2; ++ai)
#pragma unroll
                for (int m = 0; m < 4; ++m)
#pragma unroll
                    for (int bj = 0; bj < 2; ++bj) ga[ai][m][bj] = *(const GAS u32x4*)(GA + (size_t)(row0 + ai * 128 + m * 16) * 2048 + col0 + bj * 128);
            __builtin_amdgcn_sched_barrier(0);
#pragma unroll
            for (int ai = 0; ai < 2; ++ai)
#pragma unroll
                for (int m = 0; m < 4; ++m)
#pragma unroll
                    for (int bj = 0; bj < 2; ++bj) {
                        const size_t idx = (size_t)(row0 + ai * 128 + m * 16) * 2048 + col0 + bj * 128;
                        const u32x4 a = ga[ai][m][bj];
                        float o[8];
#pragma unroll
                        for (int q = 0; q < 4; ++q) {
                            const f32x2 fa = {bf_lo(a[q]), bf_hi(a[q])};
                            const f32x2 ta = fa * (f32x2){-1.4426950408889634f, -1.4426950408889634f};
                            const f32x2 da = (f32x2){__builtin_amdgcn_exp2f(ta.x), __builtin_amdgcn_exp2f(ta.y)} + (f32x2){1.f, 1.f};
                            const f32x4 av = acc[ai][bj][m][q >> 1]; const int e0 = (q & 1) * 2;
                            const f32x2 ov = (f32x2){av[e0], av[e0 + 1]} * (f32x2){__builtin_amdgcn_rcpf(da.x), __builtin_amdgcn_rcpf(da.y)};
                            o[2 * q] = ov.x; o[2 * q + 1] = ov.y;
                        }
                        u32x4 w; w.x = cvtpk(o[0], o[1]); w.y = cvtpk(o[2], o[3]); w.z = cvtpk(o[4], o[5]); w.w = cvtpk(o[6], o[7]);
                        *(GAS u32x4*)(MRG + idx) = w;
                    }
        }
    }
};

struct ProbWo {
    static constexpr bool B16 = true; static constexpr int LDA2 = 4096; static constexpr bool PERM = false, GATHER = false; static constexpr int LDB = 2048; static constexpr unsigned B1OFF = 512; static constexpr bool BT = (G_BT != 0); static constexpr bool ACCINIT = true; static constexpr bool PREF = false;
    const unsigned char* ws; const float* w_o; const float* x; int G, c;
    __device__ __forceinline__ bool next(int i, gm::Unit& u) const {
        int pm, pn; if (!gm::static_tile(i * G + c, 32, 8, pm, pn)) return false;
        pm = __builtin_amdgcn_readfirstlane(pm); pn = __builtin_amdgcn_readfirstlane(pn);
        u.aS = (unsigned)(WS_MRG + (size_t)pm * MiB); u.bS0 = G_BT ? ((unsigned)pn << 20) : (unsigned)pn * 512u; u.pm = pm; u.code = gm::mk_code(pn, 0, 0, 0); return true;
    }
    __device__ __forceinline__ gm::rsrc_t adesc() const { return gm::mk_rsrc(ws, (unsigned)WS_END); }
    __device__ __forceinline__ gm::rsrc_t bdesc(int, int) const { return gm::mk_rsrc(ws + WS_W16O, 2048u * 2048u * 2u); }
    __device__ __forceinline__ void aoff(const gm::Unit&, unsigned (&v)[4], int R0, int C0, int R1, int C1) const { gm::plain_aoff(v, 4096, R0, C0, R1, C1); }
    __device__ __forceinline__ void acc_init(f32x4 (&acc)[2][2][4][2], const gm::Unit& u, int wr, int wc, int fr, int fq) const {
        const int row0 = u.pm * 256 + wr * 64 + fr, col0 = u.pn() * 256 + wc * 32 + 4 * fq;
#pragma unroll
        for (int ai = 0; ai < 2; ++ai)
#pragma unroll
            for (int m = 0; m < 4; ++m)
#pragma unroll
                for (int bj = 0; bj < 2; ++bj)
#pragma unroll
                    for (int n = 0; n < 2; ++n)
                        acc[ai][bj][m][n] = *(const GAS f32x4*)(x + (size_t)(row0 + ai * 128 + m * 16) * 2048 + col0 + bj * 128 + n * 16);
    }
    __device__ __forceinline__ void epi(f32x4 (&acc)[2][2][4][2], const gm::Unit& u, int wr, int wc, int fr, int fq) const {
        float* H1 = (float*)(ws + WS_H1);
        const int row0 = u.pm * 256 + wr * 64 + fr, col0 = u.pn() * 256 + wc * 32 + 4 * fq;
#pragma unroll
        for (int ai = 0; ai < 2; ++ai)
#pragma unroll
            for (int m = 0; m < 4; ++m) {
                const int row = row0 + ai * 128 + m * 16;
#pragma unroll
                for (int bj = 0; bj < 2; ++bj)
#pragma unroll
                    for (int n = 0; n < 2; ++n) {
                        const size_t idx = (size_t)row * 2048 + col0 + bj * 128 + n * 16;
                        *(GAS f32x4*)(H1 + idx) = acc[ai][bj][m][n];
                    }
            }
    }
};

struct MoeTab { const LAS int* pre; const LAS int* cnt; };
__device__ __forceinline__ bool moe_decode(const MoeTab& T, int L, int ntn, int& e, int& mt, int& pn) {
    int lz = threadIdx.x; asm volatile("" : "+v"(lz)); lz &= 63;
    const int pv = T.pre[(lz < 32 ? lz : 31) + 1];
    const int tot = __builtin_amdgcn_readlane(pv, 31);
    if (L >= tot * ntn) return false;
    const int ee = (int)__popcll(__ballot(lz < 31 && L >= ntn * pv));
    const int v = L - ntn * T.pre[ee], te = T.pre[ee + 1] - T.pre[ee];
    const int qd = (int)(((float)v + 0.5f) * __builtin_amdgcn_rcpf((float)te));
    e = __builtin_amdgcn_readfirstlane(ee); pn = __builtin_amdgcn_readfirstlane(qd); mt = __builtin_amdgcn_readfirstlane(v - qd * te);
    return true;
}
__device__ __forceinline__ int moe_slot(const MoeTab& T, int i, int G, int vcu, int ntn) {
    if (G != 256) return vcu;
    const int tot = __builtin_amdgcn_readfirstlane(T.pre[32]) * ntn;
    return (i + 1) * G > tot ? (vcu & 31) * 8 + (vcu >> 5) : vcu;
}
struct ProbMoe1 {
    static constexpr bool B16 = false; static constexpr int LDA2 = 4096; static constexpr bool PERM = true, GATHER = true; static constexpr int LDB = 2048; static constexpr unsigned B1OFF = 0; static constexpr bool BT = false; static constexpr bool ACCINIT = false; static constexpr bool PREF = true;
    const unsigned char* ws; const float* w_gate; const float* w_up; const float* b_gate; const float* b_up; MoeTab T; int G, vcu; LAS unsigned char* ldsb;
    __device__ __forceinline__ bool next(int i, gm::Unit& u) const {
        int e, mt, pn; if (!moe_decode(T, i * G + moe_slot(T, i, G, vcu, 16), 16, e, mt, pn)) return false;
        u.aS = (unsigned)WS_XN; u.bS0 = (unsigned)e * (2048u * 2048u * 4u) + (unsigned)pn * 512u;
        u.pm = __builtin_amdgcn_readfirstlane(T.pre[e]) + mt; u.code = gm::mk_code(pn, e, mt, 0) | ((i & 1) << 25); return true;
    }
    __device__ __forceinline__ gm::rsrc_t adesc() const { return gm::mk_rsrc(ws, (unsigned)WS_END); }
    __device__ __forceinline__ gm::rsrc_t bdesc(int, int h) const { return gm::mk_rsrc(h ? w_up : w_gate, 32u * 2048u * 2048u * 4u); }
    __device__ __forceinline__ void aoff(const gm::Unit& u, unsigned (&v)[4], int R0, int C0, int R1, int C1) const {
        const int* er = (const int*)(ws + WS_EROWS) + u.e() * 8192; const int cnt = T.cnt[u.e()]; const int base = u.aux() * 256;
        int i0 = base + R0, i1 = base + R1, i2 = base + 128 + R0, i3 = base + 128 + R1;
        i0 = i0 < cnt ? i0 : cnt - 1; i1 = i1 < cnt ? i1 : cnt - 1; i2 = i2 < cnt ? i2 : cnt - 1; i3 = i3 < cnt ? i3 : cnt - 1;
        const int t0 = __hip_atomic_load(er + i0, __ATOMIC_RELAXED, __HIP_MEMORY_SCOPE_AGENT), t1 = __hip_atomic_load(er + i1, __ATOMIC_RELAXED, __HIP_MEMORY_SCOPE_AGENT);
        const int t2 = __hip_atomic_load(er + i2, __ATOMIC_RELAXED, __HIP_MEMORY_SCOPE_AGENT), t3 = __hip_atomic_load(er + i3, __ATOMIC_RELAXED, __HIP_MEMORY_SCOPE_AGENT);
        v[0] = base + R0 < cnt ? (unsigned)(t0 * 4096 + C0 * 2) : 0xFFFFF000u; v[1] = base + R1 < cnt ? (unsigned)(t1 * 4096 + C1 * 2) : 0xFFFFF000u;
        v[2] = base + 128 + R0 < cnt ? (unsigned)(t2 * 4096 + C0 * 2) : 0xFFFFF000u; v[3] = base + 128 + R1 < cnt ? (unsigned)(t3 * 4096 + C1 * 2) : 0xFFFFF000u;
    }
    __device__ __forceinline__ void aoff_lds(const gm::Unit& nx, unsigned (&v)[4], LAS unsigned char* lds, int tz, int R0, int C0, int R1, int C1) const {
        const LAS int* ip = (const LAS int*)(lds + IDS_OFF) + tz;
        const int t0 = ip[0], t1 = ip[512], t2 = ip[1024], t3 = ip[1536];
        const int cnt = T.cnt[nx.e()], base = nx.aux() * 256;
        v[0] = base + R0 < cnt ? (unsigned)(t0 * 4096 + C0 * 2) : 0xFFFFF000u; v[1] = base + R1 < cnt ? (unsigned)(t1 * 4096 + C1 * 2) : 0xFFFFF000u;
        v[2] = base + 128 + R0 < cnt ? (unsigned)(t2 * 4096 + C0 * 2) : 0xFFFFF000u; v[3] = base + 128 + R1 < cnt ? (unsigned)(t3 * 4096 + C1 * 2) : 0xFFFFF000u;
    }
    __device__ __forceinline__ void prefetch(const gm::Unit& u, const gm::Unit& nx, LAS unsigned char* lds, int wid, int lane) const {
        { int tz = threadIdx.x; asm volatile("" : "+v"(tz)); int R0, C0, R1, C1; gm::stage_rc(tz * 16, R0, C0); gm::stage_rc(tz * 16 + 8192, R1, C1);
          const int cnt = T.cnt[nx.e()]; const int base = nx.aux() * 256;
          int ix[4] = {base + R0, base + R1, base + 128 + R0, base + 128 + R1};
          const gm::rsrc_t re = gm::mk_rsrc(ws + WS_EROWS, 32u * 8192u * 4u);
#pragma unroll
          for (int k = 0; k < 4; ++k) { const int ii = ix[k] < cnt ? ix[k] : cnt - 1;
              __builtin_amdgcn_raw_ptr_buffer_load_lds(re, (LAS void*)(lds + IDS_OFF + k * 2048 + wid * 256), 4, (unsigned)(nx.e() * 8192 + ii) * 4u, 0u, 0, 0); } }
        if (wid < 2 && lane < 32) {
            const gm::rsrc_t r = gm::mk_rsrc(wid ? b_up : b_gate, 32u * 2048u * 4u);
            __builtin_amdgcn_raw_ptr_buffer_load_lds(r, (LAS void*)(lds + MISC_OFF + 1024 + u.par() * 1024 + wid * 512), 16, (unsigned)lane * 16u, (unsigned)(u.e() * 2048 + u.pn() * 128) * 4u, 0, 0);
        }
    }
    __device__ __forceinline__ void epi(f32x4 (&acc)[2][2][4][2], const gm::Unit& u, int wr, int wc, int fr, int fq) const {
        bf16_t* HID = (bf16_t*)(ws + WS_HID);
        const int row0 = u.pm * 256 + wr * 64 + fr, col0 = u.pn() * 128 + wc * 32 + 8 * fq;
        const LAS float* bl = (const LAS float*)(ldsb + MISC_OFF + 1024 + u.par() * 1024) + wc * 32 + 8 * fq;
        const f32x4 bg0 = *(const LAS f32x4*)bl, bg1 = *(const LAS f32x4*)(bl + 4), bu0 = *(const LAS f32x4*)(bl + 128), bu1 = *(const LAS f32x4*)(bl + 132);
        const int valid = T.cnt[u.e()] - u.aux() * 256;
#pragma unroll
        for (int ai = 0; ai < 2; ++ai)
#pragma unroll
            for (int m = 0; m < 4; ++m) {
                const int g0 = ai * 128 + wr * 64 + m * 16; if (g0 >= valid) continue;
                const int row = row0 + ai * 128 + m * 16;
                float o[8];
#pragma unroll
                for (int q = 0; q < 4; ++q) {
                    const int h = q >> 1, e0 = (q & 1) * 2;
                    const f32x4 ag = acc[ai][0][m][h], au = acc[ai][1][m][h], vbg = h ? bg1 : bg0, vbu = h ? bu1 : bu0;
                    f32x2 g = (f32x2){ag[e0], ag[e0 + 1]} + (f32x2){vbg[e0], vbg[e0 + 1]};
                    f32x2 uu = (f32x2){au[e0], au[e0 + 1]} + (f32x2){vbu[e0], vbu[e0 + 1]};
                    g.x = fminf(g.x, 7.f); g.y = fminf(g.y, 7.f);
                    uu.x = fminf(fmaxf(uu.x, -7.f), 7.f); uu.y = fminf(fmaxf(uu.y, -7.f), 7.f);
                    const f32x2 t = g * (f32x2){-1.702f * 1.4426950408889634f, -1.702f * 1.4426950408889634f};
                    f32x2 d = (f32x2){__builtin_amdgcn_exp2f(t.x), __builtin_amdgcn_exp2f(t.y)} + (f32x2){1.f, 1.f};
                    const f32x2 r = {__builtin_amdgcn_rcpf(d.x), __builtin_amdgcn_rcpf(d.y)};
                    const f32x2 ov = (uu + (f32x2){1.f, 1.f}) * (g * r);
                    o[2 * q] = ov.x; o[2 * q + 1] = ov.y;
                }
                u32x4 w; w.x = cvtpk(o[0], o[1]); w.y = cvtpk(o[2], o[3]); w.z = cvtpk(o[4], o[5]); w.w = cvtpk(o[6], o[7]);
                if (g0 + fr < valid) *(GAS u32x4*)(HID + (size_t)row * 2048 + col0) = w;
            }
    }
};
struct ProbMoe2 {
    static constexpr bool B16 = false; static constexpr int LDA2 = 4096; static constexpr bool PERM = true, GATHER = true; static constexpr int LDB = 2048; static constexpr unsigned B1OFF = 512; static constexpr bool BT = false; static constexpr bool ACCINIT = false; static constexpr bool PREF = true;
    const unsigned char* ws; const float* w_down; const float* b_down; MoeTab T; int G, vcu; LAS unsigned char* ldsb;
    __device__ __forceinline__ bool next(int i, gm::Unit& u) const {
        int e, mt, pn; if (!moe_decode(T, i * G + moe_slot(T, i, G, vcu, 8), 8, e, mt, pn)) return false;
        const int pm = __builtin_amdgcn_readfirstlane(T.pre[e]) + mt;
        u.aS = (unsigned)(WS_HID + (size_t)pm * MiB); u.bS0 = (unsigned)e * (2048u * 2048u * 4u) + (unsigned)pn * 1024u;
        u.pm = pm; u.code = gm::mk_code(pn, e, mt, 0) | ((i & 1) << 25); return true;
    }
    __device__ __forceinline__ gm::rsrc_t adesc() const { return gm::mk_rsrc(ws, (unsigned)WS_END); }
    __device__ __forceinline__ gm::rsrc_t bdesc(int, int) const { return gm::mk_rsrc(w_down, 32u * 2048u * 2048u * 4u); }
    __device__ __forceinline__ void aoff(const gm::Unit& u, unsigned (&v)[4], int R0, int C0, int R1, int C1) const {
        const int valid = T.cnt[u.e()] - u.aux() * 256;
        v[0] = R0 < valid ? (unsigned)(R0 * 4096 + C0 * 2) : 0xFFFFF000u; v[1] = R1 < valid ? (unsigned)(R1 * 4096 + C1 * 2) : 0xFFFFF000u;
        v[2] = 128 + R0 < valid ? (unsigned)((128 + R0) * 4096 + C0 * 2) : 0xFFFFF000u; v[3] = 128 + R1 < valid ? (unsigned)((128 + R1) * 4096 + C1 * 2) : 0xFFFFF000u;
    }
    __device__ __forceinline__ void aoff_lds(const gm::Unit& nx, unsigned (&v)[4], LAS unsigned char*, int, int R0, int C0, int R1, int C1) const { aoff(nx, v, R0, C0, R1, C1); }
    __device__ __forceinline__ void prefetch(const gm::Unit& u, const gm::Unit&, LAS unsigned char* lds, int wid, int lane) const {
        if (wid == 0) {
            const gm::rsrc_t r = gm::mk_rsrc(b_down, 32u * 2048u * 4u);
            __builtin_amdgcn_raw_ptr_buffer_load_lds(r, (LAS void*)(lds + MISC_OFF + 1024 + u.par() * 1024), 16, (unsigned)lane * 16u, (unsigned)(u.e() * 2048 + u.pn() * 256) * 4u, 0, 0);
        }
    }
    __device__ __forceinline__ void epi(f32x4 (&acc)[2][2][4][2], const gm::Unit& u, int wr, int wc, int fr, int fq) const {
        bf16_t* YB = (bf16_t*)(ws + WS_YB);
        const int row0 = u.pm * 256 + wr * 64 + fr, col0 = u.pn() * 256 + wc * 32 + 8 * fq;
        const int valid = T.cnt[u.e()] - u.aux() * 256;
#pragma unroll
        for (int bj = 0; bj < 2; ++bj) {
            const LAS float* bl = (const LAS float*)(ldsb + MISC_OFF + 1024 + u.par() * 1024) + bj * 128 + wc * 32 + 8 * fq;
            const f32x4 b0 = *(const LAS f32x4*)bl, b1 = *(const LAS f32x4*)(bl + 4);
#pragma unroll
            for (int ai = 0; ai < 2; ++ai)
#pragma unroll
                for (int m = 0; m < 4; ++m) {
                    const int g0 = ai * 128 + wr * 64 + m * 16; if (g0 >= valid) continue;
                    const int row = row0 + ai * 128 + m * 16;
                    const f32x4 v0 = acc[ai][bj][m][0] + b0, v1 = acc[ai][bj][m][1] + b1;
                    u32x4 w; w.x = cvtpk(v0[0], v0[1]); w.y = cvtpk(v0[2], v0[3]); w.z = cvtpk(v1[0], v1[1]); w.w = cvtpk(v1[2], v1[3]);
                    if (g0 + fr < valid) *(GAS u32x4*)(YB + (size_t)row * 2048 + col0 + bj * 128) = w;
                }
        }
    }
};

namespace at {
constexpr int D = 128, NW = 8, QBLK = 32, KVBLK = 64, QB = 256, OSTR = 2048;
constexpr int SHM_V = KVBLK * D * 2, SHM_K = KVBLK * D * 2;
constexpr int GATE_OFF = 2 * SHM_V + 2 * SHM_K + NW * 64 * 4;
constexpr float SCALE = 0.08838834764831845f, THR = 8.f;
constexpr int WBIG = 1 << 30;
#define KSWZ(row, colB) ((row) * 256 + ((colB) ^ (((row) & 7) << 4)))
#define SBAR() __builtin_amdgcn_sched_barrier(0)
__device__ __forceinline__ int v_st(int k, int c) { const int kk = (k & ~0xC) | ((k & 4) << 1) | ((k & 8) >> 1); return ((kk >> 3) * 4 + (c >> 5)) * 512 + ((kk & 7) * 32 + (c & 31)) * 2; }
__device__ __forceinline__ int v_rd_base(int lane) { return ((lane & 3) << 3) | (((lane >> 2) & 3) << 6) | (((lane >> 4) & 1) << 5) | (((lane >> 5) & 1) << 8); }
constexpr int v_rd_off(int d0, int ks, int half) { return d0 * 512 + ks * 4096 + half * 2048; }
__device__ __forceinline__ int crow(int r, int hi) { return (r & 3) + 8 * (r >> 2) + 4 * hi; }
__device__ __forceinline__ unsigned cvtpkv(float lo, float hi) { unsigned r; asm volatile("v_cvt_pk_bf16_f32 %0, %1, %2" : "=v"(r) : "v"(lo), "v"(hi)); return r; }
__device__ __forceinline__ bf16x8 load8(const bf16_t* p) { return *reinterpret_cast<const bf16x8*>(p); }
__device__ __forceinline__ void mask_tile(f32x16& p0, f32x16& p1, int dq, unsigned W) {
    const float NEG = -__builtin_inff();
#pragma unroll
    for (int r = 0; r < 16; ++r) {
        const int c = (r & 3) + 8 * (r >> 2);
        if ((unsigned)(dq - c) >= W) p0[r] = NEG;
        if ((unsigned)(dq - c - 32) >= W) p1[r] = NEG;
    }
}
__device__ __forceinline__ void partialSM(f32x16& p0, f32x16& p1, float& m_reg, float& mn, float& alpha, bool rowsel) {
    float pmax = p0[0]; for (int r = 1; r < 16; ++r) pmax = fmaxf(pmax, p0[r]); for (int r = 0; r < 16; ++r) pmax = fmaxf(pmax, p1[r]);
    { auto rr = __builtin_amdgcn_permlane32_swap(__float_as_uint(pmax), __float_as_uint(pmax), false, false);
      pmax = fmaxf(__uint_as_float(rr[0]), __uint_as_float(rr[1])); }
    if (!rowsel) pmax = -__builtin_inff();
    constexpr float C2 = 1.4426950408889634f * SCALE;
    if (__builtin_expect(__all((pmax - m_reg) * SCALE <= THR), 1)) { mn = m_reg; alpha = 1.f; }
    else { mn = fmaxf(m_reg, pmax); alpha = __builtin_amdgcn_exp2f((m_reg - mn) * C2); m_reg = mn; }
    const float mnL = rowsel ? -mn * C2 : -__builtin_inff();
    for (int r = 0; r < 16; ++r) p0[r] = fmaf(p0[r], C2, mnL); for (int r = 0; r < 16; ++r) p1[r] = fmaf(p1[r], C2, mnL);
    for (int r = 0; r < 16; ++r) p0[r] = __builtin_amdgcn_exp2f(p0[r]);
}
__device__ __forceinline__ void finishSM(f32x16& p0, f32x16& p1, float alpha, float& l_reg, bf16x8& pa0, bf16x8& pa1, bf16x8& pa2, bf16x8& pa3) {
    for (int r = 0; r < 16; ++r) p1[r] = __builtin_amdgcn_exp2f(p1[r]);
    float ps = 0; for (int r = 0; r < 16; ++r) ps += p0[r]; for (int r = 0; r < 16; ++r) ps += p1[r];
    { auto rr = __builtin_amdgcn_permlane32_swap(__float_as_uint(ps), __float_as_uint(ps), false, false);
      ps = __uint_as_float(rr[0]) + __uint_as_float(rr[1]); }
    l_reg = l_reg * alpha + ps;
#define PK4(P, B_, OUT) do { unsigned a0 = cvtpkv(P[B_+0], P[B_+1]), a1 = cvtpkv(P[B_+2], P[B_+3]);                          \
        unsigned b0 = cvtpkv(P[B_+4], P[B_+5]), b1 = cvtpkv(P[B_+6], P[B_+7]);                                             \
        auto r0 = __builtin_amdgcn_permlane32_swap(a0, b0, false, false); auto r1 = __builtin_amdgcn_permlane32_swap(a1, b1, false, false); \
        u32x4 w = {r0[0], r1[0], r0[1], r1[1]}; OUT = *reinterpret_cast<bf16x8*>(&w); } while (0)
    PK4(p0, 0, pa0); PK4(p0, 8, pa1); PK4(p1, 0, pa2); PK4(p1, 8, pa3);
#undef PK4
}
template <int KB>
__device__ __forceinline__ void qkt(f32x16& p0, f32x16& p1, const char* K_lds, int r32, int hi, const bf16x8* qr) {
    p0 = f32x16{}; p1 = f32x16{};
    const char* kb[4];
#pragma unroll
    for (int dd = 0; dd < 4; ++dd) kb[dd] = K_lds + KB * SHM_K + KSWZ(r32, (dd * 16 + hi * 8) * 2);
#pragma unroll
    for (int d0 = 0; d0 < 8; ++d0) { const char* a = kb[d0 & 3] + (d0 >> 2) * 128;
        bf16x8 b0 = *reinterpret_cast<const bf16x8*>(a);
        bf16x8 b1 = *reinterpret_cast<const bf16x8*>(a + 32 * 256);
        p0 = __builtin_amdgcn_mfma_f32_32x32x16_bf16(b0, qr[d0], p0, 0, 0, 0);
        p1 = __builtin_amdgcn_mfma_f32_32x32x16_bf16(b1, qr[d0], p1, 0, 0, 0); }
}
__device__ __forceinline__ void gate_scores(f32x16& g, const char* G_lds, int r32, int hi, const bf16x8* qr) {
    g = f32x16{};
#pragma unroll
    for (int d0 = 0; d0 < 8; ++d0) { const char* a = G_lds + KSWZ(r32, ((d0 & 3) * 16 + hi * 8) * 2) + (d0 >> 2) * 128;
        bf16x8 b0 = *reinterpret_cast<const bf16x8*>(a);
        g = __builtin_amdgcn_mfma_f32_32x32x16_bf16(b0, qr[d0], g, 0, 0, 0); }
}
template <int VB>
__device__ __forceinline__ void pv_tile(f32x16* o, int vb0, bf16x8 pa0, bf16x8 pa1, bf16x8 pa2, bf16x8 pa3) {
#define TRRD(dst, off) asm volatile("ds_read_b64_tr_b16 %0, %1 offset:%2" : "=&v"(dst) : "v"(vb0), "i"(off) : "memory")
#define PV_D0(d0) do { s16x4 l0, l1, l2, l3, h0, h1, h2, h3; constexpr int b_ = VB * SHM_V + v_rd_off(d0, 0, 0); \
        TRRD(l0, b_); TRRD(h0, b_ + 2048); TRRD(l1, b_ + 4096); TRRD(h1, b_ + 6144); TRRD(l2, b_ + 8192); TRRD(h2, b_ + 10240); TRRD(l3, b_ + 12288); TRRD(h3, b_ + 14336); \
        asm volatile("s_waitcnt lgkmcnt(0)" ::: "memory"); SBAR();   \
        o[d0] = __builtin_amdgcn_mfma_f32_32x32x16_bf16(pa0, (bf16x8){l0[0], l0[1], l0[2], l0[3], h0[0], h0[1], h0[2], h0[3]}, o[d0], 0, 0, 0);   \
        o[d0] = __builtin_amdgcn_mfma_f32_32x32x16_bf16(pa1, (bf16x8){l1[0], l1[1], l1[2], l1[3], h1[0], h1[1], h1[2], h1[3]}, o[d0], 0, 0, 0);   \
        o[d0] = __builtin_amdgcn_mfma_f32_32x32x16_bf16(pa2, (bf16x8){l2[0], l2[1], l2[2], l2[3], h2[0], h2[1], h2[2], h2[3]}, o[d0], 0, 0, 0);   \
        o[d0] = __builtin_amdgcn_mfma_f32_32x32x16_bf16(pa3, (bf16x8){l3[0], l3[1], l3[2], l3[3], h3[0], h3[1], h3[2], h3[3]}, o[d0], 0, 0, 0); } while (0)
    PV_D0(0); PV_D0(1); PV_D0(2); PV_D0(3);
#undef PV_D0
#undef TRRD
}

struct BlockRef { unsigned q, k, v, o, km; int P0; };
struct Seam { bf16x8 qr[8]; bf16x8 st_v0, st_v1, st_k0, st_k1; };
typedef __amdgpu_buffer_rsrc_t rs_t;
__device__ __forceinline__ bf16x8 bl8(rs_t rs, unsigned voff, unsigned soff) { u32x4 t = __builtin_amdgcn_raw_buffer_load_b128(rs, voff, soff, 0); return *reinterpret_cast<bf16x8*>(&t); }
#define VMW() asm volatile("s_waitcnt vmcnt(0)" ::: "memory")
#define VMWN(n) asm volatile("s_waitcnt vmcnt(%0)" :: "i"(n) : "memory")
#define SLOAD_H(Ko, Vo, k0) do { const unsigned kb__ = (unsigned)(k0) * 256u; S.st_v0 = bl8(rs, kvo, (Vo) + kb__); S.st_v1 = bl8(rs, kvo, (Vo) + kb__ + 8192u);              \
                         S.st_k0 = bl8(rs, kvo, (Ko) + kb__); S.st_k1 = bl8(rs, kvo, (Ko) + kb__ + 8192u); } while (0)
#define SWRITE_HK(bf) do { *(bf16x8*)(K_lds + (bf) * SHM_K + kws) = S.st_k0; *(bf16x8*)(K_lds + (bf) * SHM_K + kws + 32 * 256) = S.st_k1; } while (0)
#define SWRITE_HV(bf) do { *(bf16x8*)(V_lds + (bf) * SHM_V + vst0) = S.st_v0; *(bf16x8*)(V_lds + (bf) * SHM_V + vst1) = S.st_v1; } while (0)
#define SWRITE_H(bf) do { SWRITE_HV(bf); SWRITE_HK(bf); } while (0)
#define QLOAD(qo) do { _Pragma("unroll") for (int d0 = 0; d0 < 8; ++d0) S.qr[d0] = bl8(rs, qvo + d0 * 32, (qo)); } while (0)
__device__ __forceinline__ void moba_prime(const BlockRef& cur, rs_t rs, char* lds, Seam& S) {
    const int tid = threadIdx.x, wid = __builtin_amdgcn_readfirstlane(tid >> 6), lane = tid & 63, r32 = lane & 31, hi = lane >> 5;
    const int sr = tid >> 4, sc = (tid & 15) * 8, kws = KSWZ(sr, sc * 2); char* K_lds = lds + 2 * SHM_V;
    const unsigned kvo = (unsigned)(sr * 128 + sc) * 2u, qvo = (unsigned)((wid * QBLK + r32) * 128 + hi * 8) * 2u;
    QLOAD(cur.q);
    SLOAD_H(cur.k, cur.v, 0);
}
__device__ __forceinline__ void moba_prime_finish(rs_t rs, char* lds, Seam& S) {
    const int tid = threadIdx.x; const int sr = tid >> 4, sc = (tid & 15) * 8, kws = KSWZ(sr, sc * 2); char* K_lds = lds + 2 * SHM_V;
    VMW(); SWRITE_HK(0);
    __syncthreads();
}
__device__ __forceinline__ void moba_block(const BlockRef& cur, const BlockRef& nxt, rs_t rs, char* lds, Seam& S) {
    const int tid = threadIdx.x, wid = __builtin_amdgcn_readfirstlane(tid >> 6), lane = tid & 63, r32 = lane & 31, hi = lane >> 5;
    const int own = cur.P0 >> 8;
    const int NT = 4 * own + 4;
    const int qlo = cur.P0 + wid * QBLK, qm = qlo + r32 - 4 * hi;
    char* V_lds = lds; char* K_lds = lds + 2 * SHM_V; char* G_lds = lds + GATE_OFF;
    float* ws = (float*)(lds + 2 * SHM_V + 2 * SHM_K) + wid * 64; float* li_l = ws, * al_l = ws + 32;
    const int sr = tid >> 4, sc = (tid & 15) * 8, vst0 = v_st(sr, sc), vst1 = v_st(32 + sr, sc), kws = KSWZ(sr, sc * 2);
    const unsigned kvo = (unsigned)(sr * 128 + sc) * 2u, qvo = (unsigned)((wid * QBLK + r32) * 128 + hi * 8) * 2u;
    { bf16x8 z = {0, 0, 0, 0, 0, 0, 0, 0};
      if (tid < 256) { const u32x4 s0 = __builtin_amdgcn_raw_buffer_load_b128(rs, 2u * kvo, cur.km, 0), s1 = __builtin_amdgcn_raw_buffer_load_b128(rs, 2u * kvo + 16u, cur.km, 0);
          const float q = 1.f / 256.f; u32x4 w;
          w.x = cvtpkv(__uint_as_float(s0.x) * q, __uint_as_float(s0.y) * q); w.y = cvtpkv(__uint_as_float(s0.z) * q, __uint_as_float(s0.w) * q);
          w.z = cvtpkv(__uint_as_float(s1.x) * q, __uint_as_float(s1.y) * q); w.w = cvtpkv(__uint_as_float(s1.z) * q, __uint_as_float(s1.w) * q); z = *reinterpret_cast<bf16x8*>(&w); }
      *(bf16x8*)(G_lds + KSWZ(sr, sc * 2)) = z; }
    __syncthreads();
    unsigned selmask = 0;
    { f32x16 g; gate_scores(g, G_lds, r32, hi, S.qr);
      float s[16];
#pragma unroll
      for (int r = 0; r < 8; ++r) { const float mine = g[r], oth = __shfl_xor(mine, 32);
          const float lo = hi ? oth : mine, hv = hi ? mine : oth;
          s[(r & 3) + 8 * (r >> 2)] = lo; s[(r & 3) + 8 * (r >> 2) + 4] = hv; }
      const float NEGI = -__builtin_inff();
#pragma unroll
      for (int j = 0; j < 16; ++j) if (j >= own) s[j] = NEGI;
#pragma unroll
      for (int k = 0; k < 3; ++k) { float best = NEGI; int bi = -1;
#pragma unroll
          for (int j = 0; j < 16; ++j) { const bool tk = s[j] > best; best = tk ? s[j] : best; bi = tk ? j : bi; }
          if (bi >= 0) { selmask |= 1u << bi;
#pragma unroll
              for (int j = 0; j < 16; ++j) if (j == bi) s[j] = NEGI; } }
    }
    float m_reg = -1e30f, l_reg = 0; f32x16 o[4] = {};
    const int vb0 = (int)(uintptr_t)V_lds + v_rd_base(lane);
    const unsigned Kh = cur.k, Vh = cur.v;
#define RESC(a) do { if (__any((a) < 1.f)) { if (hi == 0) al_l[r32] = (a); asm volatile("s_waitcnt lgkmcnt(0)" ::: "memory");              \
                     for (int d_ = 0; d_ < 4; ++d_) for (int r = 0; r < 16; ++r) o[d_][r] *= al_l[crow(r, hi)]; } } while (0)
#define KBASE(t) ((t) * KVBLK)
#define ROWSEL(t) ((((t) >> 2) >= own) || ((selmask >> ((t) >> 2)) & 1u))
#define MASKT(P0_, P1_, t) do { const int kb_ = KBASE(t); if (kb_ + KVBLK - 1 > qlo) mask_tile(P0_, P1_, qm - kb_, (unsigned)WBIG); } while (0)
    constexpr int NQL = 8;
#define SEAM_K0() do { VMWN(NQL); SWRITE_HK(0); SBAR(); } while (0)
    f32x16 pA0, pA1, pB0, pB1; float mnA, mnB, alA, alB; bf16x8 pa0, pa1, pa2, pa3;
    SWRITE_HV(0); SBAR();
    if (NT > 1) { SLOAD_H(Kh, Vh, KBASE(1)); }
    SBAR(); qkt<0>(pA0, pA1, K_lds, r32, hi, S.qr);
    MASKT(pA0, pA1, 0); partialSM(pA0, pA1, m_reg, mnA, alA, ROWSEL(0));
    if (NT > 1) { VMW(); SWRITE_H(1); }
    __syncthreads();
#define HALF_STEP(PX0, PX1, mnX, alX, PY0, PY1, alY, t, KB, VB, SB) do {                                                      \
        SBAR(); qkt<KB>(PX0, PX1, K_lds, r32, hi, S.qr);                                                                      \
        finishSM(PY0, PY1, alY, l_reg, pa0, pa1, pa2, pa3); SBAR();                                                           \
        if ((t) + 1 < NT) { SLOAD_H(Kh, Vh, KBASE((t) + 1)); SBAR(); }                                                        \
        pv_tile<VB>(o, vb0, pa0, pa1, pa2, pa3); MASKT(PX0, PX1, (t)); partialSM(PX0, PX1, m_reg, mnX, alX, ROWSEL(t));       \
        __syncthreads();                                                                                                      \
        if ((t) + 1 < NT) { VMW(); SWRITE_H(SB); }                                                                            \
        RESC(alX); __syncthreads(); } while (0)
    for (int t = 1; t + 1 < NT; t += 2) {
        HALF_STEP(pB0, pB1, mnB, alB, pA0, pA1, alA, t, 1, 0, 0);
        HALF_STEP(pA0, pA1, mnA, alA, pB0, pB1, alB, t + 1, 0, 1, 1);
    }
    SBAR(); qkt<1>(pB0, pB1, K_lds, r32, hi, S.qr); SBAR();
    SLOAD_H(nxt.k, nxt.v, 0); SBAR();
    QLOAD(nxt.q);
    SBAR();
    finishSM(pA0, pA1, alA, l_reg, pa0, pa1, pa2, pa3); SBAR();
    pv_tile<0>(o, vb0, pa0, pa1, pa2, pa3);
    MASKT(pB0, pB1, NT - 1); partialSM(pB0, pB1, m_reg, mnB, alB, true); __syncthreads(); RESC(alB);
    finishSM(pB0, pB1, alB, l_reg, pa0, pa1, pa2, pa3); SBAR(); pv_tile<1>(o, vb0, pa0, pa1, pa2, pa3);
    SBAR(); SEAM_K0();
    if (hi == 0) li_l[r32] = l_reg; asm volatile("s_waitcnt lgkmcnt(0)" ::: "memory");
    float rli[16];
#pragma unroll
    for (int r = 0; r < 16; ++r) rli[r] = __builtin_amdgcn_rcpf(li_l[crow(r, hi)]);
    int tz = threadIdx.x; asm volatile("" : "+v"(tz));
    const int r32e = tz & 31, hie = (tz >> 5) & 1;
    const unsigned osoff = cur.o + (unsigned)(wid * QBLK) * (unsigned)(OSTR * 2);
#pragma unroll
    for (int r = 0; r < 16; ++r) { const unsigned ob = (unsigned)(crow(r, hie) * OSTR + r32e) * 2u;
#pragma unroll
        for (int d0 = 0; d0 < 4; ++d0) { const float v = o[d0][r] * rli[r];
            const float vn = __shfl_xor(v, 1);
            if ((r32e & 1) == 0) __builtin_amdgcn_raw_buffer_store_b32(cvtpkv(v, vn), rs, ob + d0 * 64, osoff, 0); } }
    __syncthreads();
#undef RESC
#undef KBASE
#undef ROWSEL
#undef MASKT
#undef SEAM_K0
#undef HALF_STEP
}
#undef QLOAD
#undef VMW
#undef VMWN
#undef SLOAD_H
#undef SWRITE_HK
#undef SWRITE_HV
#undef SWRITE_H
}

__device__ __constant__ double ROPE_INVF[16] = {1.0, 0.4403666026717805, 0.1939227447486858, 0.08539710028576561, 0.03760603093086394, 0.016560440080994443,
    0.007292664737217109, 0.0032114459947525913, 0.0014142135623730955, 0.0006227724219145962, 0.00027424817567620724, 0.00012076973741146502,
    5.318295896944988e-05, 2.3419998961409345e-05, 1.0313385377212461e-05, 4.541670480607871e-06};

__device__ __forceinline__ void sincos_d(double a, double& sn, double& cs) {
    const double k = __builtin_rint(a * 0.63661977236758134308);
    double y = __builtin_fma(-k, 1.57079632679489655800e+00, a); y = __builtin_fma(-k, 6.12323399573676603587e-17, y);
    const double z = y * y;
    double s = -7.6471637318198164759e-13; s = s * z + 1.6059043836821614599e-10; s = s * z - 2.5052108385441718775e-08; s = s * z + 2.7557319223985890653e-06;
    s = s * z - 1.9841269841269841270e-04; s = s * z + 8.3333333333333333333e-03; s = s * z - 1.6666666666666666667e-01; s = y + y * z * s;
    double c = 4.7794773323873852974e-14; c = c * z - 1.1470745597729724714e-11; c = c * z + 2.0876756987868098979e-09; c = c * z - 2.7557319223985890653e-07;
    c = c * z + 2.4801587301587301587e-05; c = c * z - 1.3888888888888888889e-03; c = c * z + 4.1666666666666666667e-02; c = c * z - 0.5; c = 1.0 + z * c;
    const int q = ((int)k) & 3;
    sn = (q == 0) ? s : (q == 1) ? c : (q == 2) ? -s : -c;
    cs = (q == 0) ? c : (q == 1) ? -s : (q == 2) ? -c : s;
}

typedef const __attribute__((address_space(4))) Params* KP;
__device__ __forceinline__ KP kparams() { KP k = (KP)__builtin_amdgcn_kernarg_segment_ptr(); asm volatile("" : "+s"(k)); return k; }

__global__ void __launch_bounds__(512, 2) mega(Params p_unused) {
    extern __shared__ __attribute__((aligned(16))) unsigned char lds_raw[];
    LAS unsigned char* lds = (LAS unsigned char*)lds_raw;
#define PH_IDS int tid = threadIdx.x; asm volatile("" : "+v"(tid)); const int lane = tid & 63, wave = __builtin_amdgcn_readfirstlane(tid >> 6); (void)lane; (void)wave
    const int G = gridDim.x, bx = blockIdx.x;
    const int vcu = (G % 8 == 0) ? (bx % 8) * (G / 8) + bx / 8 : bx;
    unsigned char* ws; int lo, hi;
    { KP k = kparams(); ws = k->ws; lo = k->ph_lo; hi = k->ph_hi; }
    unsigned* ctl = (unsigned*)(ws + WS_CTL);
    volatile LAS unsigned* MISC = (volatile LAS unsigned*)(lds + MISC_OFF);
    { PH_IDS; for (int u = tid; u < (LDS_BYTES - MISC_OFF) / 4; u += 512) MISC[u] = 0u; }
    __syncthreads();
    XcdBarrier bar; bar.bar = ctl + CW_BAR; bar.st = MISC;
    if (hi - lo > 1) bar = xcd_barrier_post(ctl + CW_BAR, MISC);
#ifndef PH_MASK
#define PH_MASK 0x3ff
#endif
#define IN(k) ((((PH_MASK) >> (k)) & 1) && lo <= (k) && (k) < hi)
#define SEAM(k) do { if (IN(k) && IN((k) + 1)) xcd_barrier(bar); } while (0)
    LAS int* pre = (LAS int*)(lds + MISC_OFF + 64);
    LAS int* cntl = (LAS int*)(lds + MISC_OFF + 256);

    if (IN(0)) {
        PH_IDS; KP kp = kparams(); const float* px = kp->x; const float* pnm = kp->norm_mix;
        const int gw = vcu * 8 + wave, NGW = G * 8;
        bf16_t* XN = (bf16_t*)(ws + WS_XN);
        for (int m0 = gw; m0 < NTOK; m0 += 4 * NGW) {
            f32x4 v[4][8];
#pragma unroll
            for (int q = 0; q < 4; ++q) { const int m = m0 + q * NGW; const GAS f32x4* xr = (const GAS f32x4*)(px + (size_t)(m < NTOK ? m : m0) * DM) + lane;
#pragma unroll
                for (int j = 0; j < 8; ++j) v[q][j] = xr[64 * j]; }
            f32x4 g[8];
#pragma unroll
            for (int j = 0; j < 8; ++j) g[j] = *((const GAS f32x4*)pnm + lane + 64 * j);
#pragma unroll
            for (int q = 0; q < 4; ++q) { const int m = m0 + q * NGW; if (m >= NTOK) break;
                float s = 0.f;
#pragma unroll
                for (int j = 0; j < 8; ++j) s += (v[q][j].x * v[q][j].x + v[q][j].y * v[q][j].y) + (v[q][j].z * v[q][j].z + v[q][j].w * v[q][j].w);
                const float rs = 1.f / sqrtf(wave_sum(s) * (1.f / DM) + NORM_EPS);
                GAS u32x2* o8 = (GAS u32x2*)(XN + (size_t)m * DM) + lane;
#pragma unroll
                for (int j = 0; j < 8; ++j) {
                    u32x2 w; w.x = cvtpk(v[q][j].x * rs * g[j].x, v[q][j].y * rs * g[j].y); w.y = cvtpk(v[q][j].z * rs * g[j].z, v[q][j].w * rs * g[j].w); o8[64 * j] = w; }
            }
        }
        if (G_BT) {
            LAS float* scr = (LAS float*)(lds + wave * 8448);
            for (int it = gw; it < 16384 + 3 * 2048; it += NGW) {
                int r = it; const float* W; size_t off; int N;
                if (r < 16384) { W = kp->w_in; off = WS_W16IN; N = 16384; }
                else { r -= 16384; const int q = r >> 11; r &= 2047; W = q == 0 ? kp->w_conv_out : (q == 1 ? kp->w_attn_out : kp->w_o); off = q == 0 ? WS_W16C : (q == 1 ? WS_W16A : WS_W16O); N = 2048; }
                if (N == 16384) p0_transpose_item<true>(W, N, (bf16_t*)(ws + off), scr, r, lane); else p0_transpose_item<false>(W, N, (bf16_t*)(ws + off), scr, r, lane);
            }
        } else
        { const float* srcs[4] = {kp->w_in, kp->w_conv_out, kp->w_attn_out, kp->w_o};
          const size_t offs[4] = {WS_W16IN, WS_W16C, WS_W16A, WS_W16O}; const int n8s[4] = {2048 * 16384 / 8, 2048 * 2048 / 8, 2048 * 2048 / 8, 2048 * 2048 / 8};
#pragma unroll
          for (int q = 0; q < 4; ++q) { const GAS f32x4* sp = (const GAS f32x4*)srcs[q]; GAS u32x4* dp = (GAS u32x4*)(ws + offs[q]);
              for (int i = vcu * 512 + tid; i < n8s[q]; i += G * 512) { const f32x4 a = sp[2 * i], b = sp[2 * i + 1];
                  u32x4 w; w.x = cvtpk(a.x, a.y); w.y = cvtpk(a.z, a.w); w.z = cvtpk(b.x, b.y); w.w = cvtpk(b.z, b.w); dp[i] = w; } } }
        float* COS = (float*)(ws + WS_ROPE); float* SIN = COS + 4096 * 16;
        for (int i = vcu * 512 + tid; i < 4096 * 16; i += G * 512) { const int pos = i >> 4, f = i & 15;
            double sn, cs; sincos_d((double)pos * ROPE_INVF[f], sn, cs); COS[i] = (float)cs; SIN[i] = (float)sn; }
    }
    SEAM(0);
    if (IN(1)) { KP kp = kparams(); ProbIn P{ws, kp->w_in, G, bx, lds, kp->conv_w}; gm::gemm_stream<ProbIn>(lds, P); }
    SEAM(1);
    if (IN(3)) {
        const at::rs_t rs = __builtin_amdgcn_make_buffer_rsrc((void*)ws, 0, (unsigned)WS_END, 0x00020000);
        auto conv_fixup = [&]() {
            { PH_IDS;
          KP kp = kparams(); const float* pcw = kp->conv_w; const float* SBp = (const float*)(ws + WS_SB); bf16_t* CONV = (bf16_t*)(ws + WS_CONV);
          for (int it = vcu * 512 + tid; it < 32 * 2 * 512; it += G * 512) {
              const int c4 = (it & 511) * 4, r01 = (it >> 9) & 1, pm = it >> 10;
              if ((pm & 15) != 0) {
                  const float* curp = SBp + (size_t)pm * (6 * 2048) + c4; const float* prv = SBp + (size_t)(pm - 1) * (6 * 2048) + c4;
                  const f32x4 w0 = *(const GAS f32x4*)(pcw + c4), w1 = *(const GAS f32x4*)(pcw + 2048 + c4), w2 = *(const GAS f32x4*)(pcw + 4096 + c4);
                  const f32x4 p254 = *(const GAS f32x4*)prv, p255 = *(const GAS f32x4*)(prv + 2048);
                  const f32x4 bg0 = *(const GAS f32x4*)(curp + 2 * 2048), u0 = *(const GAS f32x4*)(curp + 3 * 2048), bg1 = *(const GAS f32x4*)(curp + 4 * 2048), u1 = *(const GAS f32x4*)(curp + 5 * 2048);
                  const f32x4 y = r01 == 0 ? bg0 * (w0 * p254 + w1 * p255 + w2 * u0) : bg1 * (w0 * p255 + w1 * u0 + w2 * u1);
                  u32x2 o; o.x = cvtpk(y[0], y[1]); o.y = cvtpk(y[2], y[3]);
                  *(GAS u32x2*)(CONV + (size_t)(pm * 256 + r01) * 2048 + c4) = o;
              }
          } }
        };
        int L = vcu;
        if (L < 256) {
            int pass = 0;
#define MK_REF(r, L_, p_) do { const int bh = (L_) >> 3, x_ = (L_) & 7, qb = (p_) ? 15 - x_ : x_; const int b_ = bh >> 4, h_ = bh & 15; \
                r.q = (unsigned)(WS_Q + ((size_t)bh * 4096 + qb * 256) * 256); r.k = (unsigned)(WS_K + (size_t)bh * MiB); r.v = (unsigned)(WS_V + (size_t)bh * MiB); \
                r.o = (unsigned)(WS_ATT + ((size_t)(b_ * 4096 + qb * 256)) * 4096 + h_ * 256); r.km = (unsigned)(WS_KMSUM + (size_t)bh * 8192); r.P0 = qb * 256; } while (0)
            at::BlockRef cur, nxt; MK_REF(cur, L, 0);
            at::Seam S;
            at::moba_prime(cur, rs, (char*)lds_raw, S);
            conv_fixup();
            at::moba_prime_finish(rs, (char*)lds_raw, S);
            for (;;) {
                const bool more_pass = (pass == 0), more_item = (L + G < 256), last = !more_pass && !more_item;
                int passn = pass + 1, Ln = L;
                if (!more_pass) { passn = 0; Ln = more_item ? L + G : L; }
                if (last) nxt = cur; else MK_REF(nxt, Ln, passn);
                at::moba_block(cur, nxt, rs, (char*)lds_raw, S);
                if (last) break;
                cur = nxt; pass = passn; L = Ln;
            }
#undef MK_REF
        } else conv_fixup();
    }
    SEAM(3);
    if (IN(4)) { KP kp = kparams(); ProbMerge P{ws, kp->w_conv_out, kp->w_attn_out, G, bx}; gm::gemm_stream<ProbMerge>(lds, P); }
    SEAM(4);
    if (IN(5)) { KP kp = kparams(); ProbWo P{ws, kp->w_o, kp->x, G, bx}; gm::gemm_stream<ProbWo>(lds, P); }
    SEAM(5);
    if (IN(6)) {
        PH_IDS;
        const float* H1 = (const float*)(ws + WS_H1); bf16_t* XN2 = (bf16_t*)(ws + WS_XN);
        KP kp = kparams(); const float* pnf = kp->norm_ffn; const float* pwr = kp->w_router; const float* pbr = kp->b_router;
        int* SLOT = (int*)(ws + WS_SLOT); float* TOKW = (float*)(ws + WS_TOKW); int* EROWS = (int*)(ws + WS_EROWS);
        LAS float* rs_l = (LAS float*)lds;
        LAS float* part = (LAS float*)(lds + 1024);
        LAS float* lg = (LAS float*)(lds + 1024 + 32768);
        for (int rb = vcu; rb < NTOK / 32; rb += G) {
            { f32x4 v[4][8];
#pragma unroll
              for (int rr = 0; rr < 4; ++rr) { const GAS f32x4* xr = (const GAS f32x4*)(H1 + (size_t)(rb * 32 + wave * 4 + rr) * DM) + lane;
#pragma unroll
                  for (int j = 0; j < 8; ++j) v[rr][j] = xr[64 * j]; }
              f32x4 gg[8];
#pragma unroll
              for (int j = 0; j < 8; ++j) gg[j] = *((const GAS f32x4*)pnf + lane + 64 * j);
#pragma unroll
              for (int rr = 0; rr < 4; ++rr) {
                const int rl = wave * 4 + rr, m = rb * 32 + rl;
                float s = 0.f;
#pragma unroll
                for (int j = 0; j < 8; ++j) s += (v[rr][j].x * v[rr][j].x + v[rr][j].y * v[rr][j].y) + (v[rr][j].z * v[rr][j].z + v[rr][j].w * v[rr][j].w);
                const float rs = 1.f / sqrtf(wave_sum(s) * (1.f / DM) + NORM_EPS);
                GAS u32x2* o8 = (GAS u32x2*)(XN2 + (size_t)m * DM) + lane;
#pragma unroll
                for (int j = 0; j < 8; ++j) {
                    u32x2 w; w.x = cvtpk(v[rr][j].x * rs * gg[j].x, v[rr][j].y * rs * gg[j].y); w.y = cvtpk(v[rr][j].z * rs * gg[j].z, v[rr][j].w * rs * gg[j].w); o8[64 * j] = w; }
                if (lane == 0) rs_l[rl] = rs;
              } }
            { const int row = lane & 31, kk = lane >> 5;
              const GAS float* hp = (const GAS float*)H1 + (size_t)(rb * 32 + row) * DM + 256 * wave + kk;
              const GAS float* wp = (const GAS float*)pwr + (size_t)(256 * wave + kk) * 32 + row;
              const GAS float* gp = (const GAS float*)pnf + 256 * wave + kk;
              f32x16 acc = {};
#pragma unroll 8
              for (int st = 0; st < 128; ++st) { const float a = hp[2 * st]; const float bb = wp[(size_t)(2 * st) * 32] * gp[2 * st];
                  acc = __builtin_amdgcn_mfma_f32_32x32x2f32(a, bb, acc, 0, 0, 0); }
#pragma unroll
              for (int r = 0; r < 16; ++r) part[(wave * 32 + ((r & 3) + 8 * (r >> 2) + 4 * kk)) * 32 + row] = acc[r];
            }
            __syncthreads();
            for (int idx = tid; idx < 1024; idx += 512) { float sum = 0.f;
#pragma unroll
                for (int w8 = 0; w8 < 8; ++w8) sum += part[w8 * 1024 + idx];
                lg[idx] = sum * rs_l[idx >> 5] + pbr[idx & 31]; }
            __syncthreads();
            if (tid < 32) {
                const int m = rb * 32 + tid; float l[32];
#pragma unroll
                for (int e = 0; e < 32; ++e) l[e] = lg[tid * 32 + e];
                int se[4]; float sv[4];
#pragma unroll
                for (int k = 0; k < 4; ++k) { float best = -__builtin_inff(); int bi = 0;
#pragma unroll
                    for (int e = 0; e < 32; ++e) { const bool tk = l[e] > best; best = tk ? l[e] : best; bi = tk ? e : bi; }
                    se[k] = bi; sv[k] = best;
#pragma unroll
                    for (int e = 0; e < 32; ++e) if (e == bi) l[e] = -__builtin_inff(); }
                const float e1 = fast_exp(sv[1] - sv[0]), e2 = fast_exp(sv[2] - sv[0]), e3 = fast_exp(sv[3] - sv[0]);
                const float inv = 1.f / (1.f + e1 + e2 + e3);
                const float wgt[4] = {inv, e1 * inv, e2 * inv, e3 * inv};
#pragma unroll
                for (int k = 0; k < 4; ++k) {
                    const int pos = (int)__hip_atomic_fetch_add(ctl + CW_CNT + 64 * se[k], 1u, __ATOMIC_RELAXED, __HIP_MEMORY_SCOPE_AGENT);
                    EROWS[se[k] * 8192 + pos] = m; SLOT[m * 4 + k] = (se[k] << 16) | pos; TOKW[m * 4 + k] = wgt[k];
                }
            }
            __syncthreads();
        }
    }
    SEAM(6);
    if (IN(7) || IN(8) || IN(9)) {
        PH_IDS;
        if (tid < 64) {
            const int c = tid < 32 ? (int)__hip_atomic_load(ctl + CW_CNT + 64 * tid, __ATOMIC_RELAXED, __HIP_MEMORY_SCOPE_AGENT) : 0;
            const int tl = (c + 255) >> 8; int inc = tl;
#pragma unroll
            for (int o = 1; o < 32; o <<= 1) { const int t = __shfl_up(inc, o); if ((tid & 63) >= o) inc += t; }
            if (tid < 32) { cntl[tid] = c; pre[tid] = inc - tl; if (tid == 31) pre[32] = inc; }
        }
        __syncthreads();
    }
    const MoeTab MT{pre, cntl};
    if (IN(7)) { KP kp = kparams(); ProbMoe1 P{ws, kp->w_gate, kp->w_up, kp->b_gate, kp->b_up, MT, G, vcu, lds}; gm::gemm_stream<ProbMoe1>(lds, P); }
    SEAM(7);
    if (IN(8)) { KP kp = kparams(); ProbMoe2 P{ws, kp->w_down, kp->b_down, MT, G, vcu, lds}; gm::gemm_stream<ProbMoe2>(lds, P); }
    SEAM(8);
    if (IN(9)) {
        PH_IDS;
        const float* H1 = (const float*)(ws + WS_H1); const bf16_t* YB = (const bf16_t*)(ws + WS_YB);
        const int* SLOT = (const int*)(ws + WS_SLOT); const float* TOKW = (const float*)(ws + WS_TOKW);
        KP kp = kparams(); const float* pfin = kp->norm_final; float* pout = kp->out;
        const int gw = vcu * 8 + wave, NGW = G * 8;
        for (int m = gw; m < NTOK; m += NGW) {
            const GAS u32x4* yr[4]; float wk[4];
#pragma unroll
            for (int k = 0; k < 4; ++k) { const int sl = SLOT[m * 4 + k]; const int e = sl >> 16, pos = sl & 0xffff; wk[k] = TOKW[m * 4 + k];
                yr[k] = (const GAS u32x4*)(YB + ((size_t)pre[e] * 256 + pos) * 2048) + lane; }
            const GAS f32x4* xr = (const GAS f32x4*)(H1 + (size_t)m * DM) + 2 * lane;
            f32x4 v[4][2]; float s = 0.f;
#pragma unroll
            for (int j = 0; j < 4; ++j) { v[j][0] = xr[128 * j]; v[j][1] = xr[128 * j + 1];
#pragma unroll
                for (int k = 0; k < 4; ++k) { const u32x4 y = yr[k][64 * j];
                    v[j][0].x += wk[k] * bf_lo(y.x); v[j][0].y += wk[k] * bf_hi(y.x); v[j][0].z += wk[k] * bf_lo(y.y); v[j][0].w += wk[k] * bf_hi(y.y);
                    v[j][1].x += wk[k] * bf_lo(y.z); v[j][1].y += wk[k] * bf_hi(y.z); v[j][1].z += wk[k] * bf_lo(y.w); v[j][1].w += wk[k] * bf_hi(y.w); }
#pragma unroll
                for (int h = 0; h < 2; ++h) s += (v[j][h].x * v[j][h].x + v[j][h].y * v[j][h].y) + (v[j][h].z * v[j][h].z + v[j][h].w * v[j][h].w); }
            const float rs = 1.f / sqrtf(wave_sum(s) * (1.f / DM) + NORM_EPS);
            GAS f32x4* orow = (GAS f32x4*)(pout + (size_t)m * DM) + 2 * lane;
#pragma unroll
            for (int j = 0; j < 4; ++j)
#pragma unroll
                for (int h = 0; h < 2; ++h) { const f32x4 gg = *((const GAS f32x4*)pfin + 2 * lane + 128 * j + h);
                    orow[128 * j + h] = (f32x4){v[j][h].x * rs * gg.x, v[j][h].y * rs * gg.y, v[j][h].z * rs * gg.z, v[j][h].w * rs * gg.w}; }
        }
    }
#undef IN
#undef SEAM
}


#if PROBE_REP >= 0
__global__ void __launch_bounds__(512, 2) probe_k(Params p_unused) {
    extern __shared__ __attribute__((aligned(16))) unsigned char lds_raw[];
    LAS unsigned char* lds = (LAS unsigned char*)lds_raw;
    const int G = gridDim.x, bx = blockIdx.x;
    const int vcu = (G % 8 == 0) ? (bx % 8) * (G / 8) + bx / 8 : bx;
    KP kp = kparams(); unsigned char* ws = kp->ws; unsigned* ctl = (unsigned*)(ws + WS_CTL);
    LAS int* pre = (LAS int*)(lds + MISC_OFF + 64);
    LAS int* cntl = (LAS int*)(lds + MISC_OFF + 256);
    { const int tid = threadIdx.x;
      if (tid < 32) cntl[tid] = (int)__hip_atomic_load(ctl + CW_CNT + 64 * tid, __ATOMIC_RELAXED, __HIP_MEMORY_SCOPE_AGENT);
      __syncthreads();
      if (tid == 0) { int a = 0; for (int e = 0; e < 32; ++e) { pre[e] = a; a += (cntl[e] + 255) >> 8; } pre[32] = a; }
      __syncthreads(); }
    const MoeTab MT{pre, cntl};
    if (PROBE_REP == 1) { ProbIn P{ws, kp->w_in, G, bx, lds, kp->conv_w}; gm::gemm_stream<ProbIn, PROBE_ABL>(lds, P); }
    if (PROBE_REP == 7) { ProbMoe1 P{ws, kp->w_gate, kp->w_up, kp->b_gate, kp->b_up, MT, G, vcu, lds}; gm::gemm_stream<ProbMoe1, PROBE_ABL>(lds, P); }
    if (PROBE_REP == 8) { ProbMoe2 P{ws, kp->w_down, kp->b_down, MT, G, vcu, lds}; gm::gemm_stream<ProbMoe2, PROBE_ABL>(lds, P); }
}
#endif

extern "C" void kernel_launch(void* const* d_in, const int* in_sizes, int n_in, void* d_out, int out_size, void* d_ws, size_t ws_size, hipStream_t stream) {
    static int grid = 0;
    if (grid == 0) {
        if (n_in != 17 || in_sizes[0] != NTOK * DM || out_size != NTOK * DM || ws_size < WS_END) {
            fprintf(stderr, "kernel_launch: unexpected shapes (n_in %d, in0 %d, out %d, ws %zu); nothing launched\n", n_in, n_in > 0 ? in_sizes[0] : -1, out_size, ws_size); grid = -1; return; }
        int dev = 0, cus = 0, per_cu = 0;
        if (hipGetDevice(&dev) != hipSuccess || hipDeviceGetAttribute(&cus, hipDeviceAttributeMultiprocessorCount, dev) != hipSuccess) { grid = -1; return; }
        if (hipFuncSetAttribute((const void*)mega, hipFuncAttributeMaxDynamicSharedMemorySize, LDS_BYTES) != hipSuccess) { fprintf(stderr, "kernel_launch: hipFuncSetAttribute failed\n"); grid = -1; return; }
        if (hipOccupancyMaxActiveBlocksPerMultiprocessor(&per_cu, (const void*)mega, 512, LDS_BYTES) != hipSuccess || per_cu < 1) {
            fprintf(stderr, "kernel_launch: occupancy query says %d blocks per CU\n", per_cu); }
        (void)hipGetLastError();
        grid = cus;
    }
    if (grid < 0) return;
    (void)hipMemsetAsync((char*)d_ws + WS_CTL, 0, CTL_BYTES, stream);
    Params p{};
    p.x = (const float*)d_in[0]; p.norm_mix = (const float*)d_in[1]; p.w_in = (const float*)d_in[2]; p.conv_w = (const float*)d_in[3];
    p.w_conv_out = (const float*)d_in[4]; p.w_attn_out = (const float*)d_in[5]; p.w_o = (const float*)d_in[6]; p.norm_ffn = (const float*)d_in[7];
    p.w_router = (const float*)d_in[8]; p.b_router = (const float*)d_in[9]; p.w_gate = (const float*)d_in[10]; p.b_gate = (const float*)d_in[11];
    p.w_up = (const float*)d_in[12]; p.b_up = (const float*)d_in[13]; p.w_down = (const float*)d_in[14]; p.b_down = (const float*)d_in[15];
    p.norm_final = (const float*)d_in[16];
    p.out = (float*)d_out; p.ws = (unsigned char*)d_ws;
#if MK_FUSED
    p.ph_lo = 0; p.ph_hi = N_PHASES;
    hipLaunchKernelGGL(mega, dim3(grid), dim3(512), LDS_BYTES, stream, p);
#if PROBE_REP >= 0
    { static bool once = false; if (!once) { once = true; (void)hipFuncSetAttribute((const void*)probe_k, hipFuncAttributeMaxDynamicSharedMemorySize, LDS_BYTES); }
      hipLaunchKernelGGL(probe_k, dim3(grid), dim3(512), LDS_BYTES, stream, p); }
#endif
#else
    for (int ph = 0; ph < N_PHASES; ++ph) { p.ph_lo = ph; p.ph_hi = ph + 1; hipLaunchKernelGGL(mega, dim3(grid), dim3(512), LDS_BYTES, stream, p); }
#endif
}
```
